# Optimizing an MI355X kernel written in HIP

```python
import jax, jax.numpy as jnp
from jax import lax
import numpy as np

D_MODEL = 1024
BATCH = 4
SEQ = 4096
DEPTH = 1

N_META = 16
BLOCK = 128
PAD_FRONT = BLOCK - N_META
N_Q_HEADS = 8
N_KV_HEADS = 2
HEAD_DIM = 64
WINDOW = 128
ROPE_DIM = HEAD_DIM // 4
ROPE_THETA = 500000.0
N_R_HEADS = 4
R_KEY_DIM = 128
R_VAL_DIM = 128
CHUNK = 64
SUB = 16
ATTN_WIDTH = N_Q_HEADS * HEAD_DIM
KV_WIDTH = N_KV_HEADS * HEAD_DIM
REC_K_WIDTH = N_R_HEADS * R_KEY_DIM
REC_V_WIDTH = N_R_HEADS * R_VAL_DIM
SPLIT_WIDTHS = (ATTN_WIDTH, KV_WIDTH, KV_WIDTH, REC_K_WIDTH, REC_K_WIDTH, REC_V_WIDTH, REC_V_WIDTH, D_MODEL, D_MODEL)
IN_WIDTH = sum(SPLIT_WIDTHS)
N_SUBKEYS = 128
N_EXPERTS = N_SUBKEYS * N_SUBKEYS
PEER_HEADS = 8
PEER_QUERY_DIM = 128
PEER_TOPK = 16
PEER_BLOCK = 256
EPS = 1e-6
MASK_VALUE = -1e30

kernel_name = 'hybrid_swa_hgrn2_peer_block'


def rmsnorm(x, g):
    xf = x.astype(jnp.float32)
    y = xf * lax.rsqrt(jnp.mean(xf * xf, axis=-1, keepdims=True) + EPS)
    return (y * g.astype(jnp.float32)).astype(x.dtype)


def apply_partial_rope(t, pos):
    half = ROPE_DIM // 2
    inv_freq = jnp.power(ROPE_THETA, -jnp.arange(half, dtype=jnp.float32) * 2.0 / ROPE_DIM)
    ang = pos.astype(jnp.float32)[:, None] * inv_freq[None, :]
    cos = jnp.cos(ang)[None, :, None, :]
    sin = jnp.sin(ang)[None, :, None, :]
    tf = t.astype(jnp.float32)
    t1, t2 = tf[..., :half], tf[..., half:ROPE_DIM]
    out = jnp.concatenate([t1 * cos - t2 * sin, t2 * cos + t1 * sin, tf[..., ROPE_DIM:]], axis=-1)
    return out.astype(t.dtype)


def sliding_window_attention(q, k, v, sinks):
    B, Lp = q.shape[0], q.shape[1]
    nb = Lp // BLOCK
    G = N_Q_HEADS // N_KV_HEADS
    qb = q.astype(jnp.float32).reshape(B, nb, BLOCK, N_KV_HEADS, G, HEAD_DIM)
    kb = k.astype(jnp.float32).reshape(B, nb, BLOCK, N_KV_HEADS, HEAD_DIM)
    vb = v.astype(jnp.float32).reshape(B, nb, BLOCK, N_KV_HEADS, HEAD_DIM)
    k_band = jnp.concatenate([jnp.concatenate([jnp.zeros_like(kb[:, :1]), kb[:, :-1]], axis=1), kb], axis=2)
    v_band = jnp.concatenate([jnp.concatenate([jnp.zeros_like(vb[:, :1]), vb[:, :-1]], axis=1), vb], axis=2)
    meta_k = k[:, PAD_FRONT:BLOCK].astype(jnp.float32)
    meta_v = v[:, PAD_FRONT:BLOCK].astype(jnp.float32)
    scale = HEAD_DIM ** -0.5
    s_band = jnp.einsum('bnqhgd,bnkhd->bnhgqk', qb, k_band) * scale
    s_meta = jnp.einsum('bnqhgd,bmhd->bnhgqm', qb, meta_k) * scale
    p_q = jnp.arange(Lp).reshape(nb, BLOCK)
    p_k = p_q[:, :1] - BLOCK + jnp.arange(2 * BLOCK)[None, :]
    dq = p_q[:, :, None] - p_k[:, None, :]
    band_ok = (dq >= 0) & (dq < WINDOW) & (p_k[:, None, :] >= BLOCK)
    meta_ok = (PAD_FRONT + jnp.arange(N_META))[None, None, :] <= p_q[:, :, None]
    s_band = jnp.where(band_ok[None, :, None, None], s_band, MASK_VALUE)
    s_meta = jnp.where(meta_ok[None, :, None, None], s_meta, MASK_VALUE)
    sink = jnp.broadcast_to(sinks.astype(jnp.float32).reshape(1, 1, N_KV_HEADS, G, 1, 1), s_band.shape[:-1] + (1,))
    probs = jax.nn.softmax(jnp.concatenate([s_band, s_meta, sink], axis=-1), axis=-1)
    p_band = probs[..., :2 * BLOCK]
    p_meta = probs[..., 2 * BLOCK:2 * BLOCK + N_META]
    out = (jnp.einsum('bnhgqk,bnkhd->bnqhgd', p_band, v_band)
           + jnp.einsum('bnhgqm,bmhd->bnqhgd', p_meta, meta_v))
    return out.reshape(B, Lp, N_Q_HEADS * HEAD_DIM)


def hgrn2_chunkwise(q, k, v, log_f):
    B, Lp, H, dk = q.shape
    dv = v.shape[-1]
    nc = Lp // CHUNK
    ns = CHUNK // SUB

    def to_chunks(t):
        return t.astype(jnp.float32).reshape(B, nc, CHUNK, H, t.shape[-1]).transpose(0, 3, 1, 2, 4)

    qc, kc, vc, lf = to_chunks(q), to_chunks(k), to_chunks(v), to_chunks(log_f)
    b = jnp.cumsum(lf, axis=3)
    b_last = b[:, :, :, -1]
    dS = jnp.einsum('bhncd,bhnce->bhnde', kc * jnp.exp(b_last[:, :, :, None] - b), vc)
    decay = jnp.exp(b_last)

    def step(S, inp):
        a, u = inp
        return a[..., None] * S + u, S

    _, S_prev = lax.scan(step, jnp.zeros((B, H, dk, dv), jnp.float32),
                         (decay.transpose(2, 0, 1, 3), dS.transpose(2, 0, 1, 3, 4)))
    S_prev = S_prev.transpose(1, 2, 0, 3, 4)
    o_inter = jnp.einsum('bhncd,bhnde->bhnce', qc * jnp.exp(b), S_prev)
    qs = qc.reshape(B, H, nc, ns, SUB, dk)
    ks = kc.reshape(B, H, nc, ns, SUB, dk)
    vs = vc.reshape(B, H, nc, ns, SUB, dv)
    bs = b.reshape(B, H, nc, ns, SUB, dk)
    b_ref = jnp.concatenate([jnp.zeros_like(bs[:, :, :, :1, 0]), bs[:, :, :, :-1, -1]], axis=3)
    q_t = qs * jnp.exp(bs - b_ref[:, :, :, :, None, :])
    off_mask = jnp.arange(ns)[None, :] < jnp.arange(ns)[:, None]
    expo_off = b_ref[:, :, :, :, None, None, :] - bs[:, :, :, None]
    k_t = ks[:, :, :, None] * jnp.exp(jnp.where(off_mask[:, :, None, None], expo_off, MASK_VALUE))
    a_off = jnp.einsum('bhnitd,bhnijsd->bhnitjs', q_t, k_t)
    o_off = jnp.einsum('bhnitjs,bhnjse->bhnite', a_off, vs)
    causal = jnp.tril(jnp.ones((SUB, SUB), dtype=bool))
    expo_diag = bs[..., :, None, :] - bs[..., None, :, :]
    dec_diag = jnp.exp(jnp.where(causal[:, :, None], expo_diag, MASK_VALUE))
    a_diag = jnp.einsum('bhnitd,bhnisd,bhnitsd->bhnits', qs, ks, dec_diag)
    o_diag = jnp.einsum('bhnits,bhnise->bhnite', a_diag, vs)
    o = o_inter + (o_off + o_diag).reshape(B, H, nc, CHUNK, dv)
    return o.transpose(0, 2, 3, 1, 4).reshape(B, Lp, H, dv)


def hybrid_mixer(xn, w_in, b_in, sinks, lower_bound, rec_norm_g, w_up_attn, w_up_rec, w_out, pos):
    B, L, _ = xn.shape
    Lp = L + PAD_FRONT
    xp = jnp.pad(xn, ((0, 0), (PAD_FRONT, 0), (0, 0)))
    proj = xp @ w_in + b_in
    q, k, v, rq, rf, ri, rg, ga, gr = jnp.split(proj, np.cumsum(SPLIT_WIDTHS)[:-1].tolist(), axis=-1)
    q = apply_partial_rope(q.reshape(B, Lp, N_Q_HEADS, HEAD_DIM), pos)
    k = apply_partial_rope(k.reshape(B, Lp, N_KV_HEADS, HEAD_DIM), pos)
    v = v.reshape(B, Lp, N_KV_HEADS, HEAD_DIM)
    attn_out = sliding_window_attention(q, k, v, sinks)[:, PAD_FRONT:].astype(xn.dtype)
    lb = lower_bound.reshape(N_R_HEADS, R_KEY_DIM)
    valid = (jnp.arange(Lp) >= PAD_FRONT)[None, :, None, None]
    z_f = rf.reshape(B, Lp, N_R_HEADS, R_KEY_DIM).astype(jnp.float32)
    log_f = jnp.logaddexp(jnp.log(lb), jnp.log1p(-lb) + jax.nn.log_sigmoid(z_f))
    log_f = jnp.where(valid, log_f, 0.0)
    k_r = -jnp.expm1(log_f)
    o_r = hgrn2_chunkwise(rq.reshape(B, Lp, N_R_HEADS, R_KEY_DIM), k_r,
                          ri.reshape(B, Lp, N_R_HEADS, R_VAL_DIM), log_f)[:, PAD_FRONT:]
    o_r = o_r * lax.rsqrt(jnp.mean(o_r * o_r, axis=-1, keepdims=True) + EPS)
    o_r = o_r * rec_norm_g.astype(jnp.float32).reshape(N_R_HEADS, R_VAL_DIM)
    o_r = o_r * jax.nn.silu(rg[:, PAD_FRONT:].astype(jnp.float32).reshape(B, L, N_R_HEADS, R_VAL_DIM))
    rec_out = o_r.reshape(B, L, REC_V_WIDTH).astype(xn.dtype)
    merged = (jax.nn.sigmoid(ga[:, PAD_FRONT:]) * (attn_out @ w_up_attn)
              + jax.nn.sigmoid(gr[:, PAD_FRONT:]) * (rec_out @ w_up_rec))
    return merged @ w_out


def peer_ffn(x, w_query, sub_keys, expert_down, expert_up):
    T = x.shape[0]
    T_pad = -(-T // PEER_BLOCK) * PEER_BLOCK
    xp = jnp.pad(x, ((0, T_pad - T), (0, 0)))
    half = PEER_QUERY_DIM // 2
    qry = (xp @ w_query).astype(jnp.float32).reshape(T_pad, PEER_HEADS, 2, half)
    scores = jnp.einsum('thpd,hpnd->thpn', qry, sub_keys.astype(jnp.float32))
    s_top, i_top = lax.top_k(scores, PEER_TOPK)
    cand = s_top[:, :, 0, :, None] + s_top[:, :, 1, None, :]
    cand_idx = i_top[:, :, 0, :, None] * N_SUBKEYS + i_top[:, :, 1, None, :]
    best, sel = lax.top_k(cand.reshape(T_pad, PEER_HEADS, PEER_TOPK * PEER_TOPK), PEER_TOPK)
    idx = jnp.take_along_axis(cand_idx.reshape(T_pad, PEER_HEADS, PEER_TOPK * PEER_TOPK), sel, axis=-1)
    gate = jax.nn.softmax(best, axis=-1)
    nblk = T_pad // PEER_BLOCK

    def apply_block(args):
        xb, ib, wb = args
        u = expert_down[ib]
        act = jax.nn.gelu(jnp.einsum('td,thkd->thk', xb, u).astype(jnp.float32), approximate=False) * wb
        return jnp.einsum('thk,thkd->td', act.astype(xb.dtype), expert_up[ib])

    y = lax.map(apply_block, (xp.reshape(nblk, PEER_BLOCK, D_MODEL),
                              idx.reshape(nblk, PEER_BLOCK, PEER_HEADS, PEER_TOPK),
                              gate.reshape(nblk, PEER_BLOCK, PEER_HEADS, PEER_TOPK)))
    return y.reshape(T_pad, D_MODEL)[:T]


def setup_inputs(seed: int = 0) -> dict:
    key = jax.random.key(seed)
    ks = jax.random.split(key, 17)

    def normal(k, shape, scale):
        return jax.random.normal(k, shape, jnp.float32) * scale

    return {
        'x': normal(ks[0], (BATCH, SEQ, D_MODEL), 1.0),
        'meta_tokens': normal(ks[1], (N_META, D_MODEL), 1.0),
        'norm_mix_g': 1.0 + normal(ks[2], (DEPTH, D_MODEL), 0.02),
        'w_in': normal(ks[3], (DEPTH, D_MODEL, IN_WIDTH), D_MODEL ** -0.5),
        'b_in': normal(ks[4], (DEPTH, IN_WIDTH), 0.02),
        'attn_sinks': normal(ks[5], (DEPTH, N_Q_HEADS), 0.5),
        'lb_logits': normal(ks[6], (DEPTH + 1, REC_K_WIDTH), 0.5),
        'rec_norm_g': 1.0 + normal(ks[7], (DEPTH, REC_V_WIDTH), 0.02),
        'w_up_attn': normal(ks[8], (DEPTH, ATTN_WIDTH, D_MODEL), ATTN_WIDTH ** -0.5),
        'w_up_rec': normal(ks[9], (DEPTH, REC_V_WIDTH, D_MODEL), REC_V_WIDTH ** -0.5),
        'w_out': normal(ks[10], (DEPTH, D_MODEL, D_MODEL), D_MODEL ** -0.5),
        'norm_ffn_g': 1.0 + normal(ks[11], (DEPTH, D_MODEL), 0.02),
        'peer_w_query': normal(ks[12], (DEPTH, D_MODEL, PEER_HEADS * PEER_QUERY_DIM), D_MODEL ** -0.5),
        'peer_sub_keys': normal(ks[13], (DEPTH, PEER_HEADS, 2, N_SUBKEYS, PEER_QUERY_DIM // 2), (PEER_QUERY_DIM // 2) ** -0.5),
        'peer_expert_down': normal(ks[14], (DEPTH, N_EXPERTS, D_MODEL), D_MODEL ** -0.5),
        'peer_expert_up': normal(ks[15], (DEPTH, N_EXPERTS, D_MODEL), PEER_HEADS ** -0.5),
        'final_norm_g': 1.0 + normal(ks[16], (D_MODEL,), 0.02),
    }


def reference(x, meta_tokens, norm_mix_g, w_in, b_in, attn_sinks, lb_logits, rec_norm_g, w_up_attn, w_up_rec,
              w_out, norm_ffn_g, peer_w_query, peer_sub_keys, peer_expert_down, peer_expert_up, final_norm_g):
    B = x.shape[0]
    h = jnp.concatenate([jnp.broadcast_to(meta_tokens[None].astype(x.dtype), (B, N_META, D_MODEL)), x], axis=1)
    pos = jnp.arange(PAD_FRONT + h.shape[1]) - PAD_FRONT
    lower_bounds = jnp.cumsum(jax.nn.softmax(lb_logits.astype(jnp.float32), axis=0), axis=0)
    for layer in range(DEPTH):
        h = h + hybrid_mixer(rmsnorm(h, norm_mix_g[layer]), w_in[layer], b_in[layer], attn_sinks[layer],
                             lower_bounds[layer], rec_norm_g[layer], w_up_attn[layer], w_up_rec[layer],
                             w_out[layer], pos)
        if layer == DEPTH - 1:
            h = h[:, N_META:]
        L = h.shape[1]
        y = peer_ffn(rmsnorm(h, norm_ffn_g[layer]).reshape(B * L, D_MODEL), peer_w_query[layer],
                     peer_sub_keys[layer], peer_expert_down[layer], peer_expert_up[layer])
        h = h + y.reshape(B, L, D_MODEL)
    return rmsnorm(h, final_norm_g)
```

```cpp
#include <hip/hip_runtime.h>
#include <stdint.h>

typedef unsigned short bf16_t;
typedef short bf16x8 __attribute__((ext_vector_type(8)));
typedef float f32x4 __attribute__((ext_vector_type(4)));

constexpr int NB = 4, SEQ = 4096, DM = 1024, LP = 4224, PADF = 112;
constexpr int R = NB * LP;
constexpr int T = NB * SEQ;
constexpr int NIN = 4864;
constexpr float EPS = 1e-6f;

constexpr size_t MiB = 1024 * 1024;
constexpr size_t OFF_WUA = 0;
constexpr size_t OFF_WUR = 1 * MiB;
constexpr size_t OFF_WOUT = 2 * MiB;
constexpr size_t OFF_WQ = 4 * MiB;
constexpr size_t OFF_KEYS = 6 * MiB;
constexpr size_t OFF_ROPE = 6 * MiB + 256 * 1024;
constexpr size_t OFF_LB = OFF_ROPE + 272 * 1024;
constexpr size_t OFF_SSQ = 7 * MiB;
constexpr size_t OFF_B = 8 * MiB;
constexpr size_t OFF_QB = OFF_B;
constexpr size_t OFF_KB = OFF_QB + (size_t)R * 512 * 2;
constexpr size_t OFF_VB = OFF_KB + (size_t)R * 128 * 2;
constexpr size_t OFF_RQ = OFF_VB + (size_t)R * 128 * 2;
constexpr size_t OFF_LOGF = OFF_RQ + (size_t)R * 512 * 2;
constexpr size_t OFF_RI = OFF_LOGF + (size_t)R * 512 * 4;
constexpr size_t OFF_RG = OFF_RI + (size_t)R * 512 * 2;
constexpr size_t OFF_GA = OFF_RG + (size_t)R * 512 * 2;
constexpr size_t OFF_GR = OFF_GA + (size_t)R * 1024 * 2;
constexpr size_t OFF_C = OFF_GR + (size_t)R * 1024 * 2;
constexpr size_t OFF_XN = OFF_C;
constexpr size_t OFF_WIN = OFF_XN + (size_t)R * 1024 * 2;
constexpr size_t OFF_TAIL = OFF_WIN + (size_t)NIN * 1024 * 2;
constexpr size_t OFF_ATT = OFF_C;
constexpr size_t OFF_REC = OFF_ATT + (size_t)T * 512 * 2;
constexpr size_t OFF_MRG = OFF_LOGF;
constexpr size_t OFF_H2 = OFF_GA;
constexpr size_t OFF_H2B = OFF_RI;
constexpr size_t OFF_EDN = OFF_C;
constexpr size_t OFF_EUP = OFF_EDN + (size_t)16384 * 1024 * 2;
constexpr size_t OFF_QRY = OFF_QB;
constexpr size_t OFF_PIDX = OFF_MRG;
constexpr size_t OFF_PGATE = OFF_PIDX + (size_t)T * 128 * 4;
static_assert(OFF_EUP + (size_t)16384 * 1024 * 2 <= 256 * MiB, "ws overflow");
static_assert(OFF_TAIL <= 256 * MiB, "ws overflow");
static_assert(OFF_REC + (size_t)T * 512 * 2 <= OFF_TAIL, "overlay");
static_assert((size_t)T * 1024 * 4 <= (size_t)R * 1024 * 4, "h2 overlay");
static_assert(OFF_QRY + (size_t)T * 1024 * 2 <= OFF_LOGF, "qry overlay");
static_assert(OFF_PGATE + (size_t)T * 128 * 4 <= OFF_RI, "pidx overlay");

struct P {
    const float *x, *meta, *g_mix, *w_in, *b_in, *sinks, *lb_logits, *g_rec, *w_ua, *w_ur, *w_out, *g_ffn, *w_q, *keys, *edown, *eup, *g_fin;
    float* out;
    char* ws;
};
#define WS(type, off) ((type*)(p.ws + (off)))

__device__ __forceinline__ bf16_t f2bf(float f) {
    uint32_t u = __float_as_uint(f);
    u += 0x7FFFu + ((u >> 16) & 1u);
    return (bf16_t)(u >> 16);
}
__device__ __forceinline__ float bf2f(bf16_t h) { return __uint_as_float(((uint32_t)h) << 16); }
__device__ __forceinline__ float sigmoidf_(float v) { return 1.f / (1.f + __expf(-v)); }

__device__ __forceinline__ float wave_sum(float v) {
#pragma unroll
    for (int o = 32; o > 0; o >>= 1) v += __shfl_xor(v, o);
    return v;
}

__global__ void __launch_bounds__(256) k_transpose(const float* __restrict__ W, bf16_t* __restrict__ Wt, int K, int N, const float* __restrict__ rs) {
    __shared__ float tile[32][33];
    const int k0 = blockIdx.y * 32, n0 = blockIdx.x * 32, tx = threadIdx.x & 31, ty = threadIdx.x >> 5;
#pragma unroll
    for (int i = 0; i < 4; ++i) {
        const int k = k0 + ty + i * 8;
        tile[ty + i * 8][tx] = W[(size_t)k * N + n0 + tx] * (rs ? rs[k] : 1.f);
    }
    __syncthreads();
#pragma unroll
    for (int i = 0; i < 4; ++i) {
        const int n = n0 + ty + i * 8;
        Wt[(size_t)n * K + k0 + tx] = f2bf(tile[tx][ty + i * 8]);
    }
}

__global__ void __launch_bounds__(256) k_cvt(const float* __restrict__ src, bf16_t* __restrict__ dst, size_t n4) {
    for (size_t i = (size_t)blockIdx.x * 256 + threadIdx.x; i < n4; i += (size_t)gridDim.x * 256) {
        const float4 v = ((const float4*)src)[i];
        ushort4 o; o.x = f2bf(v.x); o.y = f2bf(v.y); o.z = f2bf(v.z); o.w = f2bf(v.w);
        ((ushort4*)dst)[i] = o;
    }
}

__global__ void __launch_bounds__(256) k_misc(P p) {
    const int gid = blockIdx.x * 256 + threadIdx.x;
    if (gid < LP * 8) {
        const int pp = gid >> 3, i = gid & 7;
        const double inv = pow(500000.0, -(double)i / 8.0);
        const double ang = (double)(pp - PADF) * inv;
        float2 cs; cs.x = (float)cos(ang); cs.y = (float)sin(ang);
        WS(float2, OFF_ROPE)[gid] = cs;
    }
    if (gid < 512) {
        const float l0 = p.lb_logits[gid], l1 = p.lb_logits[512 + gid];
        WS(float, OFF_LB)[gid] = 1.f / (1.f + expf(l1 - l0));
    }
}

__global__ void __launch_bounds__(256) k_rmsnorm_in(P p) {
    __shared__ float red[4];
    const int r = blockIdx.x, b = r / LP, pp = r % LP, tid = threadIdx.x;
    bf16_t* dst = WS(bf16_t, OFF_XN) + (size_t)r * DM;
    if (pp < PADF) { ((ushort4*)dst)[tid] = make_ushort4(0, 0, 0, 0); return; }
    const float* src = (pp < 128) ? (p.meta + (size_t)(pp - PADF) * DM) : (p.x + ((size_t)b * SEQ + (pp - 128)) * DM);
    const float4 v = ((const float4*)src)[tid];
    float ss = v.x * v.x + v.y * v.y + v.z * v.z + v.w * v.w;
    ss = wave_sum(ss);
    if ((tid & 63) == 0) red[tid >> 6] = ss;
    __syncthreads();
    ss = red[0] + red[1] + red[2] + red[3];
    const float rstd = rsqrtf(ss * (1.f / DM) + EPS);
    const float4 g = ((const float4*)p.g_mix)[tid];
    ushort4 o; o.x = f2bf(v.x * rstd * g.x); o.y = f2bf(v.y * rstd * g.y); o.z = f2bf(v.z * rstd * g.z); o.w = f2bf(v.w * rstd * g.w);
    ((ushort4*)dst)[tid] = o;
}

__device__ __forceinline__ void glds16(const void* src, void* lds) { __builtin_amdgcn_global_load_lds((const unsigned*)src, (unsigned*)lds, 16, 0, 0); }

__device__ __forceinline__ void gemm_kloop(const bf16_t* __restrict__ A, int lda, const bf16_t* __restrict__ Bt, int ldb, int K, int brow, int bcol,
                                           f32x4 (&acc)[4][4], char* SA, char* SB) {
    const int tid = threadIdx.x, wid = tid >> 6, lane = tid & 63, wr = wid >> 1, wc = wid & 1, fr = lane & 15, fq = lane >> 4;
    for (int kt = 0; kt < K / 32; ++kt) {
#pragma unroll
        for (int i = 0; i < 2; ++i) {
            const int b = tid * 16 + i * 4096, r = b >> 6, c = (b & 63) >> 1;
            glds16(A + (size_t)(brow + r) * lda + kt * 32 + c, SA + b);
            glds16(Bt + (size_t)(bcol + r) * ldb + kt * 32 + c, SB + b);
        }
        asm volatile("s_waitcnt vmcnt(0)" ::: "memory");
        __syncthreads();
        bf16x8 a[4], b[4];
#pragma unroll
        for (int m = 0; m < 4; ++m) a[m] = *(const bf16x8*)(SA + (wr * 64 + m * 16 + fr) * 64 + fq * 16);
#pragma unroll
        for (int n = 0; n < 4; ++n) b[n] = *(const bf16x8*)(SB + (wc * 64 + n * 16 + fr) * 64 + fq * 16);
#pragma unroll
        for (int m = 0; m < 4; ++m)
#pragma unroll
            for (int n = 0; n < 4; ++n) acc[m][n] = __builtin_amdgcn_mfma_f32_16x16x32_bf16(a[m], b[n], acc[m][n], 0, 0, 0);
        __syncthreads();
    }
}

__device__ __forceinline__ void zero_acc(f32x4 (&acc)[4][4]) {
#pragma unroll
    for (int m = 0; m < 4; ++m)
#pragma unroll
        for (int n = 0; n < 4; ++n) acc[m][n] = (f32x4){0.f, 0.f, 0.f, 0.f};
}

__global__ void __launch_bounds__(256) k_gemm_inproj(P p) {
    __shared__ __attribute__((aligned(16))) char shm[16384];
    const int tid = threadIdx.x, wid = tid >> 6, lane = tid & 63, wr = wid >> 1, wc = wid & 1, fr = lane & 15, fq = lane >> 4;
    constexpr int NT_N = NIN / 128, NT_M = R / 128;
    const float2* rope = WS(float2, OFF_ROPE);
    const float* lbv = WS(float, OFF_LB);
    for (int tile = blockIdx.x; tile < NT_N * NT_M; tile += gridDim.x) {
        const int pm = tile / NT_N, pn = tile % NT_N, brow = pm * 128, bcol = pn * 128;
        f32x4 acc[4][4]; zero_acc(acc);
        gemm_kloop(WS(bf16_t, OFF_XN), DM, WS(bf16_t, OFF_WIN), DM, DM, brow, bcol, acc, shm, shm + 8192);
#pragma unroll
        for (int m = 0; m < 4; ++m)
#pragma unroll
            for (int n = 0; n < 4; ++n) {
                const int col = bcol + wc * 64 + n * 16 + fr;
                const float bv = p.b_in[col];
#pragma unroll
                for (int j = 0; j < 4; ++j) {
                    const int row = brow + wr * 64 + m * 16 + fq * 4 + j;
                    const int pp = row % LP;
                    float v = acc[m][n][j] + bv;
                    if (bcol < 640) {
                        if (n == 0) {
                            const float other = __shfl_xor(v, 8);
                            const float2 cs = rope[pp * 8 + (fr & 7)];
                            v = (fr < 8) ? (v * cs.x - other * cs.y) : (v * cs.x + other * cs.y);
                        }
                        if (bcol < 512) WS(bf16_t, OFF_QB)[(size_t)row * 512 + col] = f2bf(v * 0.125f);
                        else WS(bf16_t, OFF_KB)[(size_t)row * 128 + (col - 512)] = f2bf(v);
                    } else if (bcol < 768) {
                        WS(bf16_t, OFF_VB)[(size_t)row * 128 + (col - 640)] = f2bf(v);
                    } else if (bcol < 1280) {
                        WS(bf16_t, OFF_RQ)[(size_t)row * 512 + (col - 768)] = f2bf(v);
                    } else if (bcol < 1792) {
                        const float lb = lbv[col - 1280];
                        const float f = lb + (1.f - lb) * sigmoidf_(v);
                        WS(float, OFF_LOGF)[(size_t)row * 512 + (col - 1280)] = (pp < PADF) ? 0.f : __logf(f);
                    } else if (bcol < 2304) {
                        WS(bf16_t, OFF_RI)[(size_t)row * 512 + (col - 1792)] = f2bf(v);
                    } else if (bcol < 2816) {
                        WS(bf16_t, OFF_RG)[(size_t)row * 512 + (col - 2304)] = f2bf(v * sigmoidf_(v));
                    } else if (bcol < 3840) {
                        WS(bf16_t, OFF_GA)[(size_t)row * 1024 + (col - 2816)] = f2bf(sigmoidf_(v));
                    } else {
                        WS(bf16_t, OFF_GR)[(size_t)row * 1024 + (col - 3840)] = f2bf(sigmoidf_(v));
                    }
                }
            }
    }
}

__global__ void __launch_bounds__(256) k_gemm_merge(P p) {
    __shared__ __attribute__((aligned(16))) char shm[16384];
    const int tid = threadIdx.x, wid = tid >> 6, lane = tid & 63, wr = wid >> 1, wc = wid & 1, fr = lane & 15, fq = lane >> 4;
    constexpr int NT_N = 8, NT_M = T / 128;
    for (int tile = blockIdx.x; tile < NT_N * NT_M; tile += gridDim.x) {
        const int pm = tile / NT_N, pn = tile % NT_N, brow = pm * 128, bcol = pn * 128;
        f32x4 acc[4][4], tt[4][4]; zero_acc(acc);
        gemm_kloop(WS(bf16_t, OFF_ATT), 512, WS(bf16_t, OFF_WUA), 512, 512, brow, bcol, acc, shm, shm + 8192);
#pragma unroll
        for (int m = 0; m < 4; ++m)
#pragma unroll
            for (int n = 0; n < 4; ++n) {
                const int col = bcol + wc * 64 + n * 16 + fr;
#pragma unroll
                for (int j = 0; j < 4; ++j) {
                    const int row = brow + wr * 64 + m * 16 + fq * 4 + j;
                    const int rr = row + 128 * (row / SEQ + 1);
                    tt[m][n][j] = acc[m][n][j] * bf2f(WS(bf16_t, OFF_GA)[(size_t)rr * 1024 + col]);
                }
            }
        zero_acc(acc);
        gemm_kloop(WS(bf16_t, OFF_REC), 512, WS(bf16_t, OFF_WUR), 512, 512, brow, bcol, acc, shm, shm + 8192);
#pragma unroll
        for (int m = 0; m < 4; ++m)
#pragma unroll
            for (int n = 0; n < 4; ++n) {
                const int col = bcol + wc * 64 + n * 16 + fr;
#pragma unroll
                for (int j = 0; j < 4; ++j) {
                    const int row = brow + wr * 64 + m * 16 + fq * 4 + j;
                    const int rr = row + 128 * (row / SEQ + 1);
                    const float v = tt[m][n][j] + acc[m][n][j] * bf2f(WS(bf16_t, OFF_GR)[(size_t)rr * 1024 + col]);
                    WS(bf16_t, OFF_MRG)[(size_t)row * 1024 + col] = f2bf(v);
                }
            }
    }
}

__global__ void __launch_bounds__(256) k_gemm_out(P p) {
    __shared__ __attribute__((aligned(16))) char shm[16384];
    const int tid = threadIdx.x, wid = tid >> 6, lane = tid & 63, wr = wid >> 1, wc = wid & 1, fr = lane & 15, fq = lane >> 4;
    constexpr int NT_N = 8, NT_M = T / 128;
    for (int tile = blockIdx.x; tile < NT_N * NT_M; tile += gridDim.x) {
        const int pm = tile / NT_N, pn = tile % NT_N, brow = pm * 128, bcol = pn * 128;
        f32x4 acc[4][4]; zero_acc(acc);
        gemm_kloop(WS(bf16_t, OFF_MRG), 1024, WS(bf16_t, OFF_WOUT), 1024, 1024, brow, bcol, acc, shm, shm + 8192);
#pragma unroll
        for (int m = 0; m < 4; ++m)
#pragma unroll
            for (int j = 0; j < 4; ++j) {
                const int row = brow + wr * 64 + m * 16 + fq * 4 + j;
                float ss = 0.f;
#pragma unroll
                for (int n = 0; n < 4; ++n) {
                    const int col = bcol + wc * 64 + n * 16 + fr;
                    const float v = acc[m][n][j] + p.x[(size_t)row * DM + col];
                    WS(float, OFF_H2)[(size_t)row * DM + col] = v;
                    WS(bf16_t, OFF_H2B)[(size_t)row * DM + col] = f2bf(v);
                    ss += v * v;
                }
                ss += __shfl_xor(ss, 1); ss += __shfl_xor(ss, 2); ss += __shfl_xor(ss, 4); ss += __shfl_xor(ss, 8);
                if (fr == 0) WS(float, OFF_SSQ)[(size_t)(pn * 2 + wc) * T + row] = ss;
            }
    }
}

__device__ __forceinline__ float row_rstd(const P& p, int row) {
    float s = 0.f;
#pragma unroll
    for (int i = 0; i < 16; ++i) s += WS(float, OFF_SSQ)[(size_t)i * T + row];
    return rsqrtf(s * (1.f / DM) + EPS);
}

__global__ void __launch_bounds__(256) k_gemm_qry(P p) {
    __shared__ __attribute__((aligned(16))) char shm[16384];
    const int tid = threadIdx.x, wid = tid >> 6, lane = tid & 63, wr = wid >> 1, wc = wid & 1, fr = lane & 15, fq = lane >> 4;
    constexpr int NT_N = 8, NT_M = T / 128;
    for (int tile = blockIdx.x; tile < NT_N * NT_M; tile += gridDim.x) {
        const int pm = tile / NT_N, pn = tile % NT_N, brow = pm * 128, bcol = pn * 128;
        f32x4 acc[4][4]; zero_acc(acc);
        gemm_kloop(WS(bf16_t, OFF_H2B), 1024, WS(bf16_t, OFF_WQ), 1024, 1024, brow, bcol, acc, shm, shm + 8192);
#pragma unroll
        for (int m = 0; m < 4; ++m)
#pragma unroll
            for (int j = 0; j < 4; ++j) {
                const int row = brow + wr * 64 + m * 16 + fq * 4 + j;
                const float rstd = row_rstd(p, row);
#pragma unroll
                for (int n = 0; n < 4; ++n) {
                    const int col = bcol + wc * 64 + n * 16 + fr;
                    WS(bf16_t, OFF_QRY)[(size_t)row * DM + col] = f2bf(acc[m][n][j] * rstd);
                }
            }
    }
}

__global__ void __launch_bounds__(256) k_attn_simple(P p) {
    const int gid = blockIdx.x * 256 + threadIdx.x;
    const int hq = gid / T, t = gid % T, b = t / SEQ, s = t % SEQ, pq = 128 + s, kvh = hq >> 2;
    const bf16_t* qp = WS(bf16_t, OFF_QB) + ((size_t)b * LP + pq) * 512 + hq * 64;
    float q[64], o[64];
#pragma unroll
    for (int d = 0; d < 64; ++d) { q[d] = bf2f(qp[d]); o[d] = 0.f; }
    float m = p.sinks[hq], l = 1.f;
    const bf16_t* kbase = WS(bf16_t, OFF_KB) + (size_t)b * LP * 128 + kvh * 64;
    const bf16_t* vbase = WS(bf16_t, OFF_VB) + (size_t)b * LP * 128 + kvh * 64;
    const int lo = (pq - 127 > 128) ? (pq - 127) : 128;
    const int nkeys = 16 + (pq - lo + 1);
    for (int i = 0; i < nkeys; ++i) {
        const int pk = (i < 16) ? (PADF + i) : (lo + i - 16);
        const bf16_t* kp = kbase + (size_t)pk * 128;
        const bf16_t* vp = vbase + (size_t)pk * 128;
        float sc = 0.f;
#pragma unroll
        for (int d = 0; d < 64; ++d) sc += q[d] * bf2f(kp[d]);
        const float mn = fmaxf(m, sc), a = __expf(m - mn), e = __expf(sc - mn);
        l = l * a + e;
#pragma unroll
        for (int d = 0; d < 64; ++d) o[d] = o[d] * a + e * bf2f(vp[d]);
        m = mn;
    }
    const float inv = 1.f / l;
    bf16_t* op = WS(bf16_t, OFF_ATT) + (size_t)t * 512 + hq * 64;
#pragma unroll
    for (int d = 0; d < 64; ++d) op[d] = f2bf(o[d] * inv);
}

__global__ void __launch_bounds__(128) k_hgrn_simple(P p) {
    __shared__ float fs[8][128], ks[8][128], qs[8][128], os[8][128], red[8][2];
    const int b = blockIdx.x >> 2, h = blockIdx.x & 3, e = threadIdx.x;
    float S[128];
#pragma unroll
    for (int d = 0; d < 128; ++d) S[d] = 0.f;
    const float g = p.g_rec[h * 128 + e];
    for (int p0 = PADF; p0 < LP; p0 += 8) {
        float v[8];
#pragma unroll
        for (int i = 0; i < 8; ++i) {
            const size_t r = (size_t)b * LP + p0 + i;
            const float lf = WS(float, OFF_LOGF)[r * 512 + h * 128 + e];
            const float f = __expf(lf);
            fs[i][e] = f; ks[i][e] = 1.f - f;
            qs[i][e] = bf2f(WS(bf16_t, OFF_RQ)[r * 512 + h * 128 + e]);
            v[i] = bf2f(WS(bf16_t, OFF_RI)[r * 512 + h * 128 + e]);
        }
        __syncthreads();
#pragma unroll
        for (int i = 0; i < 8; ++i) {
            float o = 0.f;
#pragma unroll
            for (int d = 0; d < 128; ++d) { S[d] = fs[i][d] * S[d] + ks[i][d] * v[i]; o += qs[i][d] * S[d]; }
            os[i][e] = o;
            const float ss = wave_sum(o * o);
            if ((e & 63) == 0) red[i][e >> 6] = ss;
        }
        __syncthreads();
        if (p0 >= 128) {
#pragma unroll
            for (int i = 0; i < 8; ++i) {
                const size_t r = (size_t)b * LP + p0 + i;
                const size_t t = (size_t)b * SEQ + (p0 + i - 128);
                const float rstd = rsqrtf((red[i][0] + red[i][1]) * (1.f / 128.f) + EPS);
                const float val = os[i][e] * rstd * g * bf2f(WS(bf16_t, OFF_RG)[r * 512 + h * 128 + e]);
                WS(bf16_t, OFF_REC)[t * 512 + h * 128 + e] = f2bf(val);
            }
        }
        __syncthreads();
    }
}

__global__ void __launch_bounds__(256) k_peer_topk_simple(P p) {
    const int t = blockIdx.x * 256 + threadIdx.x, h = blockIdx.y;
    const bf16_t* qp = WS(bf16_t, OFF_QRY) + (size_t)t * DM + h * 128;
    float tv[2][16]; int ti[2][16];
#pragma unroll
    for (int pp = 0; pp < 2; ++pp) {
        float q[64];
#pragma unroll
        for (int d = 0; d < 64; ++d) q[d] = bf2f(qp[pp * 64 + d]);
#pragma unroll
        for (int i = 0; i < 16; ++i) { tv[pp][i] = -3.0e38f; ti[pp][i] = 0; }
        const bf16_t* kp = WS(bf16_t, OFF_KEYS) + (size_t)(h * 2 + pp) * 128 * 64;
        for (int n = 0; n < 128; ++n) {
            float sc = 0.f;
#pragma unroll
            for (int d = 0; d < 64; ++d) sc += q[d] * bf2f(kp[n * 64 + d]);
            float xv = sc; int xi = n;
#pragma unroll
            for (int i = 0; i < 16; ++i) {
                if (xv > tv[pp][i]) { const float tf = tv[pp][i]; const int tn = ti[pp][i]; tv[pp][i] = xv; ti[pp][i] = xi; xv = tf; xi = tn; }
            }
        }
    }
    float bv[16]; int bi[16];
#pragma unroll
    for (int i = 0; i < 16; ++i) { bv[i] = -3.0e38f; bi[i] = 0; }
#pragma unroll
    for (int i = 0; i < 16; ++i)
#pragma unroll
        for (int j = 0; j < 16; ++j) {
            if ((i + 1) * (j + 1) <= 16) {
                float xv = tv[0][i] + tv[1][j]; int xi = ti[0][i] * 128 + ti[1][j];
#pragma unroll
                for (int k = 0; k < 16; ++k) {
                    if (xv > bv[k]) { const float tf = bv[k]; const int tn = bi[k]; bv[k] = xv; bi[k] = xi; xv = tf; xi = tn; }
                }
            }
        }
    float se = 0.f, ev[16];
#pragma unroll
    for (int k = 0; k < 16; ++k) { ev[k] = __expf(bv[k] - bv[0]); se += ev[k]; }
    const float inv = 1.f / se;
#pragma unroll
    for (int k = 0; k < 16; ++k) {
        WS(int, OFF_PIDX)[(size_t)t * 128 + h * 16 + k] = bi[k];
        WS(float, OFF_PGATE)[(size_t)t * 128 + h * 16 + k] = ev[k] * inv;
    }
}

__global__ void __launch_bounds__(256) k_peer_expert(P p) {
    __shared__ float act[128];
    __shared__ float red[4];
    const int t = blockIdx.x, tid = threadIdx.x, wid = tid >> 6, lane = tid & 63;
    const float rstd = row_rstd(p, t);
    const float* h2 = WS(float, OFF_H2) + (size_t)t * DM;
    float xn[16];
#pragma unroll
    for (int i = 0; i < 4; ++i) {
        const float4 v = ((const float4*)h2)[lane * 4 + i];
        const float4 g = ((const float4*)p.g_ffn)[lane * 4 + i];
        xn[4 * i + 0] = v.x * rstd * g.x; xn[4 * i + 1] = v.y * rstd * g.y; xn[4 * i + 2] = v.z * rstd * g.z; xn[4 * i + 3] = v.w * rstd * g.w;
    }
    const int* idx = WS(int, OFF_PIDX) + (size_t)t * 128;
    const float* gate = WS(float, OFF_PGATE) + (size_t)t * 128;
    const bf16_t* edn = WS(bf16_t, OFF_EDN);
    const bf16_t* eup = WS(bf16_t, OFF_EUP);
    for (int e = wid; e < 128; e += 4) {
        const bf16_t* row = edn + (size_t)idx[e] * DM + lane * 16;
        const uint4 a = ((const uint4*)row)[0], c = ((const uint4*)row)[1];
        const uint32_t w[8] = {a.x, a.y, a.z, a.w, c.x, c.y, c.z, c.w};
        float s = 0.f;
#pragma unroll
        for (int i = 0; i < 8; ++i) s += xn[2 * i] * __uint_as_float(w[i] << 16) + xn[2 * i + 1] * __uint_as_float(w[i] & 0xFFFF0000u);
        s = wave_sum(s);
        if (lane == 0) act[e] = 0.5f * s * (1.f + erff(s * 0.70710678118654752f)) * gate[e];
    }
    __syncthreads();
    float y0 = 0.f, y1 = 0.f, y2 = 0.f, y3 = 0.f;
    for (int e = 0; e < 128; ++e) {
        const float a = act[e];
        const uint2 w = *(const uint2*)(eup + (size_t)idx[e] * DM + tid * 4);
        y0 += a * __uint_as_float(w.x << 16); y1 += a * __uint_as_float(w.x & 0xFFFF0000u);
        y2 += a * __uint_as_float(w.y << 16); y3 += a * __uint_as_float(w.y & 0xFFFF0000u);
    }
    const float4 hv = ((const float4*)h2)[tid];
    const float o0 = hv.x + y0, o1 = hv.y + y1, o2 = hv.z + y2, o3 = hv.w + y3;
    float ss = wave_sum(o0 * o0 + o1 * o1 + o2 * o2 + o3 * o3);
    if (lane == 0) red[wid] = ss;
    __syncthreads();
    ss = red[0] + red[1] + red[2] + red[3];
    const float rs = rsqrtf(ss * (1.f / DM) + EPS);
    const float4 g = ((const float4*)p.g_fin)[tid];
    float4 ov; ov.x = o0 * rs * g.x; ov.y = o1 * rs * g.y; ov.z = o2 * rs * g.z; ov.w = o3 * rs * g.w;
    ((float4*)(p.out + (size_t)t * DM))[tid] = ov;
}

extern "C" void kernel_launch(void* const* d_in, const int* in_sizes, int n_in, void* d_out, int out_size, void* d_ws, size_t ws_size, hipStream_t stream) {
    P p{};
    p.x = (const float*)d_in[0]; p.meta = (const float*)d_in[1]; p.g_mix = (const float*)d_in[2]; p.w_in = (const float*)d_in[3];
    p.b_in = (const float*)d_in[4]; p.sinks = (const float*)d_in[5]; p.lb_logits = (const float*)d_in[6]; p.g_rec = (const float*)d_in[7];
    p.w_ua = (const float*)d_in[8]; p.w_ur = (const float*)d_in[9]; p.w_out = (const float*)d_in[10]; p.g_ffn = (const float*)d_in[11];
    p.w_q = (const float*)d_in[12]; p.keys = (const float*)d_in[13]; p.edown = (const float*)d_in[14]; p.eup = (const float*)d_in[15];
    p.g_fin = (const float*)d_in[16];
    p.out = (float*)d_out; p.ws = (char*)d_ws;
    char* ws = (char*)d_ws;
    k_transpose<<<dim3(NIN / 32, 1024 / 32), 256, 0, stream>>>(p.w_in, (bf16_t*)(ws + OFF_WIN), 1024, NIN, nullptr);
    k_transpose<<<dim3(1024 / 32, 512 / 32), 256, 0, stream>>>(p.w_ua, (bf16_t*)(ws + OFF_WUA), 512, 1024, nullptr);
    k_transpose<<<dim3(1024 / 32, 512 / 32), 256, 0, stream>>>(p.w_ur, (bf16_t*)(ws + OFF_WUR), 512, 1024, nullptr);
    k_transpose<<<dim3(1024 / 32, 1024 / 32), 256, 0, stream>>>(p.w_out, (bf16_t*)(ws + OFF_WOUT), 1024, 1024, nullptr);
    k_transpose<<<dim3(1024 / 32, 1024 / 32), 256, 0, stream>>>(p.w_q, (bf16_t*)(ws + OFF_WQ), 1024, 1024, p.g_ffn);
    k_cvt<<<128, 256, 0, stream>>>(p.keys, (bf16_t*)(ws + OFF_KEYS), (size_t)16 * 128 * 64 / 4);
    k_misc<<<(LP * 8 + 255) / 256, 256, 0, stream>>>(p);
    k_rmsnorm_in<<<R, 256, 0, stream>>>(p);
    k_gemm_inproj<<<2048, 256, 0, stream>>>(p);
    k_attn_simple<<<T * 8 / 256, 256, 0, stream>>>(p);
    k_hgrn_simple<<<16, 128, 0, stream>>>(p);
    k_gemm_merge<<<1024, 256, 0, stream>>>(p);
    k_gemm_out<<<1024, 256, 0, stream>>>(p);
    k_cvt<<<2048, 256, 0, stream>>>(p.edown, (bf16_t*)(ws + OFF_EDN), (size_t)16384 * 1024 / 4);
    k_cvt<<<2048, 256, 0, stream>>>(p.eup, (bf16_t*)(ws + OFF_EUP), (size_t)16384 * 1024 / 4);
    k_gemm_qry<<<1024, 256, 0, stream>>>(p);
    k_peer_topk_simple<<<dim3(T / 256, 8), 256, 0, stream>>>(p);
    k_peer_expert<<<T, 256, 0, stream>>>(p);
}
```

```cpp
#include <hip/hip_runtime.h>
#include <hip/hip_cooperative_groups.h>
#include <stdint.h>
#include <stdio.h>
namespace cg = cooperative_groups;

typedef unsigned short bf16_t;
typedef short bf16x8 __attribute__((ext_vector_type(8)));
typedef float f32x4 __attribute__((ext_vector_type(4)));

constexpr int NB = 4, SEQ = 4096, DM = 1024, LP = 4224, PADF = 112;
constexpr int R = NB * LP;
constexpr int T = NB * SEQ;
constexpr int NIN = 4864;
constexpr float EPS = 1e-6f;

constexpr size_t MiB = 1024 * 1024;
constexpr size_t OFF_WUA = 0;
constexpr size_t OFF_WUR = 1 * MiB;
constexpr size_t OFF_WOUT = 2 * MiB;
constexpr size_t OFF_WQ = 4 * MiB;
constexpr size_t OFF_KEYS = 6 * MiB;
constexpr size_t OFF_ROPE = 6 * MiB + 256 * 1024;
constexpr size_t OFF_LB = OFF_ROPE + 272 * 1024;
constexpr size_t OFF_SSQ = 7 * MiB;
constexpr size_t OFF_B = 8 * MiB;
constexpr size_t OFF_QB = OFF_B;
constexpr size_t OFF_KB = OFF_QB + (size_t)R * 512 * 2;
constexpr size_t OFF_VB = OFF_KB + (size_t)R * 128 * 2;
constexpr size_t OFF_RQ = OFF_VB + (size_t)R * 128 * 2;
constexpr size_t OFF_LOGF = OFF_RQ + (size_t)R * 512 * 2;
constexpr size_t OFF_RI = OFF_LOGF + (size_t)R * 512 * 4;
constexpr size_t OFF_RG = OFF_RI + (size_t)R * 512 * 2;
constexpr size_t OFF_GA = OFF_RG + (size_t)R * 512 * 2;
constexpr size_t OFF_GR = OFF_GA + (size_t)R * 1024 * 2;
constexpr size_t OFF_C = OFF_GR + (size_t)R * 1024 * 2;
constexpr size_t OFF_XN = OFF_C;
constexpr size_t OFF_WIN = OFF_XN + (size_t)R * 1024 * 2;
constexpr size_t OFF_TAIL = OFF_WIN + (size_t)NIN * 1024 * 2;
constexpr size_t OFF_ATT = OFF_C;
constexpr size_t OFF_REC = OFF_ATT + (size_t)T * 512 * 2;
constexpr size_t OFF_MRG = OFF_LOGF;
constexpr size_t OFF_H2 = OFF_GA;
constexpr size_t OFF_H2B = OFF_RI;
constexpr size_t OFF_EDN = OFF_C;
constexpr size_t OFF_EUP = OFF_EDN + (size_t)16384 * 1024 * 2;
constexpr size_t OFF_QRY = OFF_QB;
constexpr size_t OFF_PIDX = OFF_MRG;
constexpr size_t OFF_PGATE = OFF_PIDX + (size_t)T * 128 * 4;
static_assert(OFF_EUP + (size_t)16384 * 1024 * 2 <= 256 * MiB, "ws overflow");
static_assert(OFF_TAIL <= 256 * MiB, "ws overflow");
static_assert(OFF_REC + (size_t)T * 512 * 2 <= OFF_TAIL, "overlay");
static_assert((size_t)T * 1024 * 4 <= (size_t)R * 1024 * 4, "h2 overlay");
static_assert(OFF_QRY + (size_t)T * 1024 * 2 <= OFF_LOGF, "qry overlay");
static_assert(OFF_PGATE + (size_t)T * 128 * 4 <= OFF_RI, "pidx overlay");

struct P {
    const float *x, *meta, *g_mix, *w_in, *b_in, *sinks, *lb_logits, *g_rec, *w_ua, *w_ur, *w_out, *g_ffn, *w_q, *keys, *edown, *eup, *g_fin;
    float* out;
    char* ws;
};
#define WS(type, off) ((type*)(p.ws + (off)))

__device__ __forceinline__ bf16_t f2bf(float f) {
    uint32_t u = __float_as_uint(f);
    u += 0x7FFFu + ((u >> 16) & 1u);
    return (bf16_t)(u >> 16);
}
__device__ __forceinline__ float bf2f(bf16_t h) { return __uint_as_float(((uint32_t)h) << 16); }
__device__ __forceinline__ float sigmoidf_(float v) { return 1.f / (1.f + __expf(-v)); }

__device__ __forceinline__ float wave_sum(float v) {
#pragma unroll
    for (int o = 32; o > 0; o >>= 1) v += __shfl_xor(v, o);
    return v;
}

__device__ __forceinline__ void d_transpose(const float* __restrict__ W, bf16_t* __restrict__ Wt, int K, int N, const float* __restrict__ rs, int unit, char* shm) {
    float (*tile)[33] = (float (*)[33])shm;
    const int ntn = N / 32;
    const int k0 = (unit / ntn) * 32, n0 = (unit % ntn) * 32, tx = threadIdx.x & 31, ty = threadIdx.x >> 5;
#pragma unroll
    for (int i = 0; i < 4; ++i) {
        const int k = k0 + ty + i * 8;
        tile[ty + i * 8][tx] = W[(size_t)k * N + n0 + tx] * (rs ? rs[k] : 1.f);
    }
    __syncthreads();
#pragma unroll
    for (int i = 0; i < 4; ++i) {
        const int n = n0 + ty + i * 8;
        Wt[(size_t)n * K + k0 + tx] = f2bf(tile[tx][ty + i * 8]);
    }
    __syncthreads();
}

__device__ __forceinline__ void d_cvt(const float* __restrict__ src, bf16_t* __restrict__ dst, size_t n4, int vblk, int nvblk) {
    for (size_t i = (size_t)vblk * 256 + threadIdx.x; i < n4; i += (size_t)nvblk * 256) {
        const float4 v = ((const float4*)src)[i];
        ushort4 o; o.x = f2bf(v.x); o.y = f2bf(v.y); o.z = f2bf(v.z); o.w = f2bf(v.w);
        ((ushort4*)dst)[i] = o;
    }
}

__device__ __forceinline__ void d_misc(const P& p, int unit) {
    const int gid = unit * 256 + threadIdx.x;
    if (gid < LP * 8) {
        const int pp = gid >> 3, i = gid & 7;
        const double inv = pow(500000.0, -(double)i / 8.0);
        const double ang = (double)(pp - PADF) * inv;
        float2 cs; cs.x = (float)cos(ang); cs.y = (float)sin(ang);
        WS(float2, OFF_ROPE)[gid] = cs;
    }
    if (gid < 512) {
        const float l0 = p.lb_logits[gid], l1 = p.lb_logits[512 + gid];
        WS(float, OFF_LB)[gid] = 1.f / (1.f + expf(l1 - l0));
    }
}

__device__ __forceinline__ void d_rmsnorm_in(const P& p, int r, char* shm) {
    float* red = (float*)shm;
    const int b = r / LP, pp = r % LP, tid = threadIdx.x;
    bf16_t* dst = WS(bf16_t, OFF_XN) + (size_t)r * DM;
    if (pp < PADF) { ((ushort4*)dst)[tid] = make_ushort4(0, 0, 0, 0); return; }
    const float* src = (pp < 128) ? (p.meta + (size_t)(pp - PADF) * DM) : (p.x + ((size_t)b * SEQ + (pp - 128)) * DM);
    const float4 v = ((const float4*)src)[tid];
    float ss = v.x * v.x + v.y * v.y + v.z * v.z + v.w * v.w;
    ss = wave_sum(ss);
    if ((tid & 63) == 0) red[tid >> 6] = ss;
    __syncthreads();
    ss = red[0] + red[1] + red[2] + red[3];
    const float rstd = rsqrtf(ss * (1.f / DM) + EPS);
    const float4 g = ((const float4*)p.g_mix)[tid];
    ushort4 o; o.x = f2bf(v.x * rstd * g.x); o.y = f2bf(v.y * rstd * g.y); o.z = f2bf(v.z * rstd * g.z); o.w = f2bf(v.w * rstd * g.w);
    ((ushort4*)dst)[tid] = o;
    __syncthreads();
}

__device__ __forceinline__ void glds16(const void* src, void* lds) { __builtin_amdgcn_global_load_lds((const unsigned*)src, (unsigned*)lds, 16, 0, 0); }

__device__ __forceinline__ void gemm_kloop(const bf16_t* __restrict__ A, int lda, const bf16_t* __restrict__ Bt, int ldb, int K, int brow, int bcol,
                                           f32x4 (&acc)[4][4], char* SA, char* SB) {
    const int tid = threadIdx.x, wid = tid >> 6, lane = tid & 63, wr = wid >> 1, wc = wid & 1, fr = lane & 15, fq = lane >> 4;
    for (int kt = 0; kt < K / 32; ++kt) {
#pragma unroll
        for (int i = 0; i < 2; ++i) {
            const int b = tid * 16 + i * 4096, r = b >> 6, c = (b & 63) >> 1;
            glds16(A + (size_t)(brow + r) * lda + kt * 32 + c, SA + b);
            glds16(Bt + (size_t)(bcol + r) * ldb + kt * 32 + c, SB + b);
        }
        asm volatile("s_waitcnt vmcnt(0)" ::: "memory");
        __syncthreads();
        bf16x8 a[4], b[4];
#pragma unroll
        for (int m = 0; m < 4; ++m) a[m] = *(const bf16x8*)(SA + (wr * 64 + m * 16 + fr) * 64 + fq * 16);
#pragma unroll
        for (int n = 0; n < 4; ++n) b[n] = *(const bf16x8*)(SB + (wc * 64 + n * 16 + fr) * 64 + fq * 16);
#pragma unroll
        for (int m = 0; m < 4; ++m)
#pragma unroll
            for (int n = 0; n < 4; ++n) acc[m][n] = __builtin_amdgcn_mfma_f32_16x16x32_bf16(a[m], b[n], acc[m][n], 0, 0, 0);
        __syncthreads();
    }
}

__device__ __forceinline__ void zero_acc(f32x4 (&acc)[4][4]) {
#pragma unroll
    for (int m = 0; m < 4; ++m)
#pragma unroll
        for (int n = 0; n < 4; ++n) acc[m][n] = (f32x4){0.f, 0.f, 0.f, 0.f};
}

__device__ __forceinline__ void ph_gemm_inproj(const P& p, char* shm) {
    const int tid = threadIdx.x, wid = tid >> 6, lane = tid & 63, wr = wid >> 1, wc = wid & 1, fr = lane & 15, fq = lane >> 4;
    constexpr int NT_N = NIN / 128, NT_M = R / 128;
    const float2* rope = WS(float2, OFF_ROPE);
    const float* lbv = WS(float, OFF_LB);
    for (int tile = blockIdx.x; tile < NT_N * NT_M; tile += gridDim.x) {
        const int pm = tile / NT_N, pn = tile % NT_N, brow_ = pm * 128, bcol_ = pn * 128;
        f32x4 acc[4][4]; zero_acc(acc);
        int brow = brow_, bcol = bcol_;
        gemm_kloop(WS(bf16_t, OFF_XN), DM, WS(bf16_t, OFF_WIN), DM, DM, brow, bcol, acc, shm, shm + 8192);
        asm volatile("" : "+s"(brow), "+s"(bcol));
#pragma unroll
        for (int m = 0; m < 4; ++m)
#pragma unroll
            for (int n = 0; n < 4; ++n) {
                const int col = bcol + wc * 64 + n * 16 + fr;
                const float bv = p.b_in[col];
#pragma unroll
                for (int j = 0; j < 4; ++j) {
                    const int row = brow + wr * 64 + m * 16 + fq * 4 + j;
                    const int pp = row % LP;
                    float v = acc[m][n][j] + bv;
                    if (bcol < 640) {
                        if (n == 0) {
                            const float other = __shfl_xor(v, 8);
                            const float2 cs = rope[pp * 8 + (fr & 7)];
                            v = (fr < 8) ? (v * cs.x - other * cs.y) : (v * cs.x + other * cs.y);
                        }
                        if (bcol < 512) WS(bf16_t, OFF_QB)[(size_t)row * 512 + col] = f2bf(v * 0.125f);
                        else WS(bf16_t, OFF_KB)[(size_t)row * 128 + (col - 512)] = f2bf(v);
                    } else if (bcol < 768) {
                        WS(bf16_t, OFF_VB)[(size_t)row * 128 + (col - 640)] = f2bf(v);
                    } else if (bcol < 1280) {
                        WS(bf16_t, OFF_RQ)[(size_t)row * 512 + (col - 768)] = f2bf(v);
                    } else if (bcol < 1792) {
                        const float lb = lbv[col - 1280];
                        const float f = lb + (1.f - lb) * sigmoidf_(v);
                        WS(float, OFF_LOGF)[(size_t)row * 512 + (col - 1280)] = (pp < PADF) ? 0.f : __logf(f);
                    } else if (bcol < 2304) {
                        WS(bf16_t, OFF_RI)[(size_t)row * 512 + (col - 1792)] = f2bf(v);
                    } else if (bcol < 2816) {
                        WS(bf16_t, OFF_RG)[(size_t)row * 512 + (col - 2304)] = f2bf(v * sigmoidf_(v));
                    } else if (bcol < 3840) {
                        WS(bf16_t, OFF_GA)[(size_t)row * 1024 + (col - 2816)] = f2bf(sigmoidf_(v));
                    } else {
                        WS(bf16_t, OFF_GR)[(size_t)row * 1024 + (col - 3840)] = f2bf(sigmoidf_(v));
                    }
                }
            }
    }
}

__device__ __forceinline__ void ph_gemm_merge(const P& p, char* shm) {
    const int tid = threadIdx.x, wid = tid >> 6, lane = tid & 63, wr = wid >> 1, wc = wid & 1, fr = lane & 15, fq = lane >> 4;
    constexpr int NT_N = 8, NT_M = T / 128;
    for (int tile = blockIdx.x; tile < NT_N * NT_M; tile += gridDim.x) {
        const int pm = tile / NT_N, pn = tile % NT_N, brow = pm * 128, bcol = pn * 128;
        f32x4 acc[4][4];
#pragma unroll 1
        for (int pass = 0; pass < 2; ++pass) {
            zero_acc(acc);
            gemm_kloop(WS(bf16_t, pass ? OFF_REC : OFF_ATT), 512, WS(bf16_t, pass ? OFF_WUR : OFF_WUA), 512, 512, brow, bcol, acc, shm, shm + 8192);
            int erow = brow, ecol = bcol;
            asm volatile("" : "+s"(erow), "+s"(ecol));
            const bf16_t* gate = WS(bf16_t, pass ? OFF_GR : OFF_GA) + (size_t)(128 * (erow / SEQ + 1)) * 1024;
#pragma unroll
            for (int m = 0; m < 4; ++m)
#pragma unroll
                for (int n = 0; n < 4; ++n) {
                    const int col = ecol + wc * 64 + n * 16 + fr;
#pragma unroll
                    for (int j = 0; j < 4; ++j) {
                        const int row = erow + wr * 64 + m * 16 + fq * 4 + j;
                        bf16_t* dst = WS(bf16_t, OFF_MRG) + (size_t)row * 1024 + col;
                        float v = acc[m][n][j] * bf2f(gate[(size_t)row * 1024 + col]);
                        if (pass) v += bf2f(*dst);
                        *dst = f2bf(v);
                    }
                    asm volatile("" ::: "memory");
                }
        }
    }
}

__device__ __forceinline__ void ph_gemm_out(const P& p, char* shm) {
    const int tid = threadIdx.x, wid = tid >> 6, lane = tid & 63, wr = wid >> 1, wc = wid & 1, fr = lane & 15, fq = lane >> 4;
    constexpr int NT_N = 8, NT_M = T / 128;
    for (int tile = blockIdx.x; tile < NT_N * NT_M; tile += gridDim.x) {
        const int pm = tile / NT_N, pn = tile % NT_N, brow_ = pm * 128, bcol_ = pn * 128;
        f32x4 acc[4][4]; zero_acc(acc);
        int brow = brow_, bcol = bcol_;
        gemm_kloop(WS(bf16_t, OFF_MRG), 1024, WS(bf16_t, OFF_WOUT), 1024, 1024, brow, bcol, acc, shm, shm + 8192);
        asm volatile("" : "+s"(brow), "+s"(bcol));
#pragma unroll
        for (int m = 0; m < 4; ++m)
#pragma unroll
            for (int j = 0; j < 4; ++j) {
                const int row = brow + wr * 64 + m * 16 + fq * 4 + j;
                float ss = 0.f;
#pragma unroll
                for (int n = 0; n < 4; ++n) {
                    const int col = bcol + wc * 64 + n * 16 + fr;
                    const float v = acc[m][n][j] + p.x[(size_t)row * DM + col];
                    WS(float, OFF_H2)[(size_t)row * DM + col] = v;
                    WS(bf16_t, OFF_H2B)[(size_t)row * DM + col] = f2bf(v);
                    ss += v * v;
                }
                ss += __shfl_xor(ss, 1); ss += __shfl_xor(ss, 2); ss += __shfl_xor(ss, 4); ss += __shfl_xor(ss, 8);
                if (fr == 0) WS(float, OFF_SSQ)[(size_t)(pn * 2 + wc) * T + row] = ss;
            }
    }
}

__device__ __forceinline__ float row_rstd(const P& p, int row) {
    float s = 0.f;
#pragma unroll
    for (int i = 0; i < 16; ++i) s += WS(float, OFF_SSQ)[(size_t)i * T + row];
    return rsqrtf(s * (1.f / DM) + EPS);
}

__device__ __forceinline__ void ph_gemm_qry(const P& p, char* shm) {
    const int tid = threadIdx.x, wid = tid >> 6, lane = tid & 63, wr = wid >> 1, wc = wid & 1, fr = lane & 15, fq = lane >> 4;
    constexpr int NT_N = 8, NT_M = T / 128;
    for (int tile = blockIdx.x; tile < NT_N * NT_M; tile += gridDim.x) {
        const int pm = tile / NT_N, pn = tile % NT_N, brow_ = pm * 128, bcol_ = pn * 128;
        f32x4 acc[4][4]; zero_acc(acc);
        int brow = brow_, bcol = bcol_;
        gemm_kloop(WS(bf16_t, OFF_H2B), 1024, WS(bf16_t, OFF_WQ), 1024, 1024, brow, bcol, acc, shm, shm + 8192);
        asm volatile("" : "+s"(brow), "+s"(bcol));
#pragma unroll
        for (int m = 0; m < 4; ++m)
#pragma unroll
            for (int j = 0; j < 4; ++j) {
                const int row = brow + wr * 64 + m * 16 + fq * 4 + j;
                const float rstd = row_rstd(p, row);
#pragma unroll
                for (int n = 0; n < 4; ++n) {
                    const int col = bcol + wc * 64 + n * 16 + fr;
                    WS(bf16_t, OFF_QRY)[(size_t)row * DM + col] = f2bf(acc[m][n][j] * rstd);
                }
            }
    }
}

__device__ __forceinline__ void d_attn_simple(const P& p, int unit) {
    const int gid = unit * 256 + threadIdx.x;
    const int hq = gid / T, t = gid % T, b = t / SEQ, s = t % SEQ, pq = 128 + s, kvh = hq >> 2;
    const bf16_t* qp = WS(bf16_t, OFF_QB) + ((size_t)b * LP + pq) * 512 + hq * 64;
    float q[64], o[64];
#pragma unroll
    for (int d = 0; d < 64; ++d) { q[d] = bf2f(qp[d]); o[d] = 0.f; }
    float m = p.sinks[hq], l = 1.f;
    const bf16_t* kbase = WS(bf16_t, OFF_KB) + (size_t)b * LP * 128 + kvh * 64;
    const bf16_t* vbase = WS(bf16_t, OFF_VB) + (size_t)b * LP * 128 + kvh * 64;
    const int lo = (pq - 127 > 128) ? (pq - 127) : 128;
    const int nkeys = 16 + (pq - lo + 1);
    for (int i = 0; i < nkeys; ++i) {
        const int pk = (i < 16) ? (PADF + i) : (lo + i - 16);
        const bf16_t* kp = kbase + (size_t)pk * 128;
        const bf16_t* vp = vbase + (size_t)pk * 128;
        float sc = 0.f;
#pragma unroll
        for (int d = 0; d < 64; ++d) sc += q[d] * bf2f(kp[d]);
        const float mn = fmaxf(m, sc), a = __expf(m - mn), e = __expf(sc - mn);
        l = l * a + e;
#pragma unroll
        for (int d = 0; d < 64; ++d) o[d] = o[d] * a + e * bf2f(vp[d]);
        m = mn;
    }
    const float inv = 1.f / l;
    bf16_t* op = WS(bf16_t, OFF_ATT) + (size_t)t * 512 + hq * 64;
#pragma unroll
    for (int d = 0; d < 64; ++d) op[d] = f2bf(o[d] * inv);
}

__device__ __forceinline__ void d_hgrn_simple(const P& p, int bh, char* shm) {
    float (*fs)[128] = (float (*)[128])shm;
    float (*ks)[128] = (float (*)[128])(shm + 4096);
    float (*qs)[128] = (float (*)[128])(shm + 8192);
    float (*os)[128] = (float (*)[128])(shm + 12288);
    float (*red)[2] = (float (*)[2])(shm + 16384);
    const int b = bh >> 2, h = bh & 3, e = threadIdx.x & 127;
    const bool act = threadIdx.x < 128;
    float S[128];
#pragma unroll
    for (int d = 0; d < 128; ++d) S[d] = 0.f;
    const float g = p.g_rec[h * 128 + e];
    for (int p0 = PADF; p0 < LP; p0 += 8) {
        float v[8];
        if (act) {
#pragma unroll
            for (int i = 0; i < 8; ++i) {
                const size_t r = (size_t)b * LP + p0 + i;
                const float lf = WS(float, OFF_LOGF)[r * 512 + h * 128 + e];
                const float f = __expf(lf);
                fs[i][e] = f; ks[i][e] = 1.f - f;
                qs[i][e] = bf2f(WS(bf16_t, OFF_RQ)[r * 512 + h * 128 + e]);
                v[i] = bf2f(WS(bf16_t, OFF_RI)[r * 512 + h * 128 + e]);
            }
        }
        __syncthreads();
        if (act) {
#pragma unroll
            for (int i = 0; i < 8; ++i) {
                float o = 0.f;
#pragma unroll
                for (int d = 0; d < 128; ++d) { S[d] = fs[i][d] * S[d] + ks[i][d] * v[i]; o += qs[i][d] * S[d]; }
                os[i][e] = o;
                const float ss = wave_sum(o * o);
                if ((e & 63) == 0) red[i][e >> 6] = ss;
            }
        }
        __syncthreads();
        if (act && p0 >= 128) {
#pragma unroll
            for (int i = 0; i < 8; ++i) {
                const size_t r = (size_t)b * LP + p0 + i;
                const size_t t = (size_t)b * SEQ + (p0 + i - 128);
                const float rstd = rsqrtf((red[i][0] + red[i][1]) * (1.f / 128.f) + EPS);
                const float val = os[i][e] * rstd * g * bf2f(WS(bf16_t, OFF_RG)[r * 512 + h * 128 + e]);
                WS(bf16_t, OFF_REC)[t * 512 + h * 128 + e] = f2bf(val);
            }
        }
        __syncthreads();
    }
}

__device__ __forceinline__ void d_peer_topk_simple(const P& p, int unit) {
    const int t = (unit >> 3) * 256 + threadIdx.x, h = unit & 7;
    const bf16_t* qp = WS(bf16_t, OFF_QRY) + (size_t)t * DM + h * 128;
    float tv[2][16]; int ti[2][16];
#pragma unroll
    for (int pp = 0; pp < 2; ++pp) {
        float q[64];
#pragma unroll
        for (int d = 0; d < 64; ++d) q[d] = bf2f(qp[pp * 64 + d]);
#pragma unroll
        for (int i = 0; i < 16; ++i) { tv[pp][i] = -3.0e38f; ti[pp][i] = 0; }
        const bf16_t* kp = WS(bf16_t, OFF_KEYS) + (size_t)(h * 2 + pp) * 128 * 64;
        for (int n = 0; n < 128; ++n) {
            float sc = 0.f;
#pragma unroll
            for (int d = 0; d < 64; ++d) sc += q[d] * bf2f(kp[n * 64 + d]);
            float xv = sc; int xi = n;
#pragma unroll
            for (int i = 0; i < 16; ++i) {
                if (xv > tv[pp][i]) { const float tf = tv[pp][i]; const int tn = ti[pp][i]; tv[pp][i] = xv; ti[pp][i] = xi; xv = tf; xi = tn; }
            }
        }
    }
    float bv[16]; int bi[16];
#pragma unroll
    for (int i = 0; i < 16; ++i) { bv[i] = -3.0e38f; bi[i] = 0; }
#pragma unroll
    for (int i = 0; i < 16; ++i)
#pragma unroll
        for (int j = 0; j < 16; ++j) {
            if ((i + 1) * (j + 1) <= 16) {
                float xv = tv[0][i] + tv[1][j]; int xi = ti[0][i] * 128 + ti[1][j];
#pragma unroll
                for (int k = 0; k < 16; ++k) {
                    if (xv > bv[k]) { const float tf = bv[k]; const int tn = bi[k]; bv[k] = xv; bi[k] = xi; xv = tf; xi = tn; }
                }
            }
        }
    float se = 0.f, ev[16];
#pragma unroll
    for (int k = 0; k < 16; ++k) { ev[k] = __expf(bv[k] - bv[0]); se += ev[k]; }
    const float inv = 1.f / se;
#pragma unroll
    for (int k = 0; k < 16; ++k) {
        WS(int, OFF_PIDX)[(size_t)t * 128 + h * 16 + k] = bi[k];
        WS(float, OFF_PGATE)[(size_t)t * 128 + h * 16 + k] = ev[k] * inv;
    }
}

__device__ __forceinline__ void d_peer_expert(const P& p, int t, char* shm) {
    float* act = (float*)shm;
    float* red = (float*)(shm + 512);
    const int tid = threadIdx.x, wid = tid >> 6, lane = tid & 63;
    const float rstd = row_rstd(p, t);
    const float* h2 = WS(float, OFF_H2) + (size_t)t * DM;
    float xn[16];
#pragma unroll
    for (int i = 0; i < 4; ++i) {
        const float4 v = ((const float4*)h2)[lane * 4 + i];
        const float4 g = ((const float4*)p.g_ffn)[lane * 4 + i];
        xn[4 * i + 0] = v.x * rstd * g.x; xn[4 * i + 1] = v.y * rstd * g.y; xn[4 * i + 2] = v.z * rstd * g.z; xn[4 * i + 3] = v.w * rstd * g.w;
    }
    const int* idx = WS(int, OFF_PIDX) + (size_t)t * 128;
    const float* gate = WS(float, OFF_PGATE) + (size_t)t * 128;
    const bf16_t* edn = WS(bf16_t, OFF_EDN);
    const bf16_t* eup = WS(bf16_t, OFF_EUP);
    for (int e = wid; e < 128; e += 4) {
        const bf16_t* row = edn + (size_t)idx[e] * DM + lane * 16;
        const uint4 a = ((const uint4*)row)[0], c = ((const uint4*)row)[1];
        const uint32_t w[8] = {a.x, a.y, a.z, a.w, c.x, c.y, c.z, c.w};
        float s = 0.f;
#pragma unroll
        for (int i = 0; i < 8; ++i) s += xn[2 * i] * __uint_as_float(w[i] << 16) + xn[2 * i + 1] * __uint_as_float(w[i] & 0xFFFF0000u);
        s = wave_sum(s);
        if (lane == 0) act[e] = 0.5f * s * (1.f + erff(s * 0.70710678118654752f)) * gate[e];
    }
    __syncthreads();
    float y0 = 0.f, y1 = 0.f, y2 = 0.f, y3 = 0.f;
    for (int e = 0; e < 128; ++e) {
        const float a = act[e];
        const uint2 w = *(const uint2*)(eup + (size_t)idx[e] * DM + tid * 4);
        y0 += a * __uint_as_float(w.x << 16); y1 += a * __uint_as_float(w.x & 0xFFFF0000u);
        y2 += a * __uint_as_float(w.y << 16); y3 += a * __uint_as_float(w.y & 0xFFFF0000u);
    }
    const float4 hv = ((const float4*)h2)[tid];
    const float o0 = hv.x + y0, o1 = hv.y + y1, o2 = hv.z + y2, o3 = hv.w + y3;
    float ss = wave_sum(o0 * o0 + o1 * o1 + o2 * o2 + o3 * o3);
    if (lane == 0) red[wid] = ss;
    __syncthreads();
    ss = red[0] + red[1] + red[2] + red[3];
    const float rs = rsqrtf(ss * (1.f / DM) + EPS);
    const float4 g = ((const float4*)p.g_fin)[tid];
    float4 ov; ov.x = o0 * rs * g.x; ov.y = o1 * rs * g.y; ov.z = o2 * rs * g.z; ov.w = o3 * rs * g.w;
    ((float4*)(p.out + (size_t)t * DM))[tid] = ov;
    __syncthreads();
}

constexpr int SHM_BYTES = 16384 + 64;
__global__ void __launch_bounds__(256, 2) mega(P p) {
    __shared__ __attribute__((aligned(16))) char shm[SHM_BYTES];
    cg::grid_group grid = cg::this_grid();
    const int G = gridDim.x, bid = blockIdx.x;

    {
        constexpr int U_WIN = (NIN / 32) * 32, U_WUA = 32 * 16, U_WUR = 32 * 16, U_WOUT = 32 * 32, U_WQ = 32 * 32, U_KEYS = 32, U_MISC = (LP * 8 + 255) / 256;
        constexpr int E0 = U_WIN, E1 = E0 + U_WUA, E2 = E1 + U_WUR, E3 = E2 + U_WOUT, E4 = E3 + U_WQ, E5 = E4 + U_KEYS, E6 = E5 + U_MISC, E7 = E6 + R;
        for (int u = bid; u < E7; u += G) {
            if (u < E0) d_transpose(p.w_in, WS(bf16_t, OFF_WIN), 1024, NIN, nullptr, u, shm);
            else if (u < E1) d_transpose(p.w_ua, WS(bf16_t, OFF_WUA), 512, 1024, nullptr, u - E0, shm);
            else if (u < E2) d_transpose(p.w_ur, WS(bf16_t, OFF_WUR), 512, 1024, nullptr, u - E1, shm);
            else if (u < E3) d_transpose(p.w_out, WS(bf16_t, OFF_WOUT), 1024, 1024, nullptr, u - E2, shm);
            else if (u < E4) d_transpose(p.w_q, WS(bf16_t, OFF_WQ), 1024, 1024, p.g_ffn, u - E3, shm);
            else if (u < E5) d_cvt(p.keys, WS(bf16_t, OFF_KEYS), (size_t)16 * 128 * 64 / 4, u - E4, U_KEYS);
            else if (u < E6) d_misc(p, u - E5);
            else d_rmsnorm_in(p, u - E6, shm);
        }
    }
    grid.sync();
    ph_gemm_inproj(p, shm);
    grid.sync();
    if (bid < 16) d_hgrn_simple(p, bid, shm);
    else for (int u = bid - 16; u < T * 8 / 256; u += G - 16) d_attn_simple(p, u);
    grid.sync();
    ph_gemm_merge(p, shm);
    grid.sync();
    ph_gemm_out(p, shm);
    d_cvt(p.edown, WS(bf16_t, OFF_EDN), (size_t)16384 * 1024 / 4, bid, G);
    d_cvt(p.eup, WS(bf16_t, OFF_EUP), (size_t)16384 * 1024 / 4, bid, G);
    grid.sync();
    ph_gemm_qry(p, shm);
    grid.sync();
    for (int u = bid; u < (T / 256) * 8; u += G) d_peer_topk_simple(p, u);
    grid.sync();
    for (int t = bid; t < T; t += G) d_peer_expert(p, t, shm);
}

extern "C" void kernel_launch(void* const* d_in, const int* in_sizes, int n_in, void* d_out, int out_size, void* d_ws, size_t ws_size, hipStream_t stream) {
    P p{};
    p.x = (const float*)d_in[0]; p.meta = (const float*)d_in[1]; p.g_mix = (const float*)d_in[2]; p.w_in = (const float*)d_in[3];
    p.b_in = (const float*)d_in[4]; p.sinks = (const float*)d_in[5]; p.lb_logits = (const float*)d_in[6]; p.g_rec = (const float*)d_in[7];
    p.w_ua = (const float*)d_in[8]; p.w_ur = (const float*)d_in[9]; p.w_out = (const float*)d_in[10]; p.g_ffn = (const float*)d_in[11];
    p.w_q = (const float*)d_in[12]; p.keys = (const float*)d_in[13]; p.edown = (const float*)d_in[14]; p.eup = (const float*)d_in[15];
    p.g_fin = (const float*)d_in[16];
    p.out = (float*)d_out; p.ws = (char*)d_ws;
    static int grid_blocks = 0;
    if (!grid_blocks) {
        int dev = 0, cus = 0, per_cu = 0;
        (void)hipGetDevice(&dev);
        (void)hipDeviceGetAttribute(&cus, hipDeviceAttributeMultiprocessorCount, dev);
        (void)hipOccupancyMaxActiveBlocksPerMultiprocessor(&per_cu, mega, 256, 0);
        if (per_cu > 2) per_cu = 2;
        if (per_cu < 1) per_cu = 1;
        grid_blocks = cus * per_cu;
    }
    void* args[] = {&p};
    hipError_t e = hipLaunchCooperativeKernel((void*)mega, dim3(grid_blocks), dim3(256), args, 0, stream);
    if (e != hipSuccess) fprintf(stderr, "cooperative launch failed: %s (grid %d)\n", hipGetErrorString(e), grid_blocks);
}
```

```cpp
#include <hip/hip_runtime.h>
#include <hip/hip_cooperative_groups.h>
#include <stdint.h>
#include <stdio.h>
namespace cg = cooperative_groups;

typedef unsigned short bf16_t;
typedef short bf16x8 __attribute__((ext_vector_type(8)));
typedef float f32x4 __attribute__((ext_vector_type(4)));

constexpr int NB = 4, SEQ = 4096, DM = 1024, LP = 4224, PADF = 112;
constexpr int R = NB * LP;
constexpr int T = NB * SEQ;
constexpr int NIN = 4864;
constexpr float EPS = 1e-6f;

constexpr size_t MiB = 1024 * 1024;
constexpr size_t OFF_WUA = 0;
constexpr size_t OFF_WUR = 1 * MiB;
constexpr size_t OFF_WOUT = 2 * MiB;
constexpr size_t OFF_WQ = 4 * MiB;
constexpr size_t OFF_KEYS = 6 * MiB;
constexpr size_t OFF_ROPE = 6 * MiB + 256 * 1024;
constexpr size_t OFF_LB = OFF_ROPE + 272 * 1024;
constexpr size_t OFF_SSQ = 7 * MiB;
constexpr size_t OFF_B = 8 * MiB;
constexpr size_t OFF_QB = OFF_B;
constexpr size_t OFF_KB = OFF_QB + (size_t)R * 512 * 2;
constexpr size_t OFF_VB = OFF_KB + (size_t)R * 128 * 2;
constexpr size_t OFF_RQ = OFF_VB + (size_t)R * 128 * 2;
constexpr size_t OFF_LOGF = OFF_RQ + (size_t)R * 512 * 2;
constexpr size_t OFF_RI = OFF_LOGF + (size_t)R * 512 * 4;
constexpr size_t OFF_RG = OFF_RI + (size_t)R * 512 * 2;
constexpr size_t OFF_GA = OFF_RG + (size_t)R * 512 * 2;
constexpr size_t OFF_GR = OFF_GA + (size_t)R * 1024 * 2;
constexpr size_t OFF_C = OFF_GR + (size_t)R * 1024 * 2;
constexpr size_t OFF_XN = OFF_C;
constexpr size_t OFF_WIN = OFF_XN + (size_t)R * 1024 * 2;
constexpr size_t OFF_TAIL = OFF_WIN + (size_t)NIN * 1024 * 2;
constexpr size_t OFF_DS = OFF_TAIL;
constexpr size_t OFF_ATT = OFF_C;
constexpr size_t OFF_REC = OFF_ATT + (size_t)T * 512 * 2;
constexpr size_t OFF_MRG = OFF_LOGF;
constexpr size_t OFF_H2 = OFF_GA;
constexpr size_t OFF_H2B = OFF_RI;
constexpr size_t OFF_EDN = OFF_C;
constexpr size_t OFF_EUP = OFF_EDN + (size_t)16384 * 1024 * 2;
constexpr size_t OFF_QRY = OFF_QB;
constexpr size_t OFF_PIDX = OFF_MRG;
constexpr size_t OFF_PGATE = OFF_PIDX + (size_t)T * 128 * 4;
constexpr size_t OFF_RSTD = OFF_LB + 4096;
constexpr size_t OFF_BAR = 6 * MiB + 640 * 1024;
constexpr size_t OFF_QCNT = OFF_LB + 2048;
constexpr size_t OFF_PART0 = OFF_QB;
constexpr size_t OFF_SSQ2 = OFF_PART0 + 5 * (size_t)T * 128 * 4;
constexpr size_t OFF_PART1 = OFF_PGATE + (size_t)T * 128 * 4;
static_assert(OFF_SSQ2 + (size_t)8 * T * 4 <= OFF_LOGF, "ssq2 overlay");
static_assert(OFF_PART1 + 3 * (size_t)T * 128 * 4 <= OFF_GA, "part1 overlay");
static_assert(OFF_QCNT + 64 <= OFF_RSTD && OFF_RSTD + (size_t)T * 4 <= OFF_BAR && OFF_BAR + 3456 * 4 <= OFF_SSQ, "qcnt/rstd/bar");
static_assert(OFF_EUP + (size_t)16384 * 1024 * 2 <= 256 * MiB, "ws overflow");
static_assert(OFF_DS + (size_t)16 * 64 * 16384 * 2 <= 256 * MiB, "ws overflow");
static_assert(OFF_REC + (size_t)T * 512 * 2 <= OFF_TAIL, "overlay");
static_assert((size_t)T * 1024 * 4 <= (size_t)R * 1024 * 4, "h2 overlay");
static_assert(OFF_QRY + (size_t)T * 1024 * 2 <= OFF_LOGF, "qry overlay");
static_assert(OFF_PGATE + (size_t)T * 128 * 4 <= OFF_RI, "pidx overlay");

struct P {
    const float *x, *meta, *g_mix, *w_in, *b_in, *sinks, *lb_logits, *g_rec, *w_ua, *w_ur, *w_out, *g_ffn, *w_q, *keys, *edown, *eup, *g_fin;
    float* out;
    char* ws;
};
#define WS(type, off) ((type*)(p.ws + (off)))

__device__ __forceinline__ bf16_t f2bf(float f) {
    uint32_t u = __float_as_uint(f);
    u += 0x7FFFu + ((u >> 16) & 1u);
    return (bf16_t)(u >> 16);
}
__device__ __forceinline__ float bf2f(bf16_t h) { return __uint_as_float(((uint32_t)h) << 16); }
__device__ __forceinline__ uint32_t pack2(float lo, float hi) { return (uint32_t)f2bf(lo) | ((uint32_t)f2bf(hi) << 16); }
__device__ __forceinline__ float sigmoidf_(float v) { return 1.f / (1.f + __expf(-v)); }

__device__ __forceinline__ float wave_sum(float v) {
#pragma unroll
    for (int o = 32; o > 0; o >>= 1) v += __shfl_xor(v, o);
    return v;
}

__device__ __forceinline__ void d_transpose(const float* __restrict__ W, bf16_t* __restrict__ Wt, int K, int N, const float* __restrict__ rs, int unit, char* shm) {
    float (*tile)[33] = (float (*)[33])shm;
    const int ntn = N / 32;
    const int k0 = (unit / ntn) * 32, n0 = (unit % ntn) * 32, tx = threadIdx.x & 31, ty = threadIdx.x >> 5;
#pragma unroll
    for (int i = 0; i < 4; ++i) {
        const int k = k0 + ty + i * 8;
        tile[ty + i * 8][tx] = W[(size_t)k * N + n0 + tx] * (rs ? rs[k] : 1.f);
    }
    __syncthreads();
#pragma unroll
    for (int i = 0; i < 4; ++i) {
        const int n = n0 + ty + i * 8;
        Wt[(size_t)n * K + k0 + tx] = f2bf(tile[tx][ty + i * 8]);
    }
    __syncthreads();
}

__device__ __forceinline__ void d_cvt(const float* __restrict__ src, bf16_t* __restrict__ dst, size_t n4, int vblk, int nvblk) {
    for (size_t i = (size_t)vblk * 256 + threadIdx.x; i < n4; i += (size_t)nvblk * 256) {
        const float4 v = ((const float4*)src)[i];
        ushort4 o; o.x = f2bf(v.x); o.y = f2bf(v.y); o.z = f2bf(v.z); o.w = f2bf(v.w);
        ((ushort4*)dst)[i] = o;
    }
}

__device__ __forceinline__ void d_misc(const P& p, int unit) {
    const int gid = unit * 256 + threadIdx.x;
    if (gid < LP * 8) {
        const int pp = gid >> 3, i = gid & 7;
        const double inv = pow(500000.0, -(double)i / 8.0);
        const double ang = (double)(pp - PADF) * inv;
        float2 cs; cs.x = (float)cos(ang); cs.y = (float)sin(ang);
        WS(float2, OFF_ROPE)[gid] = cs;
    }
    if (gid < 512) {
        const float l0 = p.lb_logits[gid], l1 = p.lb_logits[512 + gid];
        WS(float, OFF_LB)[gid] = 1.f / (1.f + expf(l1 - l0));
    }
}

__device__ __forceinline__ void d_rmsnorm_in(const P& p, int r, char* shm) {
    float* red = (float*)shm;
    const int b = r / LP, pp = r % LP, tid = threadIdx.x;
    bf16_t* dst = WS(bf16_t, OFF_XN) + (size_t)r * DM;
    if (pp < PADF) { ((ushort4*)dst)[tid] = make_ushort4(0, 0, 0, 0); return; }
    const float* src = (pp < 128) ? (p.meta + (size_t)(pp - PADF) * DM) : (p.x + ((size_t)b * SEQ + (pp - 128)) * DM);
    const float4 v = ((const float4*)src)[tid];
    float ss = v.x * v.x + v.y * v.y + v.z * v.z + v.w * v.w;
    ss = wave_sum(ss);
    if ((tid & 63) == 0) red[tid >> 6] = ss;
    __syncthreads();
    ss = red[0] + red[1] + red[2] + red[3];
    const float rstd = rsqrtf(ss * (1.f / DM) + EPS);
    const float4 g = ((const float4*)p.g_mix)[tid];
    ushort4 o; o.x = f2bf(v.x * rstd * g.x); o.y = f2bf(v.y * rstd * g.y); o.z = f2bf(v.z * rstd * g.z); o.w = f2bf(v.w * rstd * g.w);
    ((ushort4*)dst)[tid] = o;
    __syncthreads();
}

__device__ __forceinline__ void glds16(const void* src, void* lds) { __builtin_amdgcn_global_load_lds((const unsigned*)src, (unsigned*)lds, 16, 0, 0); }

__device__ __forceinline__ void gemm_kloop(const bf16_t* __restrict__ A, int lda, const bf16_t* __restrict__ Bt, int ldb, int K, int brow, int bcol,
                                           f32x4 (&acc)[4][4], char* SA, char* SB) {
    const int tid = threadIdx.x, wid = tid >> 6, lane = tid & 63, wr = wid >> 1, wc = wid & 1, fr = lane & 15, fq = lane >> 4;
    for (int kt = 0; kt < K / 32; ++kt) {
#pragma unroll
        for (int i = 0; i < 2; ++i) {
            const int b = tid * 16 + i * 4096, r = b >> 6, c = (b & 63) >> 1;
            glds16(A + (size_t)(brow + r) * lda + kt * 32 + c, SA + b);
            glds16(Bt + (size_t)(bcol + r) * ldb + kt * 32 + c, SB + b);
        }
        asm volatile("s_waitcnt vmcnt(0)" ::: "memory");
        __syncthreads();
        bf16x8 a[4], b[4];
#pragma unroll
        for (int m = 0; m < 4; ++m) a[m] = *(const bf16x8*)(SA + (wr * 64 + m * 16 + fr) * 64 + fq * 16);
#pragma unroll
        for (int n = 0; n < 4; ++n) b[n] = *(const bf16x8*)(SB + (wc * 64 + n * 16 + fr) * 64 + fq * 16);
#pragma unroll
        for (int m = 0; m < 4; ++m)
#pragma unroll
            for (int n = 0; n < 4; ++n) acc[m][n] = __builtin_amdgcn_mfma_f32_16x16x32_bf16(a[m], b[n], acc[m][n], 0, 0, 0);
        __syncthreads();
    }
}

__device__ __forceinline__ void zero_acc(f32x4 (&acc)[4][4]) {
#pragma unroll
    for (int m = 0; m < 4; ++m)
#pragma unroll
        for (int n = 0; n < 4; ++n) acc[m][n] = (f32x4){0.f, 0.f, 0.f, 0.f};
}

__device__ __forceinline__ void ph_gemm_inproj(const P& p, char* shm) {
    const int tid = threadIdx.x, wid = tid >> 6, lane = tid & 63, wr = wid >> 1, wc = wid & 1, fr = lane & 15, fq = lane >> 4;
    constexpr int NT_N = NIN / 128, NT_M = R / 128;
    const float2* rope = WS(float2, OFF_ROPE);
    const float* lbv = WS(float, OFF_LB);
    for (int tile = blockIdx.x; tile < NT_N * NT_M; tile += gridDim.x) {
        const int pm = tile / NT_N, pn = tile % NT_N, brow_ = pm * 128, bcol_ = pn * 128;
        f32x4 acc[4][4]; zero_acc(acc);
        int brow = brow_, bcol = bcol_;
        gemm_kloop(WS(bf16_t, OFF_XN), DM, WS(bf16_t, OFF_WIN), DM, DM, brow, bcol, acc, shm, shm + 8192);
        asm volatile("" : "+s"(brow), "+s"(bcol));
        if (bcol >= 1280 && bcol < 1792) {
#pragma unroll
            for (int n = 0; n < 4; ++n) {
                const int col = bcol + wc * 64 + n * 16 + fr;
                const float bv = p.b_in[col], lb = lbv[col - 1280];
                float run = 0.f;
#pragma unroll
                for (int m = 0; m < 4; ++m) {
                    float c[4];
#pragma unroll
                    for (int j = 0; j < 4; ++j) {
                        const int row = brow + wr * 64 + m * 16 + fq * 4 + j;
                        const float v = acc[m][n][j] + bv;
                        const float f = lb + (1.f - lb) * sigmoidf_(v);
                        const float lf = ((row % LP) < PADF) ? 0.f : __logf(f);
                        c[j] = lf + (j ? c[j - 1] : 0.f);
                    }
                    const float x = c[3];
                    const float y = __shfl_up(x, 16);
                    float incl = x + (fq >= 1 ? y : 0.f);
                    const float z = __shfl_up(incl, 32);
                    incl += (fq >= 2 ? z : 0.f);
                    const float excl = incl - x;
                    const float tot = __shfl(incl, fr + 48);
#pragma unroll
                    for (int j = 0; j < 4; ++j) {
                        const int row = brow + wr * 64 + m * 16 + fq * 4 + j;
                        WS(float, OFF_LOGF)[(size_t)row * 512 + (col - 1280)] = run + excl + c[j];
                    }
                    run += tot;
                }
            }
        } else
#pragma unroll
        for (int m = 0; m < 4; ++m)
#pragma unroll
            for (int n = 0; n < 4; ++n) {
                const int col = bcol + wc * 64 + n * 16 + fr;
                const float bv = p.b_in[col];
#pragma unroll
                for (int j = 0; j < 4; ++j) {
                    const int row = brow + wr * 64 + m * 16 + fq * 4 + j;
                    const int pp = row % LP;
                    float v = acc[m][n][j] + bv;
                    if (bcol < 640) {
                        if (n == 0) {
                            const float other = __shfl_xor(v, 8);
                            const float2 cs = rope[pp * 8 + (fr & 7)];
                            v = (fr < 8) ? (v * cs.x - other * cs.y) : (v * cs.x + other * cs.y);
                        }
                        if (bcol < 512) WS(bf16_t, OFF_QB)[(size_t)row * 512 + col] = f2bf(v * 0.125f);
                        else WS(bf16_t, OFF_KB)[(size_t)row * 128 + (col - 512)] = f2bf(v);
                    } else if (bcol < 768) {
                        WS(bf16_t, OFF_VB)[(size_t)row * 128 + (col - 640)] = f2bf(v);
                    } else if (bcol < 1280) {
                        WS(bf16_t, OFF_RQ)[(size_t)row * 512 + (col - 768)] = f2bf(v);
                    } else if (bcol < 2304) {
                        WS(bf16_t, OFF_RI)[(size_t)row * 512 + (col - 1792)] = f2bf(v);
                    } else if (bcol < 2816) {
                        WS(bf16_t, OFF_RG)[(size_t)row * 512 + (col - 2304)] = f2bf(v * sigmoidf_(v));
                    } else if (bcol < 3840) {
                        WS(bf16_t, OFF_GA)[(size_t)row * 1024 + (col - 2816)] = f2bf(sigmoidf_(v));
                    } else {
                        WS(bf16_t, OFF_GR)[(size_t)row * 1024 + (col - 3840)] = f2bf(sigmoidf_(v));
                    }
                }
            }
    }
}

__device__ __forceinline__ void ph_gemm_merge(const P& p, char* shm) {
    const int tid = threadIdx.x, wid = tid >> 6, lane = tid & 63, wr = wid >> 1, wc = wid & 1, fr = lane & 15, fq = lane >> 4;
    constexpr int NT_N = 8, NT_M = T / 128;
    for (int tile = blockIdx.x; tile < NT_N * NT_M; tile += gridDim.x) {
        const int pm = tile / NT_N, pn = tile % NT_N, brow = pm * 128, bcol = pn * 128;
        f32x4 acc[4][4];
#pragma unroll 1
        for (int pass = 0; pass < 2; ++pass) {
            zero_acc(acc);
            gemm_kloop(WS(bf16_t, pass ? OFF_REC : OFF_ATT), 512, WS(bf16_t, pass ? OFF_WUR : OFF_WUA), 512, 512, brow, bcol, acc, shm, shm + 8192);
            int erow = brow, ecol = bcol;
            asm volatile("" : "+s"(erow), "+s"(ecol));
            const bf16_t* gate = WS(bf16_t, pass ? OFF_GR : OFF_GA) + (size_t)(128 * (erow / SEQ + 1)) * 1024;
#pragma unroll
            for (int m = 0; m < 4; ++m)
#pragma unroll
                for (int n = 0; n < 4; ++n) {
                    const int col = ecol + wc * 64 + n * 16 + fr;
#pragma unroll
                    for (int j = 0; j < 4; ++j) {
                        const int row = erow + wr * 64 + m * 16 + fq * 4 + j;
                        bf16_t* dst = WS(bf16_t, OFF_MRG) + (size_t)row * 1024 + col;
                        float v = acc[m][n][j] * bf2f(gate[(size_t)row * 1024 + col]);
                        if (pass) v += bf2f(*dst);
                        *dst = f2bf(v);
                    }
                    asm volatile("" ::: "memory");
                }
        }
    }
}

__device__ __forceinline__ void ph_gemm_out(const P& p, char* shm) {
    const int tid = threadIdx.x, wid = tid >> 6, lane = tid & 63, wr = wid >> 1, wc = wid & 1, fr = lane & 15, fq = lane >> 4;
    constexpr int NT_N = 8, NT_M = T / 128;
    for (int tile = blockIdx.x; tile < NT_N * NT_M; tile += gridDim.x) {
        const int pm = tile / NT_N, pn = tile % NT_N, brow_ = pm * 128, bcol_ = pn * 128;
        f32x4 acc[4][4]; zero_acc(acc);
        int brow = brow_, bcol = bcol_;
        gemm_kloop(WS(bf16_t, OFF_MRG), 1024, WS(bf16_t, OFF_WOUT), 1024, 1024, brow, bcol, acc, shm, shm + 8192);
        asm volatile("" : "+s"(brow), "+s"(bcol));
#pragma unroll
        for (int m = 0; m < 4; ++m)
#pragma unroll
            for (int j = 0; j < 4; ++j) {
                const int row = brow + wr * 64 + m * 16 + fq * 4 + j;
                float ss = 0.f;
#pragma unroll
                for (int n = 0; n < 4; ++n) {
                    const int col = bcol + wc * 64 + n * 16 + fr;
                    const float v = acc[m][n][j] + p.x[(size_t)row * DM + col];
                    WS(float, OFF_H2)[(size_t)row * DM + col] = v;
                    WS(bf16_t, OFF_H2B)[(size_t)row * DM + col] = f2bf(v);
                    ss += v * v;
                }
                ss += __shfl_xor(ss, 1); ss += __shfl_xor(ss, 2); ss += __shfl_xor(ss, 4); ss += __shfl_xor(ss, 8);
                if (fr == 0) WS(float, OFF_SSQ)[(size_t)(pn * 2 + wc) * T + row] = ss;
            }
    }
}

__device__ __forceinline__ float row_rstd(const P& p, int row) {
    float s = 0.f;
#pragma unroll
    for (int i = 0; i < 16; ++i) s += WS(float, OFF_SSQ)[(size_t)i * T + row];
    return rsqrtf(s * (1.f / DM) + EPS);
}

__device__ __forceinline__ void ph_gemm_qry(const P& p, char* shm) {
    const int tid = threadIdx.x, wid = tid >> 6, lane = tid & 63, wr = wid >> 1, wc = wid & 1, fr = lane & 15, fq = lane >> 4;
    constexpr int NT_N = 8, NT_M = T / 128;
    for (int tile = blockIdx.x; tile < NT_N * NT_M; tile += gridDim.x) {
        const int pm = tile / NT_N, pn = tile % NT_N, brow_ = pm * 128, bcol_ = pn * 128;
        f32x4 acc[4][4]; zero_acc(acc);
        int brow = brow_, bcol = bcol_;
        gemm_kloop(WS(bf16_t, OFF_H2B), 1024, WS(bf16_t, OFF_WQ), 1024, 1024, brow, bcol, acc, shm, shm + 8192);
        asm volatile("" : "+s"(brow), "+s"(bcol));
#pragma unroll
        for (int m = 0; m < 4; ++m)
#pragma unroll
            for (int j = 0; j < 4; ++j) {
                const int row = brow + wr * 64 + m * 16 + fq * 4 + j;
                const float rstd = row_rstd(p, row);
                if (bcol == 0 && wc == 0 && fr == 0) WS(float, OFF_RSTD)[row] = rstd;
#pragma unroll
                for (int n = 0; n < 4; ++n) {
                    const int col = bcol + wc * 64 + n * 16 + fr;
                    WS(bf16_t, OFF_QRY)[(size_t)row * DM + col] = f2bf(acc[m][n][j] * rstd);
                }
            }
    }
}

#if ATTN_SIMPLE
__device__ __forceinline__ void d_attn_simple(const P& p, int unit) {
    const int gid = unit * 256 + threadIdx.x;
    const int hq = gid / T, t = gid % T, b = t / SEQ, s = t % SEQ, pq = 128 + s, kvh = hq >> 2;
    const bf16_t* qp = WS(bf16_t, OFF_QB) + ((size_t)b * LP + pq) * 512 + hq * 64;
    float q[64], o[64];
#pragma unroll
    for (int d = 0; d < 64; ++d) { q[d] = bf2f(qp[d]); o[d] = 0.f; }
    float m = p.sinks[hq], l = 1.f;
    const bf16_t* kbase = WS(bf16_t, OFF_KB) + (size_t)b * LP * 128 + kvh * 64;
    const bf16_t* vbase = WS(bf16_t, OFF_VB) + (size_t)b * LP * 128 + kvh * 64;
    const int lo = (pq - 127 > 128) ? (pq - 127) : 128;
    const int nkeys = 16 + (pq - lo + 1);
    for (int i = 0; i < nkeys; ++i) {
        const int pk = (i < 16) ? (PADF + i) : (lo + i - 16);
        const bf16_t* kp = kbase + (size_t)pk * 128;
        const bf16_t* vp = vbase + (size_t)pk * 128;
        float sc = 0.f;
#pragma unroll
        for (int d = 0; d < 64; ++d) sc += q[d] * bf2f(kp[d]);
        const float mn = fmaxf(m, sc), a = __expf(m - mn), e = __expf(sc - mn);
        l = l * a + e;
#pragma unroll
        for (int d = 0; d < 64; ++d) o[d] = o[d] * a + e * bf2f(vp[d]);
        m = mn;
    }
    const float inv = 1.f / l;
    bf16_t* op = WS(bf16_t, OFF_ATT) + (size_t)t * 512 + hq * 64;
#pragma unroll
    for (int d = 0; d < 64; ++d) op[d] = f2bf(o[d] * inv);
}

#endif
constexpr int LDV = 280;
__device__ __forceinline__ void d_attn(const P& p, int unit, char* shm) {
    bf16_t* VT = (bf16_t*)shm;
    const int tid = threadIdx.x, lane = tid & 63, fr = lane & 15, fq = lane >> 4;
    const int w = __builtin_amdgcn_readfirstlane(tid >> 6);
    const int hq = unit & 7, n = ((unit >> 3) & 31) + 1, b = unit >> 8, kvh = hq >> 2;
    const size_t rb = (size_t)b * LP;
    const int kb0 = 128 * (n - 1);
    const bf16_t* kbp = WS(bf16_t, OFF_KB) + kvh * 64;
    const bf16_t* vbp = WS(bf16_t, OFF_VB) + kvh * 64;
#pragma unroll 1
    for (int i = 0; i < 9; ++i) {
        const int c = tid + 256 * i;
        if (c < 2176) {
            const int x = c >> 3, dc = c & 7;
            const int pos = (x < 256) ? (kb0 + x) : (PADF + x - 256);
            const uint4 v = *(const uint4*)(vbp + (rb + pos) * 128 + 8 * dc);
            bf16_t* dst = VT + (8 * dc) * LDV + x;
            dst[0 * LDV] = (bf16_t)(v.x & 0xFFFF); dst[1 * LDV] = (bf16_t)(v.x >> 16);
            dst[2 * LDV] = (bf16_t)(v.y & 0xFFFF); dst[3 * LDV] = (bf16_t)(v.y >> 16);
            dst[4 * LDV] = (bf16_t)(v.z & 0xFFFF); dst[5 * LDV] = (bf16_t)(v.z >> 16);
            dst[6 * LDV] = (bf16_t)(v.w & 0xFFFF); dst[7 * LDV] = (bf16_t)(v.w >> 16);
        }
    }
    __syncthreads();
    bf16x8 qf[2][2];
#pragma unroll
    for (int u = 0; u < 2; ++u)
#pragma unroll
        for (int ks = 0; ks < 2; ++ks)
            qf[u][ks] = *(const bf16x8*)(WS(bf16_t, OFF_QB) + (rb + 128 * n + 32 * w + 16 * u + fr) * 512 + hq * 64 + 32 * ks + 8 * fq);
    f32x4 s[11][2];
#pragma unroll
    for (int tt = 0; tt < 11; ++tt) {
        const int x0 = (tt < 10) ? (32 * w + 16 * tt) : 256;
        const int pos = ((tt < 10) ? (kb0 + x0) : PADF) + fr;
        const bf16x8 k0 = *(const bf16x8*)(kbp + (rb + pos) * 128 + 8 * fq);
        const bf16x8 k1 = *(const bf16x8*)(kbp + (rb + pos) * 128 + 32 + 8 * fq);
#pragma unroll
        for (int u = 0; u < 2; ++u) {
            f32x4 c = (f32x4){0.f, 0.f, 0.f, 0.f};
            c = __builtin_amdgcn_mfma_f32_16x16x32_bf16(k0, qf[u][0], c, 0, 0, 0);
            c = __builtin_amdgcn_mfma_f32_16x16x32_bf16(k1, qf[u][1], c, 0, 0, 0);
            if (tt < 10) {
                const int xq = 128 + 32 * w + 16 * u + fr;
#pragma unroll
                for (int j = 0; j < 4; ++j) {
                    const int x = x0 + 4 * fq + j, dq = xq - x;
                    const bool ok = (dq >= 0) && (dq < 128) && (kb0 + x >= 128);
                    c[j] = ok ? c[j] : -1.0e30f;
                }
            }
            s[tt][u] = c;
        }
    }
    const float sink = p.sinks[hq];
    float inv[2];
#pragma unroll
    for (int u = 0; u < 2; ++u) {
        float m = sink;
#pragma unroll
        for (int tt = 0; tt < 11; ++tt)
#pragma unroll
            for (int j = 0; j < 4; ++j) m = fmaxf(m, s[tt][u][j]);
        m = fmaxf(m, __shfl_xor(m, 16)); m = fmaxf(m, __shfl_xor(m, 32));
        float l = 0.f;
#pragma unroll
        for (int tt = 0; tt < 11; ++tt)
#pragma unroll
            for (int j = 0; j < 4; ++j) { const float e = __expf(s[tt][u][j] - m); s[tt][u][j] = e; l += e; }
        l += __shfl_xor(l, 16); l += __shfl_xor(l, 32);
        l += __expf(sink - m);
        inv[u] = 1.f / l;
    }
    f32x4 o[4][2];
#pragma unroll
    for (int dt = 0; dt < 4; ++dt)
#pragma unroll
        for (int u = 0; u < 2; ++u) o[dt][u] = (f32x4){0.f, 0.f, 0.f, 0.f};
#pragma unroll
    for (int g = 0; g < 6; ++g) {
        const int xa = (g < 5) ? (32 * w + 32 * g) : 256, xb = (g < 5) ? (xa + 16) : 256;
        bf16x8 pf[2];
#pragma unroll
        for (int u = 0; u < 2; ++u) {
#pragma unroll
            for (int j = 0; j < 4; ++j) {
                pf[u][j] = (short)f2bf(s[2 * g][u][j]);
                pf[u][4 + j] = (g < 5) ? (short)f2bf(s[(g < 5) ? (2 * g + 1) : 0][u][j]) : (short)0;
            }
        }
#pragma unroll
        for (int dt = 0; dt < 4; ++dt) {
            const uint2 a0 = *(const uint2*)(VT + (16 * dt + fr) * LDV + xa + 4 * fq);
            const uint2 a1 = *(const uint2*)(VT + (16 * dt + fr) * LDV + xb + 4 * fq);
            union { uint4 q; bf16x8 v; } av; av.q = make_uint4(a0.x, a0.y, a1.x, a1.y);
#pragma unroll
            for (int u = 0; u < 2; ++u) o[dt][u] = __builtin_amdgcn_mfma_f32_16x16x32_bf16(av.v, pf[u], o[dt][u], 0, 0, 0);
        }
    }
#pragma unroll
    for (int u = 0; u < 2; ++u) {
        const size_t t = (size_t)b * SEQ + 128 * (n - 1) + 32 * w + 16 * u + fr;
#pragma unroll
        for (int dt = 0; dt < 4; ++dt) {
            uint2 ov;
            ov.x = pack2(o[dt][u][0] * inv[u], o[dt][u][1] * inv[u]);
            ov.y = pack2(o[dt][u][2] * inv[u], o[dt][u][3] * inv[u]);
            *(uint2*)(WS(bf16_t, OFF_ATT) + t * 512 + hq * 64 + 16 * dt + 4 * fq) = ov;
        }
    }
    __syncthreads();
}

#if HGRN_SIMPLE
__device__ __forceinline__ void d_hgrn_simple(const P& p, int bh, char* shm) {
    float (*fs)[128] = (float (*)[128])shm;
    float (*ks)[128] = (float (*)[128])(shm + 4096);
    float (*qs)[128] = (float (*)[128])(shm + 8192);
    float (*os)[128] = (float (*)[128])(shm + 12288);
    float (*red)[2] = (float (*)[2])(shm + 16384);
    const int b = bh >> 2, h = bh & 3, e = threadIdx.x & 127;
    const bool act = threadIdx.x < 128;
    float S[128];
#pragma unroll
    for (int d = 0; d < 128; ++d) S[d] = 0.f;
    const float g = p.g_rec[h * 128 + e];
    for (int p0 = PADF; p0 < LP; p0 += 8) {
        float v[8];
        if (act) {
#pragma unroll
            for (int i = 0; i < 8; ++i) {
                const size_t r = (size_t)b * LP + p0 + i;
                const float lf = WS(float, OFF_LOGF)[r * 512 + h * 128 + e] - (((p0 + i) & 63) ? WS(float, OFF_LOGF)[(r - 1) * 512 + h * 128 + e] : 0.f);
                const float f = __expf(lf);
                fs[i][e] = f; ks[i][e] = 1.f - f;
                qs[i][e] = bf2f(WS(bf16_t, OFF_RQ)[r * 512 + h * 128 + e]);
                v[i] = bf2f(WS(bf16_t, OFF_RI)[r * 512 + h * 128 + e]);
            }
        }
        __syncthreads();
        if (act) {
#pragma unroll
            for (int i = 0; i < 8; ++i) {
                float o = 0.f;
#pragma unroll
                for (int d = 0; d < 128; ++d) { S[d] = fs[i][d] * S[d] + ks[i][d] * v[i]; o += qs[i][d] * S[d]; }
                os[i][e] = o;
                const float ss = wave_sum(o * o);
                if ((e & 63) == 0) red[i][e >> 6] = ss;
            }
        }
        __syncthreads();
        if (act && p0 >= 128) {
#pragma unroll
            for (int i = 0; i < 8; ++i) {
                const size_t r = (size_t)b * LP + p0 + i;
                const size_t t = (size_t)b * SEQ + (p0 + i - 128);
                const float rstd = rsqrtf((red[i][0] + red[i][1]) * (1.f / 128.f) + EPS);
                const float val = os[i][e] * rstd * g * bf2f(WS(bf16_t, OFF_RG)[r * 512 + h * 128 + e]);
                WS(bf16_t, OFF_REC)[t * 512 + h * 128 + e] = f2bf(val);
            }
        }
        __syncthreads();
    }
}

#endif

constexpr int LD64 = 72;
constexpr int LD128 = 136;

__device__ __forceinline__ void d_hgrn_A(const P& p, int unit, char* shm) {
    bf16_t* VT = (bf16_t*)shm;
    bf16_t* KT = (bf16_t*)(shm + 128 * LD64 * 2);
    const int tid = threadIdx.x, wid = tid >> 6, lane = tid & 63, fr = lane & 15, fq = lane >> 4;
    const int bh = unit >> 6, n = (unit & 63) + 1, b = bh >> 2, h = bh & 3;
    const int c = tid & 127, half = tid >> 7;
    const size_t r0 = (size_t)b * LP + 64 * n;
    const float* bb = WS(float, OFF_LOGF) + r0 * 512 + h * 128 + c;
    const bf16_t* vv = WS(bf16_t, OFF_RI) + r0 * 512 + h * 128 + c;
    {
        const float blast = bb[63 * 512];
        float prev = half ? bb[31 * 512] : 0.f;
        const float* bp = bb + (size_t)(32 * half) * 512;
        const bf16_t* vp_ = vv + (size_t)(32 * half) * 512;
#pragma unroll 1
        for (int g = 0; g < 4; ++g) {
            float bs[8]; uint32_t vs[8];
#pragma unroll
            for (int i = 0; i < 8; ++i) { bs[i] = bp[i * 512]; vs[i] = vp_[i * 512]; }
            uint32_t kp[4], vp[4];
#pragma unroll
            for (int i = 0; i < 8; i += 2) {
                const float k0 = (1.f - __expf(bs[i] - prev)) * __expf(blast - bs[i]);
                const float k1 = (1.f - __expf(bs[i + 1] - bs[i])) * __expf(blast - bs[i + 1]);
                prev = bs[i + 1];
                kp[i >> 1] = pack2(k0, k1);
                vp[i >> 1] = vs[i] | (vs[i + 1] << 16);
            }
            *(uint4*)(KT + c * LD64 + 32 * half + 8 * g) = make_uint4(kp[0], kp[1], kp[2], kp[3]);
            *(uint4*)(VT + c * LD64 + 32 * half + 8 * g) = make_uint4(vp[0], vp[1], vp[2], vp[3]);
            bp += 8 * 512; vp_ += 8 * 512;
        }
    }
    __syncthreads();
    f32x4 acc[2][8];
#pragma unroll
    for (int mi = 0; mi < 2; ++mi)
#pragma unroll
        for (int n8 = 0; n8 < 8; ++n8) acc[mi][n8] = (f32x4){0.f, 0.f, 0.f, 0.f};
#pragma unroll
    for (int ks = 0; ks < 2; ++ks) {
        bf16x8 a[2];
#pragma unroll
        for (int mi = 0; mi < 2; ++mi) a[mi] = *(const bf16x8*)(VT + (32 * wid + 16 * mi + fr) * LD64 + 32 * ks + 8 * fq);
#pragma unroll
        for (int n8 = 0; n8 < 8; ++n8) {
            const bf16x8 bf = *(const bf16x8*)(KT + (16 * n8 + fr) * LD64 + 32 * ks + 8 * fq);
#pragma unroll
            for (int mi = 0; mi < 2; ++mi) acc[mi][n8] = __builtin_amdgcn_mfma_f32_16x16x32_bf16(a[mi], bf, acc[mi][n8], 0, 0, 0);
        }
    }
    bf16_t* dst = WS(bf16_t, OFF_DS) + (size_t)unit * 16384;
#pragma unroll
    for (int mi = 0; mi < 2; ++mi)
#pragma unroll
        for (int n8 = 0; n8 < 8; ++n8)
#pragma unroll
            for (int j = 0; j < 4; ++j) dst[(32 * wid + 16 * mi + 4 * fq + j) * 128 + 16 * n8 + fr] = f2bf(acc[mi][n8][j]);
    __syncthreads();
}

__device__ __forceinline__ void d_hgrn_scan(const P& p, int unit) {
    const int gid = unit * 256 + threadIdx.x;
    const int bh = gid >> 13, rem = gid & 8191, e = rem >> 6, d2 = (rem & 63) * 2;
    uint32_t* base = (uint32_t*)(WS(bf16_t, OFF_DS) + (size_t)bh * 64 * 16384 + e * 128 + d2);
    const float* bb = WS(float, OFF_LOGF) + ((size_t)(bh >> 2) * LP + 64 + 63) * 512 + (bh & 3) * 128 + d2;
    float s0 = 0.f, s1 = 0.f;
#pragma unroll 8
    for (int j = 0; j < 64; ++j) {
        const uint32_t x = base[(size_t)j * 8192];
        const float2 bl = *(const float2*)(bb + (size_t)j * 64 * 512);
        s0 = __expf(bl.x) * s0 + __uint_as_float(x << 16);
        s1 = __expf(bl.y) * s1 + __uint_as_float(x & 0xFFFF0000u);
        base[(size_t)j * 8192] = pack2(s0, s1);
    }
}

__device__ __forceinline__ void d_hgrn_C(const P& p, int unit, char* shm) {
    bf16_t* KS = (bf16_t*)shm;
    bf16_t* KD = KS + 64 * LD128;
    bf16_t* VT = KD + 64 * LD128;
    bf16_t* AM = VT + 128 * LD64;
    const int tid = threadIdx.x, lane = tid & 63, fr = lane & 15, fq = lane >> 4;
    const int wi = __builtin_amdgcn_readfirstlane(tid >> 6);
    const int bh = unit >> 6, n = (unit & 63) + 2, b = bh >> 2, h = bh & 3;
    const size_t r0 = (size_t)b * LP + 64 * n;
    const size_t t0 = (size_t)b * SEQ + 64 * n - 128;
    {
        const int c = tid & 127, half = tid >> 7;
        const float* bb = WS(float, OFF_LOGF) + r0 * 512 + h * 128 + c;
        const bf16_t* vv = WS(bf16_t, OFF_RI) + r0 * 512 + h * 128 + c;
        float prev = half ? bb[31 * 512] : 0.f;
        const float* bp = bb + (size_t)(32 * half) * 512;
        const bf16_t* vp_ = vv + (size_t)(32 * half) * 512;
#pragma unroll 1
        for (int g = 0; g < 4; ++g) {
            const int s0 = 32 * half + 8 * g, sb = s0 & ~15;
            const float bend = bb[(size_t)(sb + 15) * 512];
            const float bref = (sb == 0) ? 0.f : bb[(size_t)(sb - 1) * 512];
            float bs[8]; uint32_t vs[8];
#pragma unroll
            for (int i = 0; i < 8; ++i) { bs[i] = bp[i * 512]; vs[i] = vp_[i * 512]; }
#pragma unroll
            for (int i = 0; i < 8; ++i) {
                const float k = 1.f - __expf(bs[i] - prev);
                prev = bs[i];
                KS[(s0 + i) * LD128 + c] = f2bf(k * __expf(bend - bs[i]));
                KD[(s0 + i) * LD128 + c] = f2bf(k * __expf(bref - bs[i]));
            }
            *(uint4*)(VT + c * LD64 + s0) = make_uint4(vs[0] | (vs[1] << 16), vs[2] | (vs[3] << 16), vs[4] | (vs[5] << 16), vs[6] | (vs[7] << 16));
            bp += 8 * 512; vp_ += 8 * 512;
        }
#pragma unroll
        for (int i = 0; i < 9; ++i) ((uint32_t*)AM)[tid + 256 * i] = 0u;
    }
    __syncthreads();
    const int tl = 16 * wi + fr;
    bf16x8 qf[4]; float bt[4][8];
    {
        const bf16_t* qrow = WS(bf16_t, OFF_RQ) + (r0 + tl) * 512 + h * 128 + 8 * fq;
        const float* brow = WS(float, OFF_LOGF) + (r0 + tl) * 512 + h * 128 + 8 * fq;
#pragma unroll
        for (int ks = 0; ks < 4; ++ks) {
            qf[ks] = *(const bf16x8*)(qrow + 32 * ks);
            const float4 x0 = *(const float4*)(brow + 32 * ks), x1 = *(const float4*)(brow + 32 * ks + 4);
            bt[ks][0] = x0.x; bt[ks][1] = x0.y; bt[ks][2] = x0.z; bt[ks][3] = x0.w; bt[ks][4] = x1.x; bt[ks][5] = x1.y; bt[ks][6] = x1.z; bt[ks][7] = x1.w;
        }
    }
    auto qfrag = [&](int ks, const float* refrow) -> bf16x8 {
        float rf[8];
        if (refrow) {
            const float4 x0 = *(const float4*)(refrow + 32 * ks), x1 = *(const float4*)(refrow + 32 * ks + 4);
            rf[0] = x0.x; rf[1] = x0.y; rf[2] = x0.z; rf[3] = x0.w; rf[4] = x1.x; rf[5] = x1.y; rf[6] = x1.z; rf[7] = x1.w;
        } else {
#pragma unroll
            for (int jj = 0; jj < 8; ++jj) rf[jj] = 0.f;
        }
        bf16x8 o;
#pragma unroll
        for (int jj = 0; jj < 8; ++jj) o[jj] = (short)f2bf(bf2f((bf16_t)qf[ks][jj]) * __expf(bt[ks][jj] - rf[jj]));
        return o;
    };
    const float* bchunk = WS(float, OFF_LOGF) + r0 * 512 + h * 128 + 8 * fq;
    f32x4 acc[8];
#pragma unroll
    for (int n8 = 0; n8 < 8; ++n8) acc[n8] = (f32x4){0.f, 0.f, 0.f, 0.f};
    {
        const bf16_t* sp = WS(bf16_t, OFF_DS) + (size_t)unit * 16384 + fr * 128 + 8 * fq;
#pragma unroll
        for (int ks = 0; ks < 4; ++ks) {
            const bf16x8 a = qfrag(ks, nullptr);
#pragma unroll
            for (int n8 = 0; n8 < 8; ++n8) {
                const bf16x8 bf = *(const bf16x8*)(sp + (size_t)n8 * 16 * 128 + 32 * ks);
                acc[n8] = __builtin_amdgcn_mfma_f32_16x16x32_bf16(a, bf, acc[n8], 0, 0, 0);
            }
        }
    }
    for (int j = 0; j < wi; ++j) {
        f32x4 c4 = (f32x4){0.f, 0.f, 0.f, 0.f};
        const float* refrow = bchunk + (size_t)(16 * j + 15) * 512;
#pragma unroll
        for (int ks = 0; ks < 4; ++ks) {
            const bf16x8 a = qfrag(ks, refrow);
            const bf16x8 bf = *(const bf16x8*)(KS + (16 * j + fr) * LD128 + 32 * ks + 8 * fq);
            c4 = __builtin_amdgcn_mfma_f32_16x16x32_bf16(a, bf, c4, 0, 0, 0);
        }
#pragma unroll
        for (int jj = 0; jj < 4; ++jj) AM[(16 * wi + 4 * fq + jj) * LD64 + 16 * j + fr] = f2bf(c4[jj]);
    }
    {
        f32x4 c4 = (f32x4){0.f, 0.f, 0.f, 0.f};
        const float* refrow = (wi > 0) ? (bchunk + (size_t)(16 * wi - 1) * 512) : nullptr;
#pragma unroll
        for (int ks = 0; ks < 4; ++ks) {
            const bf16x8 a = qfrag(ks, refrow);
            const bf16x8 bf = *(const bf16x8*)(KD + (16 * wi + fr) * LD128 + 32 * ks + 8 * fq);
            c4 = __builtin_amdgcn_mfma_f32_16x16x32_bf16(a, bf, c4, 0, 0, 0);
        }
#pragma unroll
        for (int jj = 0; jj < 4; ++jj) AM[(16 * wi + 4 * fq + jj) * LD64 + 16 * wi + fr] = f2bf((fr <= 4 * fq + jj) ? c4[jj] : 0.f);
    }
    __syncthreads();
#pragma unroll
    for (int ks = 0; ks < 2; ++ks) {
        const bf16x8 a = *(const bf16x8*)(AM + (16 * wi + fr) * LD64 + 32 * ks + 8 * fq);
#pragma unroll
        for (int n8 = 0; n8 < 8; ++n8) {
            const bf16x8 bf = *(const bf16x8*)(VT + (16 * n8 + fr) * LD64 + 32 * ks + 8 * fq);
            acc[n8] = __builtin_amdgcn_mfma_f32_16x16x32_bf16(a, bf, acc[n8], 0, 0, 0);
        }
    }
#pragma unroll
    for (int jj = 0; jj < 4; ++jj) {
        float ss = 0.f;
#pragma unroll
        for (int n8 = 0; n8 < 8; ++n8) ss += acc[n8][jj] * acc[n8][jj];
        ss += __shfl_xor(ss, 1); ss += __shfl_xor(ss, 2); ss += __shfl_xor(ss, 4); ss += __shfl_xor(ss, 8);
        const float rstd = rsqrtf(ss * (1.f / 128.f) + EPS);
        const int trow = 16 * wi + 4 * fq + jj;
#pragma unroll
        for (int n8 = 0; n8 < 8; ++n8) {
            const int e = 16 * n8 + fr;
            const float val = acc[n8][jj] * rstd * p.g_rec[h * 128 + e] * bf2f(WS(bf16_t, OFF_RG)[(r0 + trow) * 512 + h * 128 + e]);
            WS(bf16_t, OFF_REC)[(t0 + trow) * 512 + h * 128 + e] = f2bf(val);
        }
        asm volatile("" ::: "memory");
    }
    __syncthreads();
}

__device__ __forceinline__ void d_peer_topk_simple(const P& p, int unit) {
    const int t = (unit >> 3) * 256 + threadIdx.x, h = unit & 7;
    const bf16_t* qp = WS(bf16_t, OFF_QRY) + (size_t)t * DM + h * 128;
    float tv[2][16]; int ti[2][16];
#pragma unroll
    for (int pp = 0; pp < 2; ++pp) {
        float q[64];
#pragma unroll
        for (int d = 0; d < 64; ++d) q[d] = bf2f(qp[pp * 64 + d]);
#pragma unroll
        for (int i = 0; i < 16; ++i) { tv[pp][i] = -3.0e38f; ti[pp][i] = 0; }
        const bf16_t* kp = WS(bf16_t, OFF_KEYS) + (size_t)(h * 2 + pp) * 128 * 64;
        for (int n = 0; n < 128; ++n) {
            float sc = 0.f;
#pragma unroll
            for (int d = 0; d < 64; ++d) sc += q[d] * bf2f(kp[n * 64 + d]);
            float xv = sc; int xi = n;
#pragma unroll
            for (int i = 0; i < 16; ++i) {
                if (xv > tv[pp][i]) { const float tf = tv[pp][i]; const int tn = ti[pp][i]; tv[pp][i] = xv; ti[pp][i] = xi; xv = tf; xi = tn; }
            }
        }
    }
    float bv[16]; int bi[16];
#pragma unroll
    for (int i = 0; i < 16; ++i) { bv[i] = -3.0e38f; bi[i] = 0; }
#pragma unroll
    for (int i = 0; i < 16; ++i)
#pragma unroll
        for (int j = 0; j < 16; ++j) {
            if ((i + 1) * (j + 1) <= 16) {
                float xv = tv[0][i] + tv[1][j]; int xi = ti[0][i] * 128 + ti[1][j];
#pragma unroll
                for (int k = 0; k < 16; ++k) {
                    if (xv > bv[k]) { const float tf = bv[k]; const int tn = bi[k]; bv[k] = xv; bi[k] = xi; xv = tf; xi = tn; }
                }
            }
        }
    float se = 0.f, ev[16];
#pragma unroll
    for (int k = 0; k < 16; ++k) { ev[k] = __expf(bv[k] - bv[0]); se += ev[k]; }
    const float inv = 1.f / se;
#pragma unroll
    for (int k = 0; k < 16; ++k) {
        WS(int, OFF_PIDX)[(size_t)t * 128 + h * 16 + k] = bi[k];
        WS(float, OFF_PGATE)[(size_t)t * 128 + h * 16 + k] = ev[k] * inv;
    }
}

#if PEER_SIMPLE
__device__ __forceinline__ void d_peer_expert(const P& p, int t, char* shm) {
    float* act = (float*)shm;
    float* red = (float*)(shm + 512);
    const int tid = threadIdx.x, wid = tid >> 6, lane = tid & 63;
    const float rstd = row_rstd(p, t);
    const float* h2 = WS(float, OFF_H2) + (size_t)t * DM;
    float xn[16];
#pragma unroll
    for (int i = 0; i < 4; ++i) {
        const float4 v = ((const float4*)h2)[lane * 4 + i];
        const float4 g = ((const float4*)p.g_ffn)[lane * 4 + i];
        xn[4 * i + 0] = v.x * rstd * g.x; xn[4 * i + 1] = v.y * rstd * g.y; xn[4 * i + 2] = v.z * rstd * g.z; xn[4 * i + 3] = v.w * rstd * g.w;
    }
    const int* idx = WS(int, OFF_PIDX) + (size_t)t * 128;
    const float* gate = WS(float, OFF_PGATE) + (size_t)t * 128;
    const bf16_t* edn = WS(bf16_t, OFF_EDN);
    const bf16_t* eup = WS(bf16_t, OFF_EUP);
    for (int e = wid; e < 128; e += 4) {
        const bf16_t* row = edn + (size_t)idx[e] * DM + lane * 16;
        const uint4 a = ((const uint4*)row)[0], c = ((const uint4*)row)[1];
        const uint32_t w[8] = {a.x, a.y, a.z, a.w, c.x, c.y, c.z, c.w};
        float s = 0.f;
#pragma unroll
        for (int i = 0; i < 8; ++i) s += xn[2 * i] * __uint_as_float(w[i] << 16) + xn[2 * i + 1] * __uint_as_float(w[i] & 0xFFFF0000u);
        s = wave_sum(s);
        if (lane == 0) act[e] = 0.5f * s * (1.f + erff(s * 0.70710678118654752f)) * gate[e];
    }
    __syncthreads();
    float y0 = 0.f, y1 = 0.f, y2 = 0.f, y3 = 0.f;
    for (int e = 0; e < 128; ++e) {
        const float a = act[e];
        const uint2 w = *(const uint2*)(eup + (size_t)idx[e] * DM + tid * 4);
        y0 += a * __uint_as_float(w.x << 16); y1 += a * __uint_as_float(w.x & 0xFFFF0000u);
        y2 += a * __uint_as_float(w.y << 16); y3 += a * __uint_as_float(w.y & 0xFFFF0000u);
    }
    const float4 hv = ((const float4*)h2)[tid];
    const float o0 = hv.x + y0, o1 = hv.y + y1, o2 = hv.z + y2, o3 = hv.w + y3;
    float ss = wave_sum(o0 * o0 + o1 * o1 + o2 * o2 + o3 * o3);
    if (lane == 0) red[wid] = ss;
    __syncthreads();
    ss = red[0] + red[1] + red[2] + red[3];
    const float rs = rsqrtf(ss * (1.f / DM) + EPS);
    const float4 g = ((const float4*)p.g_fin)[tid];
    float4 ov; ov.x = o0 * rs * g.x; ov.y = o1 * rs * g.y; ov.z = o2 * rs * g.z; ov.w = o3 * rs * g.w;
    ((float4*)(p.out + (size_t)t * DM))[tid] = ov;
    __syncthreads();
}

#endif
typedef __bf16 bf16v2 __attribute__((ext_vector_type(2)));
__device__ __forceinline__ float dot2bf(uint32_t a, uint32_t b, float c) {
    union { uint32_t u; bf16v2 v; } x, y; x.u = a; y.u = b;
    return __builtin_amdgcn_fdot2_f32_bf16(x.v, y.v, c, false);
}
__device__ __forceinline__ float row_sum16(float v) {
    v += __builtin_amdgcn_update_dpp(0.f, v, 0xB1, 0xF, 0xF, false);
    v += __builtin_amdgcn_update_dpp(0.f, v, 0x4E, 0xF, 0xF, false);
    v += __builtin_amdgcn_update_dpp(0.f, v, 0x141, 0xF, 0xF, false);
    v += __builtin_amdgcn_update_dpp(0.f, v, 0x140, 0xF, 0xF, false);
    return v;
}
__device__ __forceinline__ float* part_ptr(const P& p, int c) {
    return (c < 5) ? (WS(float, OFF_PART0) + (size_t)c * T * 128) : (WS(float, OFF_PART1) + (size_t)(c - 5) * T * 128);
}
__device__ __forceinline__ unsigned xcc_id() { return (unsigned)__builtin_amdgcn_s_getreg((3 << 11) | 20) & 7u; }

#define MEMFENCE() asm volatile("" ::: "memory")
__device__ __forceinline__ void d_peer_e1(const P& p, int t, int c, int lane) {
    const int g = lane >> 4, ch = lane & 15;
    const float rstd = WS(float, OFF_RSTD)[t];
    int idx[32];
    {
        const int4* ip = (const int4*)(WS(int, OFF_PIDX) + (size_t)t * 128 + 32 * g);
#pragma unroll
        for (int k = 0; k < 8; ++k) { const int4 v = ip[k]; idx[4 * k] = v.x; idx[4 * k + 1] = v.y; idx[4 * k + 2] = v.z; idx[4 * k + 3] = v.w; }
    }
    const bf16_t* tab = WS(bf16_t, OFF_EDN) + 128 * c + 8 * ch;
    uint4 wa[8], wb[8];
#pragma unroll
    for (int k = 0; k < 8; ++k) wa[k] = *(const uint4*)(tab + (size_t)idx[k] * DM);
#pragma unroll
    for (int k = 0; k < 8; ++k) wb[k] = *(const uint4*)(tab + (size_t)idx[8 + k] * DM);
    uint32_t xp[4];
    {
        const float* hp = WS(float, OFF_H2) + (size_t)t * DM + 128 * c + 8 * ch;
        const float* gp = p.g_ffn + 128 * c + 8 * ch;
        const float4 h0 = *(const float4*)hp, h1 = *(const float4*)(hp + 4), g0 = *(const float4*)gp, g1 = *(const float4*)(gp + 4);
        xp[0] = pack2(h0.x * rstd * g0.x, h0.y * rstd * g0.y); xp[1] = pack2(h0.z * rstd * g0.z, h0.w * rstd * g0.w);
        xp[2] = pack2(h1.x * rstd * g1.x, h1.y * rstd * g1.y); xp[3] = pack2(h1.z * rstd * g1.z, h1.w * rstd * g1.w);
    }
    MEMFENCE();
    float res0 = 0.f, res1 = 0.f;
#define E1_PROC(W, BASE) _Pragma("unroll") for (int k = 0; k < 8; ++k) { \
        float s = dot2bf(W[k].x, xp[0], 0.f); s = dot2bf(W[k].y, xp[1], s); s = dot2bf(W[k].z, xp[2], s); s = dot2bf(W[k].w, xp[3], s); \
        s = row_sum16(s); \
        if ((BASE) < 16) res0 = ((((BASE) + k) & 15) == ch) ? s : res0; else res1 = ((((BASE) + k) & 15) == ch) ? s : res1; }
    E1_PROC(wa, 0)
#pragma unroll
    for (int k = 0; k < 8; ++k) wa[k] = *(const uint4*)(tab + (size_t)idx[16 + k] * DM);
    MEMFENCE();
    E1_PROC(wb, 8)
#pragma unroll
    for (int k = 0; k < 8; ++k) wb[k] = *(const uint4*)(tab + (size_t)idx[24 + k] * DM);
    MEMFENCE();
    E1_PROC(wa, 16)
    E1_PROC(wb, 24)
    float* pp = part_ptr(p, c) + (size_t)t * 128 + 32 * g + ch;
    pp[0] = res0; pp[16] = res1;
}

__device__ __forceinline__ void d_peer_e2(const P& p, int t, int c, int lane, float* sact  ) {
    const int g = lane >> 4, ch = lane & 15;
    int idx[32];
    {
        const int4* ip = (const int4*)(WS(int, OFF_PIDX) + (size_t)t * 128 + 32 * g);
#pragma unroll
        for (int k = 0; k < 8; ++k) { const int4 q = ip[k]; idx[4 * k] = q.x; idx[4 * k + 1] = q.y; idx[4 * k + 2] = q.z; idx[4 * k + 3] = q.w; }
    }
    const bf16_t* tab = WS(bf16_t, OFF_EUP) + 128 * c + 8 * ch;
    uint4 wa[8], wb[8];
#pragma unroll
    for (int k = 0; k < 8; ++k) wa[k] = *(const uint4*)(tab + (size_t)idx[k] * DM);
    {
        float pu[2][8];
#pragma unroll
        for (int k = 0; k < 2; ++k)
#pragma unroll
            for (int cc = 0; cc < 8; ++cc) pu[k][cc] = part_ptr(p, cc)[(size_t)t * 128 + lane + 64 * k];
        const float g0 = WS(float, OFF_PGATE)[(size_t)t * 128 + lane], g1 = WS(float, OFF_PGATE)[(size_t)t * 128 + lane + 64];
        MEMFENCE();
        const float u0 = ((pu[0][0] + pu[0][1]) + (pu[0][2] + pu[0][3])) + ((pu[0][4] + pu[0][5]) + (pu[0][6] + pu[0][7]));
        const float u1 = ((pu[1][0] + pu[1][1]) + (pu[1][2] + pu[1][3])) + ((pu[1][4] + pu[1][5]) + (pu[1][6] + pu[1][7]));
        sact[lane] = 0.5f * u0 * (1.f + erff(u0 * 0.70710678118654752f)) * g0;
        sact[lane + 64] = 0.5f * u1 * (1.f + erff(u1 * 0.70710678118654752f)) * g1;
    }
    __syncthreads();
    float a[32];
    {
        const float4* ap = (const float4*)(sact + 32 * g);
#pragma unroll
        for (int k = 0; k < 8; ++k) { const float4 v = ap[k]; a[4 * k] = v.x; a[4 * k + 1] = v.y; a[4 * k + 2] = v.z; a[4 * k + 3] = v.w; }
    }
    __syncthreads();
#pragma unroll
    for (int k = 0; k < 8; ++k) wb[k] = *(const uint4*)(tab + (size_t)idx[8 + k] * DM);
    MEMFENCE();
    float y[8];
#pragma unroll
    for (int k = 0; k < 8; ++k) y[k] = 0.f;
#define E2_PROC(W, BASE) _Pragma("unroll") for (int k = 0; k < 8; ++k) { const float av = a[(BASE) + k]; \
        y[0] += av * __uint_as_float(W[k].x << 16); y[1] += av * __uint_as_float(W[k].x & 0xFFFF0000u); \
        y[2] += av * __uint_as_float(W[k].y << 16); y[3] += av * __uint_as_float(W[k].y & 0xFFFF0000u); \
        y[4] += av * __uint_as_float(W[k].z << 16); y[5] += av * __uint_as_float(W[k].z & 0xFFFF0000u); \
        y[6] += av * __uint_as_float(W[k].w << 16); y[7] += av * __uint_as_float(W[k].w & 0xFFFF0000u); }
    E2_PROC(wa, 0)
#pragma unroll
    for (int k = 0; k < 8; ++k) wa[k] = *(const uint4*)(tab + (size_t)idx[16 + k] * DM);
    MEMFENCE();
    E2_PROC(wb, 8)
#pragma unroll
    for (int k = 0; k < 8; ++k) wb[k] = *(const uint4*)(tab + (size_t)idx[24 + k] * DM);
    MEMFENCE();
    E2_PROC(wa, 16)
    E2_PROC(wb, 24)
#pragma unroll
    for (int k = 0; k < 8; ++k) { y[k] += __shfl_xor(y[k], 16); y[k] += __shfl_xor(y[k], 32); }
    if (g == 0) {
        const float* hp = WS(float, OFF_H2) + (size_t)t * DM + 128 * c + 8 * ch;
        const float4 h0 = *(const float4*)hp, h1 = *(const float4*)(hp + 4);
        float4 o0, o1;
        o0.x = h0.x + y[0]; o0.y = h0.y + y[1]; o0.z = h0.z + y[2]; o0.w = h0.w + y[3];
        o1.x = h1.x + y[4]; o1.y = h1.y + y[5]; o1.z = h1.z + y[6]; o1.w = h1.w + y[7];
        float* op = p.out + (size_t)t * DM + 128 * c + 8 * ch;
        *(float4*)op = o0; *(float4*)(op + 4) = o1;
        float ss = o0.x * o0.x + o0.y * o0.y + o0.z * o0.z + o0.w * o0.w + o1.x * o1.x + o1.y * o1.y + o1.z * o1.z + o1.w * o1.w;
        ss = row_sum16(ss);
        if (ch == 0) WS(float, OFF_SSQ2)[(size_t)c * T + t] = ss;
    }
}

template <int PHASE> __device__ __forceinline__ void ph_peer_sliced(const P& p, char* shm) {
    int* s_tile = (int*)shm;
    float* sact = (float*)(shm + 64) + (threadIdx.x >> 6) * 128;
    const int tid = threadIdx.x, lane = tid & 63, wid = tid >> 6;
    unsigned* qc = WS(unsigned, OFF_QCNT) + (PHASE == 2 ? 8 : 0);
    const unsigned x0 = xcc_id();
    for (int dc = 0; dc < 8; ++dc) {
        const int c = (int)((x0 + dc) & 7u);
        for (;;) {
            __syncthreads();
            if (tid == 0) *s_tile = (int)atomicAdd(&qc[c], 1u);
            __syncthreads();
            const int tile = *s_tile;
            if (tile >= T / 16) break;
#pragma unroll 1
            for (int k = 0; k < 4; ++k) {
                const int t = tile * 16 + wid * 4 + k;
                if (PHASE == 1) d_peer_e1(p, t, c, lane); else d_peer_e2(p, t, c, lane, sact);
            }
        }
    }
}

__device__ __forceinline__ void d_peer_e3(const P& p, int t) {
    const int tid = threadIdx.x;
    float s = 0.f;
#pragma unroll
    for (int c = 0; c < 8; ++c) s += WS(float, OFF_SSQ2)[(size_t)c * T + t];
    const float rs = rsqrtf(s * (1.f / DM) + EPS);
    float4* op = (float4*)(p.out + (size_t)t * DM) + tid;
    const float4 g = ((const float4*)p.g_fin)[tid];
    float4 v = *op;
    v.x *= rs * g.x; v.y *= rs * g.y; v.z *= rs * g.z; v.w *= rs * g.w;
    *op = v;
}

#define XB_TMO      128
#define XB_XCNT(j)  (256  + 64 * (j))
#define XB_XSUB(j)  (1280 + 64 * (j))
#define XB_XGEN(j)  (2304 + 64 * (j))
#define XB_TOP      3328
#define XB_TOPGEN   3392
#define XCD_BAR_WORDS 3456
#define XB_SPIN_CAP (1u << 22)
#define LAS __attribute__((address_space(3)))
__device__ __forceinline__ unsigned xb_ld(unsigned* p) { return __hip_atomic_load(p, __ATOMIC_RELAXED, __HIP_MEMORY_SCOPE_AGENT); }
__device__ __forceinline__ unsigned xb_add(unsigned* p, unsigned v) { return __hip_atomic_fetch_add(p, v, __ATOMIC_RELAXED, __HIP_MEMORY_SCOPE_AGENT); }
__device__ __forceinline__ unsigned xb_xcc_id() { return (unsigned)__builtin_amdgcn_s_getreg((3 << 11) | 20) & 0xFu; }
#define XB_SPIN(cond, bar) do { unsigned _sp = 0; while (cond) { __builtin_amdgcn_s_sleep(1); \
    if ((++_sp & 255u) == 0u) { if (xb_ld(&(bar)[XB_TMO])) break; if (_sp > XB_SPIN_CAP) { atomicAdd(&(bar)[XB_TMO], 1u); break; } } } } while (0)
struct XcdBarrier { unsigned* bar; unsigned x; volatile LAS unsigned* st; };
__device__ __forceinline__ XcdBarrier xcd_barrier_post(unsigned* bar, volatile LAS unsigned* st) {
    XcdBarrier b; b.bar = bar; b.x = xb_xcc_id(); b.st = st;
    if (threadIdx.x == 0) (void)xb_add(&bar[XB_XCNT(b.x)], 1u);
    return b;
}
__device__ __forceinline__ void xcd_barrier_complete(unsigned* bar, unsigned x, unsigned& nloc, unsigned& nx) {
    const unsigned G = gridDim.x * gridDim.y * gridDim.z;
    unsigned sum, cnt, mine, sp = 0u;
    for (;;) {
        sum = 0u; cnt = 0u; mine = 0u;
#pragma unroll
        for (unsigned j = 0; j < 16; ++j) { const unsigned c = xb_ld(&bar[XB_XCNT(j)]); sum += c; cnt += (c > 0u) ? 1u : 0u; mine = (j == x) ? c : mine; }
        if (sum == G) break;
        __builtin_amdgcn_s_sleep(1);
        if ((++sp & 255u) == 0u) { if (xb_ld(&bar[XB_TMO])) break; if (sp > XB_SPIN_CAP) { atomicAdd(&bar[XB_TMO], 1u); break; } }
    }
    nloc = mine > 0u ? mine : 1u; nx = cnt > 0u ? cnt : 1u;
}
__device__ __forceinline__ void xcd_barrier(const XcdBarrier& b) {
    asm volatile("s_waitcnt vmcnt(0)" ::: "memory");
    __syncthreads();
    if (threadIdx.x == 0) {
        unsigned* bar = b.bar;
        __builtin_amdgcn_s_waitcnt(0);
        unsigned nloc = b.st[0], nx = b.st[1];
        if (nloc == 0u) { xcd_barrier_complete(bar, b.x, nloc, nx); b.st[0] = nloc; b.st[1] = nx; }
        const unsigned old = xb_add(&bar[XB_XSUB(b.x)], 1u);
        const unsigned gen = old / nloc;
        if (old + 1u == (gen + 1u) * nloc) {
            __builtin_amdgcn_fence(__ATOMIC_RELEASE, "agent");
            asm volatile("s_waitcnt vmcnt(0)" ::: "memory");
            const unsigned og = xb_add(&bar[XB_TOP], 1u);
            const unsigned tg = og / nx;
            if (og + 1u == (tg + 1u) * nx) xb_add(&bar[XB_TOPGEN], 1u);
            else XB_SPIN(xb_ld(&bar[XB_TOPGEN]) == tg, bar);
            __builtin_amdgcn_fence(__ATOMIC_ACQUIRE, "agent");
            xb_add(&bar[XB_XGEN(b.x)], 1u);
            asm volatile("s_waitcnt vmcnt(0)" ::: "memory");
        } else {
            XB_SPIN(xb_ld(&bar[XB_XGEN(b.x)]) == gen, bar);
            __builtin_amdgcn_fence(__ATOMIC_ACQUIRE, "agent");
            asm volatile("s_waitcnt vmcnt(0)" ::: "memory");
        }
    }
    __syncthreads();
}

#ifndef REP_P2
#define REP_P2 1
#endif
#ifndef REP_P6
#define REP_P6 1
#endif
#ifndef REP_P7
#define REP_P7 1
#endif
constexpr int SHM_BYTES = (64 * LD128 * 2 + 128 * LD64 + 64 * LD64) * 2;
__global__ void __launch_bounds__(256, 2) mega(P p) {
    __shared__ __attribute__((aligned(16))) char shm[SHM_BYTES + 16];
    cg::grid_group grid = cg::this_grid();
    const int G = gridDim.x, bid = blockIdx.x;
    volatile LAS unsigned* xst = (volatile LAS unsigned*)(shm + SHM_BYTES);
    if (threadIdx.x == 0) { xst[0] = 0u; xst[1] = 0u; }
    __syncthreads();
    const XcdBarrier xb = xcd_barrier_post(WS(unsigned, OFF_BAR), xst);

    {
        constexpr int U_WIN = (NIN / 32) * 32, U_WUA = 32 * 16, U_WUR = 32 * 16, U_WOUT = 32 * 32, U_WQ = 32 * 32, U_KEYS = 32, U_MISC = (LP * 8 + 255) / 256;
        constexpr int E0 = U_WIN, E1 = E0 + U_WUA, E2 = E1 + U_WUR, E3 = E2 + U_WOUT, E4 = E3 + U_WQ, E5 = E4 + U_KEYS, E6 = E5 + U_MISC, E7 = E6 + R;
        if (bid == 0 && threadIdx.x < 16) WS(unsigned, OFF_QCNT)[threadIdx.x] = 0u;
        for (int u = bid; u < E7; u += G) {
            if (u < E0) d_transpose(p.w_in, WS(bf16_t, OFF_WIN), 1024, NIN, nullptr, u, shm);
            else if (u < E1) d_transpose(p.w_ua, WS(bf16_t, OFF_WUA), 512, 1024, nullptr, u - E0, shm);
            else if (u < E2) d_transpose(p.w_ur, WS(bf16_t, OFF_WUR), 512, 1024, nullptr, u - E1, shm);
            else if (u < E3) d_transpose(p.w_out, WS(bf16_t, OFF_WOUT), 1024, 1024, nullptr, u - E2, shm);
            else if (u < E4) d_transpose(p.w_q, WS(bf16_t, OFF_WQ), 1024, 1024, p.g_ffn, u - E3, shm);
            else if (u < E5) d_cvt(p.keys, WS(bf16_t, OFF_KEYS), (size_t)16 * 128 * 64 / 4, u - E4, U_KEYS);
            else if (u < E6) d_misc(p, u - E5);
            else d_rmsnorm_in(p, u - E6, shm);
        }
    }
    grid.sync();
    ph_gemm_inproj(p, shm);
    xcd_barrier(xb);
    for (int rep = 0; rep < REP_P2; ++rep)
    for (int u = bid; u < 2048; u += G) { if (u < 1024) d_hgrn_A(p, u, shm); else d_attn(p, u - 1024, shm); }
    xcd_barrier(xb);
    for (int u = bid; u < 512; u += G) d_hgrn_scan(p, u);
    xcd_barrier(xb);
    for (int u = bid; u < 1024; u += G) d_hgrn_C(p, u, shm);
    xcd_barrier(xb);
    ph_gemm_merge(p, shm);
    xcd_barrier(xb);
    ph_gemm_out(p, shm);
    d_cvt(p.edown, WS(bf16_t, OFF_EDN), (size_t)16384 * 1024 / 4, bid, G);
    d_cvt(p.eup, WS(bf16_t, OFF_EUP), (size_t)16384 * 1024 / 4, bid, G);
    xcd_barrier(xb);
    ph_gemm_qry(p, shm);
    xcd_barrier(xb);
    for (int rep = 0; rep < REP_P6; ++rep)
    for (int u = bid; u < (T / 256) * 8; u += G) d_peer_topk_simple(p, u);
    xcd_barrier(xb);
    ph_peer_sliced<1>(p, shm);
    xcd_barrier(xb);
    ph_peer_sliced<2>(p, shm);
    xcd_barrier(xb);
    for (int t = bid; t < T; t += G) d_peer_e3(p, t);
}

extern "C" void kernel_launch(void* const* d_in, const int* in_sizes, int n_in, void* d_out, int out_size, void* d_ws, size_t ws_size, hipStream_t stream) {
    P p{};
    p.x = (const float*)d_in[0]; p.meta = (const float*)d_in[1]; p.g_mix = (const float*)d_in[2]; p.w_in = (const float*)d_in[3];
    p.b_in = (const float*)d_in[4]; p.sinks = (const float*)d_in[5]; p.lb_logits = (const float*)d_in[6]; p.g_rec = (const float*)d_in[7];
    p.w_ua = (const float*)d_in[8]; p.w_ur = (const float*)d_in[9]; p.w_out = (const float*)d_in[10]; p.g_ffn = (const float*)d_in[11];
    p.w_q = (const float*)d_in[12]; p.keys = (const float*)d_in[13]; p.edown = (const float*)d_in[14]; p.eup = (const float*)d_in[15];
    p.g_fin = (const float*)d_in[16];
    p.out = (float*)d_out; p.ws = (char*)d_ws;
    static int grid_blocks = 0;
    if (!grid_blocks) {
        int dev = 0, cus = 0, per_cu = 0;
        (void)hipGetDevice(&dev);
        (void)hipDeviceGetAttribute(&cus, hipDeviceAttributeMultiprocessorCount, dev);
        (void)hipOccupancyMaxActiveBlocksPerMultiprocessor(&per_cu, mega, 256, 0);
        if (per_cu > 2) per_cu = 2;
        if (per_cu < 1) per_cu = 1;
        grid_blocks = cus * per_cu;
    }
    (void)hipMemsetAsync((char*)d_ws + OFF_BAR, 0, XCD_BAR_WORDS * 4, stream);
    void* args[] = {&p};
    hipError_t e = hipLaunchCooperativeKernel((void*)mega, dim3(grid_blocks), dim3(256), args, 0, stream);
    if (e != hipSuccess) fprintf(stderr, "cooperative launch failed: %s (grid %d)\n", hipGetErrorString(e), grid_blocks);
}
```

```cpp
#include <hip/hip_runtime.h>
#include <hip/hip_cooperative_groups.h>
#include <stdint.h>
#include <stdio.h>
namespace cg = cooperative_groups;

typedef unsigned short bf16_t;
typedef short bf16x8 __attribute__((ext_vector_type(8)));
typedef float f32x4 __attribute__((ext_vector_type(4)));

constexpr int NB = 4, SEQ = 4096, DM = 1024, LP = 4224, PADF = 112;
constexpr int R = NB * LP;
constexpr int T = NB * SEQ;
constexpr int NIN = 4864;
constexpr float EPS = 1e-6f;

constexpr size_t MiB = 1024 * 1024;
constexpr size_t OFF_WUA = 0;
constexpr size_t OFF_WUR = 1 * MiB;
constexpr size_t OFF_WOUT = 2 * MiB;
constexpr size_t OFF_WQ = 4 * MiB;
constexpr size_t OFF_KEYS = 6 * MiB;
constexpr size_t OFF_ROPE = 6 * MiB + 256 * 1024;
constexpr size_t OFF_LB = OFF_ROPE + 272 * 1024;
constexpr size_t OFF_SSQ = 7 * MiB;
constexpr size_t OFF_B = 8 * MiB;
constexpr size_t OFF_QB = OFF_B;
constexpr size_t OFF_KB = OFF_QB + (size_t)R * 512 * 2;
constexpr size_t OFF_VB = OFF_KB + (size_t)R * 128 * 2;
constexpr size_t OFF_RQ = OFF_VB + (size_t)R * 128 * 2;
constexpr size_t OFF_LOGF = OFF_RQ + (size_t)R * 512 * 2;
constexpr size_t OFF_RI = OFF_LOGF + (size_t)R * 512 * 4;
constexpr size_t OFF_RG = OFF_RI + (size_t)R * 512 * 2;
constexpr size_t OFF_GA = OFF_RG + (size_t)R * 512 * 2;
constexpr size_t OFF_GR = OFF_GA + (size_t)R * 1024 * 2;
constexpr size_t OFF_C = OFF_GR + (size_t)R * 1024 * 2;
constexpr size_t OFF_XN = OFF_C;
constexpr size_t OFF_WIN = OFF_XN + (size_t)R * 1024 * 2;
constexpr size_t OFF_TAIL = OFF_WIN + (size_t)NIN * 1024 * 2;
constexpr size_t OFF_DS = OFF_TAIL;
constexpr size_t OFF_ATT = OFF_C;
constexpr size_t OFF_REC = OFF_ATT + (size_t)T * 512 * 2;
constexpr size_t OFF_MRG = OFF_LOGF;
constexpr size_t OFF_H2B = OFF_RI;
constexpr size_t OFF_EDN = OFF_C;
constexpr size_t OFF_EUP = OFF_EDN + (size_t)16384 * 1024 * 2;
constexpr size_t OFF_QRY = OFF_QB;
constexpr size_t OFF_PIDX = OFF_MRG;
constexpr size_t OFF_PGATE = OFF_PIDX + (size_t)T * 128 * 4;
constexpr size_t OFF_RSTD = OFF_LB + 4096;
constexpr size_t OFF_BAR = 6 * MiB + 640 * 1024;
constexpr size_t OFF_QCNT = OFF_LB + 2048;
constexpr size_t OFF_PART = OFF_GA;
constexpr size_t OFF_SSQ2 = OFF_QB;
static_assert(OFF_SSQ2 + (size_t)8 * T * 4 <= OFF_LOGF, "ssq2 overlay");
static_assert(OFF_PART + 8 * (size_t)T * 128 * 4 <= OFF_C, "part overlay");
static_assert(OFF_QCNT + 256 <= OFF_RSTD && OFF_RSTD + (size_t)T * 4 <= OFF_BAR && OFF_BAR + 3456 * 4 <= OFF_SSQ, "qcnt/rstd/bar");
static_assert(OFF_EUP + (size_t)16384 * 1024 * 2 <= 256 * MiB, "ws overflow");
static_assert(OFF_DS + (size_t)16 * 64 * 16384 * 2 <= 256 * MiB, "ws overflow");
static_assert(OFF_REC + (size_t)T * 512 * 2 <= OFF_TAIL, "overlay");
static_assert(OFF_QRY + (size_t)T * 1024 * 2 <= OFF_LOGF, "qry overlay");
static_assert(OFF_PGATE + (size_t)T * 128 * 4 <= OFF_RI, "pidx overlay");

struct P {
    const float *x, *meta, *g_mix, *w_in, *b_in, *sinks, *lb_logits, *g_rec, *w_ua, *w_ur, *w_out, *g_ffn, *w_q, *keys, *edown, *eup, *g_fin;
    float* out;
    char* ws;
};
#define WS(type, off) ((type*)(p.ws + (off)))

__device__ __forceinline__ bf16_t f2bf(float f) {
    uint32_t u = __float_as_uint(f);
    u += 0x7FFFu + ((u >> 16) & 1u);
    return (bf16_t)(u >> 16);
}
__device__ __forceinline__ float bf2f(bf16_t h) { return __uint_as_float(((uint32_t)h) << 16); }
__device__ __forceinline__ uint32_t pack2(float lo, float hi) { return (uint32_t)f2bf(lo) | ((uint32_t)f2bf(hi) << 16); }
__device__ __forceinline__ float sigmoidf_(float v) { return 1.f / (1.f + __expf(-v)); }

__device__ __forceinline__ float wave_sum(float v) {
#pragma unroll
    for (int o = 32; o > 0; o >>= 1) v += __shfl_xor(v, o);
    return v;
}

typedef __bf16 bf16v2 __attribute__((ext_vector_type(2)));
__device__ __forceinline__ float dot2bf(uint32_t a, uint32_t b, float c) {
    union { uint32_t u; bf16v2 v; } x, y; x.u = a; y.u = b;
    return __builtin_amdgcn_fdot2_f32_bf16(x.v, y.v, c, false);
}
__device__ __forceinline__ float row_sum16(float v) {
    v += __builtin_amdgcn_update_dpp(0.f, v, 0xB1, 0xF, 0xF, false);
    v += __builtin_amdgcn_update_dpp(0.f, v, 0x4E, 0xF, 0xF, false);
    v += __builtin_amdgcn_update_dpp(0.f, v, 0x141, 0xF, 0xF, false);
    v += __builtin_amdgcn_update_dpp(0.f, v, 0x140, 0xF, 0xF, false);
    return v;
}
__device__ __forceinline__ void d_transpose(const float* __restrict__ W, bf16_t* __restrict__ Wt, int K, int N, const float* __restrict__ rs, int unit, char* shm) {
    float (*tile)[33] = (float (*)[33])shm;
    const int ntn = N / 32;
    const int k0 = (unit / ntn) * 32, n0 = (unit % ntn) * 32, tx = threadIdx.x & 31, ty = threadIdx.x >> 5;
#pragma unroll
    for (int i = 0; i < 4; ++i) {
        const int k = k0 + ty + i * 8;
        tile[ty + i * 8][tx] = W[(size_t)k * N + n0 + tx] * (rs ? rs[k] : 1.f);
    }
    __syncthreads();
#pragma unroll
    for (int i = 0; i < 4; ++i) {
        const int n = n0 + ty + i * 8;
        Wt[(size_t)n * K + k0 + tx] = f2bf(tile[tx][ty + i * 8]);
    }
    __syncthreads();
}

__device__ __forceinline__ void d_cvt(const float* __restrict__ src, bf16_t* __restrict__ dst, size_t n4, int vblk, int nvblk) {
    for (size_t i = (size_t)vblk * 256 + threadIdx.x; i < n4; i += (size_t)nvblk * 256) {
        const float4 v = ((const float4*)src)[i];
        ushort4 o; o.x = f2bf(v.x); o.y = f2bf(v.y); o.z = f2bf(v.z); o.w = f2bf(v.w);
        ((ushort4*)dst)[i] = o;
    }
}

__device__ __forceinline__ void d_misc(const P& p, int unit) {
    const int gid = unit * 256 + threadIdx.x;
    if (gid < LP * 8) {
        const int pp = gid >> 3, i = gid & 7;
        const double inv = pow(500000.0, -(double)i / 8.0);
        const double ang = (double)(pp - PADF) * inv;
        float2 cs; cs.x = (float)cos(ang); cs.y = (float)sin(ang);
        WS(float2, OFF_ROPE)[gid] = cs;
    }
    if (gid < 512) {
        const float l0 = p.lb_logits[gid], l1 = p.lb_logits[512 + gid];
        WS(float, OFF_LB)[gid] = 1.f / (1.f + expf(l1 - l0));
    }
}

__device__ __forceinline__ void d_rmsnorm_in(const P& p, int r, char* shm) {
    float* red = (float*)shm;
    const int b = r / LP, pp = r % LP, tid = threadIdx.x;
    bf16_t* dst = WS(bf16_t, OFF_XN) + (size_t)r * DM;
    if (pp < PADF) { ((ushort4*)dst)[tid] = make_ushort4(0, 0, 0, 0); return; }
    const float* src = (pp < 128) ? (p.meta + (size_t)(pp - PADF) * DM) : (p.x + ((size_t)b * SEQ + (pp - 128)) * DM);
    const float4 v = ((const float4*)src)[tid];
    float ss = v.x * v.x + v.y * v.y + v.z * v.z + v.w * v.w;
    ss = wave_sum(ss);
    if ((tid & 63) == 0) red[tid >> 6] = ss;
    __syncthreads();
    ss = red[0] + red[1] + red[2] + red[3];
    const float rstd = rsqrtf(ss * (1.f / DM) + EPS);
    const float4 g = ((const float4*)p.g_mix)[tid];
    ushort4 o; o.x = f2bf(v.x * rstd * g.x); o.y = f2bf(v.y * rstd * g.y); o.z = f2bf(v.z * rstd * g.z); o.w = f2bf(v.w * rstd * g.w);
    ((ushort4*)dst)[tid] = o;
    __syncthreads();
}

__device__ __forceinline__ void glds16(const void* src, void* lds) { __builtin_amdgcn_global_load_lds((const unsigned*)src, (unsigned*)lds, 16, 0, 0); }

__device__ __forceinline__ void gemm_kloop(const bf16_t* __restrict__ A, int lda, const bf16_t* __restrict__ Bt, int ldb, int K, int brow, int bcol,
                                           f32x4 (&acc)[4][4], char* shm) {
    const int tid = threadIdx.x, wid = tid >> 6, lane = tid & 63, wr = wid >> 1, wc = wid & 1, fr = lane & 15, fq = lane >> 4;
    const int sr = tid >> 3, sc = ((tid & 7) ^ ((sr >> 1) & 7)) * 8;
    const bf16_t* ag = A + (size_t)(brow + sr) * lda + sc;
    const bf16_t* bg = Bt + (size_t)(bcol + sr) * ldb + sc;
    const int nt = K >> 6;
#pragma unroll
    for (int i = 0; i < 4; ++i) {
        glds16(ag + (size_t)(32 * i) * lda, shm + tid * 16 + i * 4096);
        glds16(bg + (size_t)(32 * i) * ldb, shm + 16384 + tid * 16 + i * 4096);
    }
    asm volatile("s_waitcnt vmcnt(0)" ::: "memory");
    __syncthreads();
    const int arow = wr * 64 + fr, brw = wc * 64 + fr;
    const int swz = (fr >> 1) & 7;
    for (int kt = 0; kt < nt; ++kt) {
        char* SA = shm + (kt & 1) * 32768;
        char* SB = SA + 16384;
        if (kt + 1 < nt) {
            char* NA = shm + ((kt + 1) & 1) * 32768;
#pragma unroll
            for (int i = 0; i < 4; ++i) {
                glds16(ag + (size_t)(32 * i) * lda + (kt + 1) * 64, NA + tid * 16 + i * 4096);
                glds16(bg + (size_t)(32 * i) * ldb + (kt + 1) * 64, NA + 16384 + tid * 16 + i * 4096);
            }
        }
#pragma unroll
        for (int ks = 0; ks < 2; ++ks) {
            bf16x8 a[4], b[4];
            const int coff = (((ks * 4 + fq) ^ swz) << 4);
#pragma unroll
            for (int m = 0; m < 4; ++m) a[m] = *(const bf16x8*)(SA + (arow + m * 16) * 128 + coff);
#pragma unroll
            for (int n = 0; n < 4; ++n) b[n] = *(const bf16x8*)(SB + (brw + n * 16) * 128 + coff);
#pragma unroll
            for (int m = 0; m < 4; ++m)
#pragma unroll
                for (int n = 0; n < 4; ++n) acc[m][n] = __builtin_amdgcn_mfma_f32_16x16x32_bf16(a[m], b[n], acc[m][n], 0, 0, 0);
        }
        asm volatile("s_waitcnt vmcnt(0)" ::: "memory");
        __syncthreads();
    }
}

__device__ __forceinline__ void zero_acc(f32x4 (&acc)[4][4]) {
#pragma unroll
    for (int m = 0; m < 4; ++m)
#pragma unroll
        for (int n = 0; n < 4; ++n) acc[m][n] = (f32x4){0.f, 0.f, 0.f, 0.f};
}

constexpr int EPI_LD = 136;
__device__ __forceinline__ void tile_store_bf16(const char* shm, bf16_t* dst, int ld) {
    __syncthreads();
#pragma unroll
    for (int i = 0; i < 8; ++i) {
        const int q = threadIdx.x + 256 * i, r = q >> 4, c = q & 15;
        *(uint4*)(dst + (size_t)r * ld + c * 8) = *(const uint4*)(shm + (r * EPI_LD + c * 8) * 2);
    }
    __syncthreads();
}

__device__ __forceinline__ void tile_load_bf16(char* shm, const bf16_t* srcp, int ld) {
#pragma unroll
    for (int i = 0; i < 8; ++i) {
        const int q = threadIdx.x + 256 * i, r = q >> 4, c = q & 15;
        *(uint4*)(shm + (r * EPI_LD + c * 8) * 2) = *(const uint4*)(srcp + (size_t)r * ld + c * 8);
    }
}

__device__ __forceinline__ void ph_gemm_inproj(const P& p, char* shm) {
    const int tid = threadIdx.x, wid = tid >> 6, lane = tid & 63, wr = wid >> 1, wc = wid & 1, fr = lane & 15, fq = lane >> 4;
    constexpr int NT_N = NIN / 128, NT_M = R / 128;
    const float2* rope = WS(float2, OFF_ROPE);
    const float* lbv = WS(float, OFF_LB);
    for (int tile = blockIdx.x; tile < NT_N * NT_M; tile += gridDim.x) {
        const int pm = tile / NT_N, pn = tile % NT_N, brow_ = pm * 128, bcol_ = pn * 128;
        f32x4 acc[4][4]; zero_acc(acc);
        int brow = brow_, bcol = bcol_;
        gemm_kloop(WS(bf16_t, OFF_XN), DM, WS(bf16_t, OFF_WIN), DM, DM, brow, bcol, acc, shm);
        asm volatile("" : "+s"(brow), "+s"(bcol));
        if (bcol >= 1280 && bcol < 1792) {
#pragma unroll
            for (int n = 0; n < 4; ++n) {
                const int col = bcol + wc * 64 + n * 16 + fr;
                const float bv = p.b_in[col], lb = lbv[col - 1280];
                float run = 0.f;
#pragma unroll
                for (int m = 0; m < 4; ++m) {
                    float c[4];
#pragma unroll
                    for (int j = 0; j < 4; ++j) {
                        const int row = brow + wr * 64 + m * 16 + fq * 4 + j;
                        const float v = acc[m][n][j] + bv;
                        const float f = lb + (1.f - lb) * sigmoidf_(v);
                        const float lf = ((row % LP) < PADF) ? 0.f : __logf(f);
                        c[j] = lf + (j ? c[j - 1] : 0.f);
                    }
                    const float x = c[3];
                    const float y = __shfl_up(x, 16);
                    float incl = x + (fq >= 1 ? y : 0.f);
                    const float z = __shfl_up(incl, 32);
                    incl += (fq >= 2 ? z : 0.f);
                    const float excl = incl - x;
                    const float tot = __shfl(incl, fr + 48);
#pragma unroll
                    for (int j = 0; j < 4; ++j) {
                        const int row = brow + wr * 64 + m * 16 + fq * 4 + j;
                        WS(float, OFF_LOGF)[(size_t)row * 512 + (col - 1280)] = run + excl + c[j];
                    }
                    run += tot;
                }
            }
        } else {
            bf16_t* st = (bf16_t*)shm;
            const int kind = (bcol < 512) ? 0 : (bcol < 640) ? 1 : (bcol < 2304) ? 2 : (bcol < 2816) ? 3 : 4;
#pragma unroll
            for (int m = 0; m < 4; ++m)
#pragma unroll
                for (int n = 0; n < 4; ++n) {
                    const int cl = wc * 64 + n * 16 + fr;
                    const float bv = p.b_in[bcol + cl];
#pragma unroll
                    for (int j = 0; j < 4; ++j) {
                        const int rl = wr * 64 + m * 16 + fq * 4 + j;
                        float v = acc[m][n][j] + bv;
                        if (kind <= 1) {
                            if (n == 0) {
                                const float other = __shfl_xor(v, 8);
                                const float2 cs = rope[((brow + rl) % LP) * 8 + (fr & 7)];
                                v = (fr < 8) ? (v * cs.x - other * cs.y) : (v * cs.x + other * cs.y);
                            }
                            if (kind == 0) v *= 0.125f;
                        } else if (kind == 3) v = v * sigmoidf_(v);
                        else if (kind == 4) v = sigmoidf_(v);
                        st[rl * EPI_LD + cl] = f2bf(v);
                    }
                }
            bf16_t* dst; int ld;
            if (bcol < 512) { dst = WS(bf16_t, OFF_QB) + bcol; ld = 512; }
            else if (bcol < 640) { dst = WS(bf16_t, OFF_KB); ld = 128; }
            else if (bcol < 768) { dst = WS(bf16_t, OFF_VB); ld = 128; }
            else if (bcol < 1280) { dst = WS(bf16_t, OFF_RQ) + (bcol - 768); ld = 512; }
            else if (bcol < 2304) { dst = WS(bf16_t, OFF_RI) + (bcol - 1792); ld = 512; }
            else if (bcol < 2816) { dst = WS(bf16_t, OFF_RG) + (bcol - 2304); ld = 512; }
            else if (bcol < 3840) { dst = WS(bf16_t, OFF_GA) + (bcol - 2816); ld = 1024; }
            else { dst = WS(bf16_t, OFF_GR) + (bcol - 3840); ld = 1024; }
            tile_store_bf16(shm, dst + (size_t)brow * ld, ld);
        }
    }
}

__device__ __forceinline__ void ph_gemm_merge(const P& p, char* shm) {
    const int tid = threadIdx.x, wid = tid >> 6, lane = tid & 63, wr = wid >> 1, wc = wid & 1, fr = lane & 15, fq = lane >> 4;
    constexpr int NT_N = 8, NT_M = T / 128;
    bf16_t* st = (bf16_t*)shm;
    for (int tile = blockIdx.x; tile < NT_N * NT_M; tile += gridDim.x) {
        const int pm = tile / NT_N, pn = tile % NT_N, brow = pm * 128, bcol = pn * 128;
        f32x4 acc[4][4];
        uint32_t tt[4][4][2];
#pragma unroll 1
        for (int pass = 0; pass < 2; ++pass) {
            zero_acc(acc);
            gemm_kloop(WS(bf16_t, pass ? OFF_REC : OFF_ATT), 512, WS(bf16_t, pass ? OFF_WUR : OFF_WUA), 512, 512, brow, bcol, acc, shm);
            int erow = brow, ecol = bcol;
            asm volatile("" : "+s"(erow), "+s"(ecol));
            tile_load_bf16(shm, WS(bf16_t, pass ? OFF_GR : OFF_GA) + (size_t)(erow + 128 * (erow / SEQ + 1)) * 1024 + ecol, 1024);
            __syncthreads();
#pragma unroll
            for (int m = 0; m < 4; ++m)
#pragma unroll
                for (int n = 0; n < 4; ++n) {
                    const int cl = wc * 64 + n * 16 + fr;
                    float v[4];
#pragma unroll
                    for (int j = 0; j < 4; ++j) v[j] = acc[m][n][j] * bf2f(st[(wr * 64 + m * 16 + fq * 4 + j) * EPI_LD + cl]);
                    if (pass == 0) { tt[m][n][0] = pack2(v[0], v[1]); tt[m][n][1] = pack2(v[2], v[3]); }
                    else {
                        st[(wr * 64 + m * 16 + fq * 4 + 0) * EPI_LD + cl] = f2bf(v[0] + __uint_as_float(tt[m][n][0] << 16));
                        st[(wr * 64 + m * 16 + fq * 4 + 1) * EPI_LD + cl] = f2bf(v[1] + __uint_as_float(tt[m][n][0] & 0xFFFF0000u));
                        st[(wr * 64 + m * 16 + fq * 4 + 2) * EPI_LD + cl] = f2bf(v[2] + __uint_as_float(tt[m][n][1] << 16));
                        st[(wr * 64 + m * 16 + fq * 4 + 3) * EPI_LD + cl] = f2bf(v[3] + __uint_as_float(tt[m][n][1] & 0xFFFF0000u));
                    }
                }
            if (pass == 0) __syncthreads();
            else tile_store_bf16(shm, WS(bf16_t, OFF_MRG) + (size_t)erow * 1024 + ecol, 1024);
        }
    }
}

__device__ __forceinline__ void ph_gemm_out(const P& p, char* shm) {
    const int tid = threadIdx.x, wid = tid >> 6, lane = tid & 63, wr = wid >> 1, wc = wid & 1, fr = lane & 15, fq = lane >> 4;
    constexpr int NT_N = 8, NT_M = T / 128;
    bf16_t* st = (bf16_t*)shm;
    for (int tile = blockIdx.x; tile < NT_N * NT_M; tile += gridDim.x) {
        const int pm = tile / NT_N, pn = tile % NT_N, brow_ = pm * 128, bcol_ = pn * 128;
        f32x4 acc[4][4]; zero_acc(acc);
        int brow = brow_, bcol = bcol_;
        gemm_kloop(WS(bf16_t, OFF_MRG), 1024, WS(bf16_t, OFF_WOUT), 1024, 1024, brow, bcol, acc, shm);
        asm volatile("" : "+s"(brow), "+s"(bcol));
#pragma unroll
        for (int m = 0; m < 4; ++m)
#pragma unroll
            for (int n = 0; n < 4; ++n)
#pragma unroll
                for (int j = 0; j < 4; ++j) st[(wr * 64 + m * 16 + fq * 4 + j) * EPI_LD + wc * 64 + n * 16 + fr] = f2bf(acc[m][n][j]);
        __syncthreads();
#pragma unroll 2
        for (int i = 0; i < 8; ++i) {
            const int q = tid + 256 * i, r = q >> 4, c = q & 15;
            const uint4 a = *(const uint4*)(shm + (r * EPI_LD + c * 8) * 2);
            const float* xp = p.x + (size_t)(brow + r) * DM + bcol + c * 8;
            const float4 x0 = *(const float4*)xp, x1 = *(const float4*)(xp + 4);
            const float h0 = x0.x + __uint_as_float(a.x << 16), h1 = x0.y + __uint_as_float(a.x & 0xFFFF0000u);
            const float h2 = x0.z + __uint_as_float(a.y << 16), h3 = x0.w + __uint_as_float(a.y & 0xFFFF0000u);
            const float h4 = x1.x + __uint_as_float(a.z << 16), h5 = x1.y + __uint_as_float(a.z & 0xFFFF0000u);
            const float h6 = x1.z + __uint_as_float(a.w << 16), h7 = x1.w + __uint_as_float(a.w & 0xFFFF0000u);
            *(uint4*)(WS(bf16_t, OFF_H2B) + (size_t)(brow + r) * DM + bcol + c * 8) = make_uint4(pack2(h0, h1), pack2(h2, h3), pack2(h4, h5), pack2(h6, h7));
            float ss = (h0 * h0 + h1 * h1) + (h2 * h2 + h3 * h3) + (h4 * h4 + h5 * h5) + (h6 * h6 + h7 * h7);
            ss = row_sum16(ss);
            if (c == 0) WS(float, OFF_SSQ)[(size_t)pn * T + brow + r] = ss;
        }
        __syncthreads();
    }
}

__device__ __forceinline__ float row_rstd(const P& p, int row) {
    float s = 0.f;
#pragma unroll
    for (int i = 0; i < 8; ++i) s += WS(float, OFF_SSQ)[(size_t)i * T + row];
    return rsqrtf(s * (1.f / DM) + EPS);
}

__device__ __forceinline__ void ph_gemm_qry(const P& p, char* shm) {
    const int tid = threadIdx.x, wid = tid >> 6, lane = tid & 63, wr = wid >> 1, wc = wid & 1, fr = lane & 15, fq = lane >> 4;
    constexpr int NT_N = 8, NT_M = T / 128;
    for (int tile = blockIdx.x; tile < NT_N * NT_M; tile += gridDim.x) {
        const int pm = tile / NT_N, pn = tile % NT_N, brow_ = pm * 128, bcol_ = pn * 128;
        f32x4 acc[4][4]; zero_acc(acc);
        int brow = brow_, bcol = bcol_;
        gemm_kloop(WS(bf16_t, OFF_H2B), 1024, WS(bf16_t, OFF_WQ), 1024, 1024, brow, bcol, acc, shm);
        asm volatile("" : "+s"(brow), "+s"(bcol));
#pragma unroll
        for (int m = 0; m < 4; ++m)
#pragma unroll
            for (int j = 0; j < 4; ++j) {
                const int row = brow + wr * 64 + m * 16 + fq * 4 + j;
                const float rstd = row_rstd(p, row);
                if (bcol == 0 && wc == 0 && fr == 0) WS(float, OFF_RSTD)[row] = rstd;
#pragma unroll
                for (int n = 0; n < 4; ++n) {
                    const int col = bcol + wc * 64 + n * 16 + fr;
                    WS(bf16_t, OFF_QRY)[(size_t)row * DM + col] = f2bf(acc[m][n][j] * rstd);
                }
            }
    }
}

#if ATTN_SIMPLE
__device__ __forceinline__ void d_attn_simple(const P& p, int unit) {
    const int gid = unit * 256 + threadIdx.x;
    const int hq = gid / T, t = gid % T, b = t / SEQ, s = t % SEQ, pq = 128 + s, kvh = hq >> 2;
    const bf16_t* qp = WS(bf16_t, OFF_QB) + ((size_t)b * LP + pq) * 512 + hq * 64;
    float q[64], o[64];
#pragma unroll
    for (int d = 0; d < 64; ++d) { q[d] = bf2f(qp[d]); o[d] = 0.f; }
    float m = p.sinks[hq], l = 1.f;
    const bf16_t* kbase = WS(bf16_t, OFF_KB) + (size_t)b * LP * 128 + kvh * 64;
    const bf16_t* vbase = WS(bf16_t, OFF_VB) + (size_t)b * LP * 128 + kvh * 64;
    const int lo = (pq - 127 > 128) ? (pq - 127) : 128;
    const int nkeys = 16 + (pq - lo + 1);
    for (int i = 0; i < nkeys; ++i) {
        const int pk = (i < 16) ? (PADF + i) : (lo + i - 16);
        const bf16_t* kp = kbase + (size_t)pk * 128;
        const bf16_t* vp = vbase + (size_t)pk * 128;
        float sc = 0.f;
#pragma unroll
        for (int d = 0; d < 64; ++d) sc += q[d] * bf2f(kp[d]);
        const float mn = fmaxf(m, sc), a = __expf(m - mn), e = __expf(sc - mn);
        l = l * a + e;
#pragma unroll
        for (int d = 0; d < 64; ++d) o[d] = o[d] * a + e * bf2f(vp[d]);
        m = mn;
    }
    const float inv = 1.f / l;
    bf16_t* op = WS(bf16_t, OFF_ATT) + (size_t)t * 512 + hq * 64;
#pragma unroll
    for (int d = 0; d < 64; ++d) op[d] = f2bf(o[d] * inv);
}

#endif
constexpr int LDV = 280;
__device__ __forceinline__ void d_attn(const P& p, int unit, char* shm) {
    bf16_t* VT = (bf16_t*)shm;
    const int tid = threadIdx.x, lane = tid & 63, fr = lane & 15, fq = lane >> 4;
    const int w = __builtin_amdgcn_readfirstlane(tid >> 6);
    const int hq = unit & 7, n = ((unit >> 3) & 31) + 1, b = unit >> 8, kvh = hq >> 2;
    const size_t rb = (size_t)b * LP;
    const int kb0 = 128 * (n - 1);
    const bf16_t* kbp = WS(bf16_t, OFF_KB) + kvh * 64;
    const bf16_t* vbp = WS(bf16_t, OFF_VB) + kvh * 64;
#pragma unroll 1
    for (int i = 0; i < 9; ++i) {
        const int c = tid + 256 * i;
        if (c < 2176) {
            const int x = c >> 3, dc = c & 7;
            const int pos = (x < 256) ? (kb0 + x) : (PADF + x - 256);
            const uint4 v = *(const uint4*)(vbp + (rb + pos) * 128 + 8 * dc);
            bf16_t* dst = VT + (8 * dc) * LDV + x;
            dst[0 * LDV] = (bf16_t)(v.x & 0xFFFF); dst[1 * LDV] = (bf16_t)(v.x >> 16);
            dst[2 * LDV] = (bf16_t)(v.y & 0xFFFF); dst[3 * LDV] = (bf16_t)(v.y >> 16);
            dst[4 * LDV] = (bf16_t)(v.z & 0xFFFF); dst[5 * LDV] = (bf16_t)(v.z >> 16);
            dst[6 * LDV] = (bf16_t)(v.w & 0xFFFF); dst[7 * LDV] = (bf16_t)(v.w >> 16);
        }
    }
    __syncthreads();
    bf16x8 qf[2][2];
#pragma unroll
    for (int u = 0; u < 2; ++u)
#pragma unroll
        for (int ks = 0; ks < 2; ++ks)
            qf[u][ks] = *(const bf16x8*)(WS(bf16_t, OFF_QB) + (rb + 128 * n + 32 * w + 16 * u + fr) * 512 + hq * 64 + 32 * ks + 8 * fq);
    f32x4 s[11][2];
#pragma unroll
    for (int tt = 0; tt < 11; ++tt) {
        const int x0 = (tt < 10) ? (32 * w + 16 * tt) : 256;
        const int pos = ((tt < 10) ? (kb0 + x0) : PADF) + fr;
        const bf16x8 k0 = *(const bf16x8*)(kbp + (rb + pos) * 128 + 8 * fq);
        const bf16x8 k1 = *(const bf16x8*)(kbp + (rb + pos) * 128 + 32 + 8 * fq);
#pragma unroll
        for (int u = 0; u < 2; ++u) {
            f32x4 c = (f32x4){0.f, 0.f, 0.f, 0.f};
            c = __builtin_amdgcn_mfma_f32_16x16x32_bf16(k0, qf[u][0], c, 0, 0, 0);
            c = __builtin_amdgcn_mfma_f32_16x16x32_bf16(k1, qf[u][1], c, 0, 0, 0);
            if (tt < 10) {
                const int xq = 128 + 32 * w + 16 * u + fr;
#pragma unroll
                for (int j = 0; j < 4; ++j) {
                    const int x = x0 + 4 * fq + j, dq = xq - x;
                    const bool ok = (dq >= 0) && (dq < 128) && (kb0 + x >= 128);
                    c[j] = ok ? c[j] : -1.0e30f;
                }
            }
            s[tt][u] = c;
        }
    }
    const float sink = p.sinks[hq];
    float inv[2];
#pragma unroll
    for (int u = 0; u < 2; ++u) {
        float m = sink;
#pragma unroll
        for (int tt = 0; tt < 11; ++tt)
#pragma unroll
            for (int j = 0; j < 4; ++j) m = fmaxf(m, s[tt][u][j]);
        m = fmaxf(m, __shfl_xor(m, 16)); m = fmaxf(m, __shfl_xor(m, 32));
        float l = 0.f;
#pragma unroll
        for (int tt = 0; tt < 11; ++tt)
#pragma unroll
            for (int j = 0; j < 4; ++j) { const float e = __expf(s[tt][u][j] - m); s[tt][u][j] = e; l += e; }
        l += __shfl_xor(l, 16); l += __shfl_xor(l, 32);
        l += __expf(sink - m);
        inv[u] = 1.f / l;
    }
    f32x4 o[4][2];
#pragma unroll
    for (int dt = 0; dt < 4; ++dt)
#pragma unroll
        for (int u = 0; u < 2; ++u) o[dt][u] = (f32x4){0.f, 0.f, 0.f, 0.f};
#pragma unroll
    for (int g = 0; g < 6; ++g) {
        const int xa = (g < 5) ? (32 * w + 32 * g) : 256, xb = (g < 5) ? (xa + 16) : 256;
        bf16x8 pf[2];
#pragma unroll
        for (int u = 0; u < 2; ++u) {
#pragma unroll
            for (int j = 0; j < 4; ++j) {
                pf[u][j] = (short)f2bf(s[2 * g][u][j]);
                pf[u][4 + j] = (g < 5) ? (short)f2bf(s[(g < 5) ? (2 * g + 1) : 0][u][j]) : (short)0;
            }
        }
#pragma unroll
        for (int dt = 0; dt < 4; ++dt) {
            const uint2 a0 = *(const uint2*)(VT + (16 * dt + fr) * LDV + xa + 4 * fq);
            const uint2 a1 = *(const uint2*)(VT + (16 * dt + fr) * LDV + xb + 4 * fq);
            union { uint4 q; bf16x8 v; } av; av.q = make_uint4(a0.x, a0.y, a1.x, a1.y);
#pragma unroll
            for (int u = 0; u < 2; ++u) o[dt][u] = __builtin_amdgcn_mfma_f32_16x16x32_bf16(av.v, pf[u], o[dt][u], 0, 0, 0);
        }
    }
#pragma unroll
    for (int u = 0; u < 2; ++u) {
        const size_t t = (size_t)b * SEQ + 128 * (n - 1) + 32 * w + 16 * u + fr;
#pragma unroll
        for (int dt = 0; dt < 4; ++dt) {
            uint2 ov;
            ov.x = pack2(o[dt][u][0] * inv[u], o[dt][u][1] * inv[u]);
            ov.y = pack2(o[dt][u][2] * inv[u], o[dt][u][3] * inv[u]);
            *(uint2*)(WS(bf16_t, OFF_ATT) + t * 512 + hq * 64 + 16 * dt + 4 * fq) = ov;
        }
    }
    __syncthreads();
}

#if HGRN_SIMPLE
__device__ __forceinline__ void d_hgrn_simple(const P& p, int bh, char* shm) {
    float (*fs)[128] = (float (*)[128])shm;
    float (*ks)[128] = (float (*)[128])(shm + 4096);
    float (*qs)[128] = (float (*)[128])(shm + 8192);
    float (*os)[128] = (float (*)[128])(shm + 12288);
    float (*red)[2] = (float (*)[2])(shm + 16384);
    const int b = bh >> 2, h = bh & 3, e = threadIdx.x & 127;
    const bool act = threadIdx.x < 128;
    float S[128];
#pragma unroll
    for (int d = 0; d < 128; ++d) S[d] = 0.f;
    const float g = p.g_rec[h * 128 + e];
    for (int p0 = PADF; p0 < LP; p0 += 8) {
        float v[8];
        if (act) {
#pragma unroll
            for (int i = 0; i < 8; ++i) {
                const size_t r = (size_t)b * LP + p0 + i;
                const float lf = WS(float, OFF_LOGF)[r * 512 + h * 128 + e] - (((p0 + i) & 63) ? WS(float, OFF_LOGF)[(r - 1) * 512 + h * 128 + e] : 0.f);
                const float f = __expf(lf);
                fs[i][e] = f; ks[i][e] = 1.f - f;
                qs[i][e] = bf2f(WS(bf16_t, OFF_RQ)[r * 512 + h * 128 + e]);
                v[i] = bf2f(WS(bf16_t, OFF_RI)[r * 512 + h * 128 + e]);
            }
        }
        __syncthreads();
        if (act) {
#pragma unroll
            for (int i = 0; i < 8; ++i) {
                float o = 0.f;
#pragma unroll
                for (int d = 0; d < 128; ++d) { S[d] = fs[i][d] * S[d] + ks[i][d] * v[i]; o += qs[i][d] * S[d]; }
                os[i][e] = o;
                const float ss = wave_sum(o * o);
                if ((e & 63) == 0) red[i][e >> 6] = ss;
            }
        }
        __syncthreads();
        if (act && p0 >= 128) {
#pragma unroll
            for (int i = 0; i < 8; ++i) {
                const size_t r = (size_t)b * LP + p0 + i;
                const size_t t = (size_t)b * SEQ + (p0 + i - 128);
                const float rstd = rsqrtf((red[i][0] + red[i][1]) * (1.f / 128.f) + EPS);
                const float val = os[i][e] * rstd * g * bf2f(WS(bf16_t, OFF_RG)[r * 512 + h * 128 + e]);
                WS(bf16_t, OFF_REC)[t * 512 + h * 128 + e] = f2bf(val);
            }
        }
        __syncthreads();
    }
}

#endif

constexpr int LD64 = 72;
constexpr int LD128 = 136;

__device__ __forceinline__ void d_hgrn_A(const P& p, int unit, char* shm) {
    bf16_t* VT = (bf16_t*)shm;
    bf16_t* KT = (bf16_t*)(shm + 128 * LD64 * 2);
    const int tid = threadIdx.x, wid = tid >> 6, lane = tid & 63, fr = lane & 15, fq = lane >> 4;
    const int bh = unit >> 6, n = (unit & 63) + 1, b = bh >> 2, h = bh & 3;
    const int c = tid & 127, half = tid >> 7;
    const size_t r0 = (size_t)b * LP + 64 * n;
    const float* bb = WS(float, OFF_LOGF) + r0 * 512 + h * 128 + c;
    const bf16_t* vv = WS(bf16_t, OFF_RI) + r0 * 512 + h * 128 + c;
    {
        const float blast = bb[63 * 512];
        float prev = half ? bb[31 * 512] : 0.f;
        const float* bp = bb + (size_t)(32 * half) * 512;
        const bf16_t* vp_ = vv + (size_t)(32 * half) * 512;
#pragma unroll 1
        for (int g = 0; g < 4; ++g) {
            float bs[8]; uint32_t vs[8];
#pragma unroll
            for (int i = 0; i < 8; ++i) { bs[i] = bp[i * 512]; vs[i] = vp_[i * 512]; }
            uint32_t kp[4], vp[4];
#pragma unroll
            for (int i = 0; i < 8; i += 2) {
                const float k0 = (1.f - __expf(bs[i] - prev)) * __expf(blast - bs[i]);
                const float k1 = (1.f - __expf(bs[i + 1] - bs[i])) * __expf(blast - bs[i + 1]);
                prev = bs[i + 1];
                kp[i >> 1] = pack2(k0, k1);
                vp[i >> 1] = vs[i] | (vs[i + 1] << 16);
            }
            *(uint4*)(KT + c * LD64 + 32 * half + 8 * g) = make_uint4(kp[0], kp[1], kp[2], kp[3]);
            *(uint4*)(VT + c * LD64 + 32 * half + 8 * g) = make_uint4(vp[0], vp[1], vp[2], vp[3]);
            bp += 8 * 512; vp_ += 8 * 512;
        }
    }
    __syncthreads();
    f32x4 acc[2][8];
#pragma unroll
    for (int mi = 0; mi < 2; ++mi)
#pragma unroll
        for (int n8 = 0; n8 < 8; ++n8) acc[mi][n8] = (f32x4){0.f, 0.f, 0.f, 0.f};
#pragma unroll
    for (int ks = 0; ks < 2; ++ks) {
        bf16x8 a[2];
#pragma unroll
        for (int mi = 0; mi < 2; ++mi) a[mi] = *(const bf16x8*)(VT + (32 * wid + 16 * mi + fr) * LD64 + 32 * ks + 8 * fq);
#pragma unroll
        for (int n8 = 0; n8 < 8; ++n8) {
            const bf16x8 bf = *(const bf16x8*)(KT + (16 * n8 + fr) * LD64 + 32 * ks + 8 * fq);
#pragma unroll
            for (int mi = 0; mi < 2; ++mi) acc[mi][n8] = __builtin_amdgcn_mfma_f32_16x16x32_bf16(a[mi], bf, acc[mi][n8], 0, 0, 0);
        }
    }
    bf16_t* dst = WS(bf16_t, OFF_DS) + (size_t)unit * 16384;
#pragma unroll
    for (int mi = 0; mi < 2; ++mi)
#pragma unroll
        for (int n8 = 0; n8 < 8; ++n8)
#pragma unroll
            for (int j = 0; j < 4; ++j) dst[(32 * wid + 16 * mi + 4 * fq + j) * 128 + 16 * n8 + fr] = f2bf(acc[mi][n8][j]);
    __syncthreads();
}

__device__ __forceinline__ void d_hgrn_scan(const P& p, int unit) {
    const int gid = unit * 256 + threadIdx.x;
    const int bh = gid >> 13, rem = gid & 8191, e = rem >> 6, d2 = (rem & 63) * 2;
    uint32_t* base = (uint32_t*)(WS(bf16_t, OFF_DS) + (size_t)bh * 64 * 16384 + e * 128 + d2);
    const float* bb = WS(float, OFF_LOGF) + ((size_t)(bh >> 2) * LP + 64 + 63) * 512 + (bh & 3) * 128 + d2;
    float s0 = 0.f, s1 = 0.f;
#pragma unroll 8
    for (int j = 0; j < 64; ++j) {
        const uint32_t x = base[(size_t)j * 8192];
        const float2 bl = *(const float2*)(bb + (size_t)j * 64 * 512);
        s0 = __expf(bl.x) * s0 + __uint_as_float(x << 16);
        s1 = __expf(bl.y) * s1 + __uint_as_float(x & 0xFFFF0000u);
        base[(size_t)j * 8192] = pack2(s0, s1);
    }
}

__device__ __forceinline__ void d_hgrn_C(const P& p, int unit, char* shm) {
    bf16_t* KS = (bf16_t*)shm;
    bf16_t* KD = KS + 64 * LD128;
    bf16_t* VT = KD + 64 * LD128;
    bf16_t* AM = VT + 128 * LD64;
    const int tid = threadIdx.x, lane = tid & 63, fr = lane & 15, fq = lane >> 4;
    const int wi = __builtin_amdgcn_readfirstlane(tid >> 6);
    const int bh = unit >> 6, n = (unit & 63) + 2, b = bh >> 2, h = bh & 3;
    const size_t r0 = (size_t)b * LP + 64 * n;
    const size_t t0 = (size_t)b * SEQ + 64 * n - 128;
    {
        const int c = tid & 127, half = tid >> 7;
        const float* bb = WS(float, OFF_LOGF) + r0 * 512 + h * 128 + c;
        const bf16_t* vv = WS(bf16_t, OFF_RI) + r0 * 512 + h * 128 + c;
        float prev = half ? bb[31 * 512] : 0.f;
        const float* bp = bb + (size_t)(32 * half) * 512;
        const bf16_t* vp_ = vv + (size_t)(32 * half) * 512;
#pragma unroll 1
        for (int g = 0; g < 4; ++g) {
            const int s0 = 32 * half + 8 * g, sb = s0 & ~15;
            const float bend = bb[(size_t)(sb + 15) * 512];
            const float bref = (sb == 0) ? 0.f : bb[(size_t)(sb - 1) * 512];
            float bs[8]; uint32_t vs[8];
#pragma unroll
            for (int i = 0; i < 8; ++i) { bs[i] = bp[i * 512]; vs[i] = vp_[i * 512]; }
#pragma unroll
            for (int i = 0; i < 8; ++i) {
                const float k = 1.f - __expf(bs[i] - prev);
                prev = bs[i];
                KS[(s0 + i) * LD128 + c] = f2bf(k * __expf(bend - bs[i]));
                KD[(s0 + i) * LD128 + c] = f2bf(k * __expf(bref - bs[i]));
            }
            *(uint4*)(VT + c * LD64 + s0) = make_uint4(vs[0] | (vs[1] << 16), vs[2] | (vs[3] << 16), vs[4] | (vs[5] << 16), vs[6] | (vs[7] << 16));
            bp += 8 * 512; vp_ += 8 * 512;
        }
#pragma unroll
        for (int i = 0; i < 9; ++i) ((uint32_t*)AM)[tid + 256 * i] = 0u;
    }
    __syncthreads();
    const int tl = 16 * wi + fr;
    bf16x8 qf[4]; float bt[4][8];
    {
        const bf16_t* qrow = WS(bf16_t, OFF_RQ) + (r0 + tl) * 512 + h * 128 + 8 * fq;
        const float* brow = WS(float, OFF_LOGF) + (r0 + tl) * 512 + h * 128 + 8 * fq;
#pragma unroll
        for (int ks = 0; ks < 4; ++ks) {
            qf[ks] = *(const bf16x8*)(qrow + 32 * ks);
            const float4 x0 = *(const float4*)(brow + 32 * ks), x1 = *(const float4*)(brow + 32 * ks + 4);
            bt[ks][0] = x0.x; bt[ks][1] = x0.y; bt[ks][2] = x0.z; bt[ks][3] = x0.w; bt[ks][4] = x1.x; bt[ks][5] = x1.y; bt[ks][6] = x1.z; bt[ks][7] = x1.w;
        }
    }
    auto qfrag = [&](int ks, const float* refrow) -> bf16x8 {
        float rf[8];
        if (refrow) {
            const float4 x0 = *(const float4*)(refrow + 32 * ks), x1 = *(const float4*)(refrow + 32 * ks + 4);
            rf[0] = x0.x; rf[1] = x0.y; rf[2] = x0.z; rf[3] = x0.w; rf[4] = x1.x; rf[5] = x1.y; rf[6] = x1.z; rf[7] = x1.w;
        } else {
#pragma unroll
            for (int jj = 0; jj < 8; ++jj) rf[jj] = 0.f;
        }
        bf16x8 o;
#pragma unroll
        for (int jj = 0; jj < 8; ++jj) o[jj] = (short)f2bf(bf2f((bf16_t)qf[ks][jj]) * __expf(bt[ks][jj] - rf[jj]));
        return o;
    };
    const float* bchunk = WS(float, OFF_LOGF) + r0 * 512 + h * 128 + 8 * fq;
    f32x4 acc[8];
#pragma unroll
    for (int n8 = 0; n8 < 8; ++n8) acc[n8] = (f32x4){0.f, 0.f, 0.f, 0.f};
    {
        const bf16_t* sp = WS(bf16_t, OFF_DS) + (size_t)unit * 16384 + fr * 128 + 8 * fq;
#pragma unroll
        for (int ks = 0; ks < 4; ++ks) {
            const bf16x8 a = qfrag(ks, nullptr);
#pragma unroll
            for (int n8 = 0; n8 < 8; ++n8) {
                const bf16x8 bf = *(const bf16x8*)(sp + (size_t)n8 * 16 * 128 + 32 * ks);
                acc[n8] = __builtin_amdgcn_mfma_f32_16x16x32_bf16(a, bf, acc[n8], 0, 0, 0);
            }
        }
    }
    for (int j = 0; j < wi; ++j) {
        f32x4 c4 = (f32x4){0.f, 0.f, 0.f, 0.f};
        const float* refrow = bchunk + (size_t)(16 * j + 15) * 512;
#pragma unroll
        for (int ks = 0; ks < 4; ++ks) {
            const bf16x8 a = qfrag(ks, refrow);
            const bf16x8 bf = *(const bf16x8*)(KS + (16 * j + fr) * LD128 + 32 * ks + 8 * fq);
            c4 = __builtin_amdgcn_mfma_f32_16x16x32_bf16(a, bf, c4, 0, 0, 0);
        }
#pragma unroll
        for (int jj = 0; jj < 4; ++jj) AM[(16 * wi + 4 * fq + jj) * LD64 + 16 * j + fr] = f2bf(c4[jj]);
    }
    {
        f32x4 c4 = (f32x4){0.f, 0.f, 0.f, 0.f};
        const float* refrow = (wi > 0) ? (bchunk + (size_t)(16 * wi - 1) * 512) : nullptr;
#pragma unroll
        for (int ks = 0; ks < 4; ++ks) {
            const bf16x8 a = qfrag(ks, refrow);
            const bf16x8 bf = *(const bf16x8*)(KD + (16 * wi + fr) * LD128 + 32 * ks + 8 * fq);
            c4 = __builtin_amdgcn_mfma_f32_16x16x32_bf16(a, bf, c4, 0, 0, 0);
        }
#pragma unroll
        for (int jj = 0; jj < 4; ++jj) AM[(16 * wi + 4 * fq + jj) * LD64 + 16 * wi + fr] = f2bf((fr <= 4 * fq + jj) ? c4[jj] : 0.f);
    }
    __syncthreads();
#pragma unroll
    for (int ks = 0; ks < 2; ++ks) {
        const bf16x8 a = *(const bf16x8*)(AM + (16 * wi + fr) * LD64 + 32 * ks + 8 * fq);
#pragma unroll
        for (int n8 = 0; n8 < 8; ++n8) {
            const bf16x8 bf = *(const bf16x8*)(VT + (16 * n8 + fr) * LD64 + 32 * ks + 8 * fq);
            acc[n8] = __builtin_amdgcn_mfma_f32_16x16x32_bf16(a, bf, acc[n8], 0, 0, 0);
        }
    }
#pragma unroll
    for (int jj = 0; jj < 4; ++jj) {
        float ss = 0.f;
#pragma unroll
        for (int n8 = 0; n8 < 8; ++n8) ss += acc[n8][jj] * acc[n8][jj];
        ss += __shfl_xor(ss, 1); ss += __shfl_xor(ss, 2); ss += __shfl_xor(ss, 4); ss += __shfl_xor(ss, 8);
        const float rstd = rsqrtf(ss * (1.f / 128.f) + EPS);
        const int trow = 16 * wi + 4 * fq + jj;
#pragma unroll
        for (int n8 = 0; n8 < 8; ++n8) {
            const int e = 16 * n8 + fr;
            const float val = acc[n8][jj] * rstd * p.g_rec[h * 128 + e] * bf2f(WS(bf16_t, OFF_RG)[(r0 + trow) * 512 + h * 128 + e]);
            WS(bf16_t, OFF_REC)[(t0 + trow) * 512 + h * 128 + e] = f2bf(val);
        }
        asm volatile("" ::: "memory");
    }
    __syncthreads();
}

#if TOPK_SIMPLE
__device__ __forceinline__ void d_peer_topk_simple(const P& p, int unit) {
    const int t = (unit >> 3) * 256 + threadIdx.x, h = unit & 7;
    const bf16_t* qp = WS(bf16_t, OFF_QRY) + (size_t)t * DM + h * 128;
    float tv[2][16]; int ti[2][16];
#pragma unroll
    for (int pp = 0; pp < 2; ++pp) {
        float q[64];
#pragma unroll
        for (int d = 0; d < 64; ++d) q[d] = bf2f(qp[pp * 64 + d]);
#pragma unroll
        for (int i = 0; i < 16; ++i) { tv[pp][i] = -3.0e38f; ti[pp][i] = 0; }
        const bf16_t* kp = WS(bf16_t, OFF_KEYS) + (size_t)(h * 2 + pp) * 128 * 64;
        for (int n = 0; n < 128; ++n) {
            float sc = 0.f;
#pragma unroll
            for (int d = 0; d < 64; ++d) sc += q[d] * bf2f(kp[n * 64 + d]);
            float xv = sc; int xi = n;
#pragma unroll
            for (int i = 0; i < 16; ++i) {
                if (xv > tv[pp][i]) { const float tf = tv[pp][i]; const int tn = ti[pp][i]; tv[pp][i] = xv; ti[pp][i] = xi; xv = tf; xi = tn; }
            }
        }
    }
    float bv[16]; int bi[16];
#pragma unroll
    for (int i = 0; i < 16; ++i) { bv[i] = -3.0e38f; bi[i] = 0; }
#pragma unroll
    for (int i = 0; i < 16; ++i)
#pragma unroll
        for (int j = 0; j < 16; ++j) {
            if ((i + 1) * (j + 1) <= 16) {
                float xv = tv[0][i] + tv[1][j]; int xi = ti[0][i] * 128 + ti[1][j];
#pragma unroll
                for (int k = 0; k < 16; ++k) {
                    if (xv > bv[k]) { const float tf = bv[k]; const int tn = bi[k]; bv[k] = xv; bi[k] = xi; xv = tf; xi = tn; }
                }
            }
        }
    float se = 0.f, ev[16];
#pragma unroll
    for (int k = 0; k < 16; ++k) { ev[k] = __expf(bv[k] - bv[0]); se += ev[k]; }
    const float inv = 1.f / se;
#pragma unroll
    for (int k = 0; k < 16; ++k) {
        WS(int, OFF_PIDX)[(size_t)t * 128 + h * 16 + k] = bi[k];
        WS(float, OFF_PGATE)[(size_t)t * 128 + h * 16 + k] = ev[k] * inv;
    }
}

#endif
template <int N> __device__ __forceinline__ void bitonic_sort_desc(float (&v)[N]) {
#pragma unroll
    for (int k = 2; k <= N; k <<= 1)
#pragma unroll
        for (int j = k >> 1; j > 0; j >>= 1)
#pragma unroll
            for (int i = 0; i < N; ++i) {
                const int l = i ^ j;
                if (l > i) {
                    const bool desc = ((i & k) == 0);
                    const float a = v[i], b = v[l];
                    const float hi = fmaxf(a, b), lo = fminf(a, b);
                    v[i] = desc ? hi : lo; v[l] = desc ? lo : hi;
                }
            }
}
template <int N> __device__ __forceinline__ void bitonic_merge_desc(float (&v)[N]) {
#pragma unroll
    for (int j = N >> 1; j > 0; j >>= 1)
#pragma unroll
        for (int i = 0; i < N; ++i) {
            const int l = i ^ j;
            if (l > i) { const float a = v[i], b = v[l]; v[i] = fmaxf(a, b); v[l] = fminf(a, b); }
        }
}
__device__ __forceinline__ void ph_peer_qry_topk(const P& p, char* shm) {
    const int tid = threadIdx.x, wid = tid >> 6, lane = tid & 63, wr = wid >> 1, wc = wid & 1, fr = lane & 15, fq = lane >> 4;
    float* tops = (float*)shm;
    for (int unit = blockIdx.x; unit < (T / 128) * 8; unit += gridDim.x) {
        const int h = unit & 7, t0 = (unit >> 3) * 128;
        f32x4 acc[4][4]; zero_acc(acc);
        gemm_kloop(WS(bf16_t, OFF_WQ), 1024, WS(bf16_t, OFF_H2B), 1024, 1024, h * 128, t0, acc, shm);
        int tb = t0 + wc * 64 + fr;
        asm volatile("" : "+v"(tb));
        const bf16_t* kbase = WS(bf16_t, OFF_KEYS) + (size_t)((h * 2 + wr) * 128 + fr) * 64 + 4 * fq;
#pragma unroll
        for (int n = 0; n < 4; ++n) {
            const int t = tb + n * 16;
            const float rstd = row_rstd(p, t);
            if (wr == 0 && fq == 0 && h == 0) WS(float, OFF_RSTD)[t] = rstd;
            bf16x8 bq[2];
#pragma unroll
            for (int ks = 0; ks < 2; ++ks)
#pragma unroll
                for (int j = 0; j < 4; ++j) { bq[ks][j] = (short)f2bf(acc[2 * ks][n][j] * rstd); bq[ks][4 + j] = (short)f2bf(acc[2 * ks + 1][n][j] * rstd); }
            float v[32];
#pragma unroll
            for (int mk = 0; mk < 8; ++mk) {
                f32x4 c = (f32x4){0.f, 0.f, 0.f, 0.f};
#pragma unroll
                for (int ks = 0; ks < 2; ++ks) {
                    const uint2 a0 = *(const uint2*)(kbase + (size_t)mk * 16 * 64 + 32 * ks);
                    const uint2 a1 = *(const uint2*)(kbase + (size_t)mk * 16 * 64 + 32 * ks + 16);
                    union { uint4 q; bf16x8 v; } av; av.q = make_uint4(a0.x, a0.y, a1.x, a1.y);
                    c = __builtin_amdgcn_mfma_f32_16x16x32_bf16(av.v, bq[ks], c, 0, 0, 0);
                }
#pragma unroll
                for (int j = 0; j < 4; ++j) v[4 * mk + j] = __uint_as_float((__float_as_uint(c[j]) & ~0x7Fu) | (unsigned)(16 * mk + 4 * fq + j));
            }
            float m[16];
            {
                float h0[16], h1[16];
#pragma unroll
                for (int i = 0; i < 16; ++i) { h0[i] = v[i]; h1[i] = v[16 + i]; }
                bitonic_sort_desc<16>(h0); bitonic_sort_desc<16>(h1);
#pragma unroll
                for (int i = 0; i < 16; ++i) m[i] = fmaxf(h0[i], h1[15 - i]);
                bitonic_merge_desc<16>(m);
            }
#pragma unroll
            for (int off = 16; off <= 32; off <<= 1) {
                float o[16];
#pragma unroll
                for (int i = 0; i < 16; ++i) o[i] = __shfl_xor(m[i], off);
#pragma unroll
                for (int i = 0; i < 16; ++i) m[i] = fmaxf(m[i], o[15 - i]);
                bitonic_merge_desc<16>(m);
            }
            if (fq == 0) {
                float4* dst = (float4*)(tops + ((size_t)wr * 128 + wc * 64 + n * 16 + fr) * 16);
                dst[0] = make_float4(m[0], m[1], m[2], m[3]); dst[1] = make_float4(m[4], m[5], m[6], m[7]);
                dst[2] = make_float4(m[8], m[9], m[10], m[11]); dst[3] = make_float4(m[12], m[13], m[14], m[15]);
            }
        }
        __syncthreads();
        if (tid < 128) {
            const float* ta = tops + (size_t)tid * 16;
            const float* tbp = tops + (size_t)(128 + tid) * 16;
            float a[16], b[16];
#pragma unroll
            for (int i = 0; i < 16; ++i) { a[i] = __uint_as_float(__float_as_uint(ta[i]) & ~0x7Fu); b[i] = __uint_as_float(__float_as_uint(tbp[i]) & ~0x7Fu); }
            float cand[64];
            int k = 0;
#pragma unroll
            for (int i = 0; i < 16; ++i)
#pragma unroll
                for (int j = 0; j < 16; ++j)
                    if ((i + 1) * (j + 1) <= 16) { cand[k] = __uint_as_float((__float_as_uint(a[i] + b[j]) & ~0xFFu) | (unsigned)(i * 16 + j)); ++k; }
#pragma unroll
            for (int kk = 50; kk < 64; ++kk) cand[kk] = -3.0e38f;
            bitonic_sort_desc<64>(cand);
            float ev[16], se = 0.f; int ex[16];
            const float best = __uint_as_float(__float_as_uint(cand[0]) & ~0xFFu);
#pragma unroll
            for (int q = 0; q < 16; ++q) {
                const unsigned bits = __float_as_uint(cand[q]);
                const int ci = (bits >> 4) & 15, cj = bits & 15;
                const int ia = (int)(__float_as_uint(ta[ci]) & 0x7Fu), ib = (int)(__float_as_uint(tbp[cj]) & 0x7Fu);
                ex[q] = ia * 128 + ib;
                ev[q] = __expf(__uint_as_float(bits & ~0xFFu) - best); se += ev[q];
            }
            const float inv = 1.f / se;
            int4* pi = (int4*)(WS(int, OFF_PIDX) + (size_t)(t0 + tid) * 128 + h * 16);
            float4* pg = (float4*)(WS(float, OFF_PGATE) + (size_t)(t0 + tid) * 128 + h * 16);
#pragma unroll
            for (int q = 0; q < 4; ++q) {
                pi[q] = make_int4(ex[4 * q], ex[4 * q + 1], ex[4 * q + 2], ex[4 * q + 3]);
                pg[q] = make_float4(ev[4 * q] * inv, ev[4 * q + 1] * inv, ev[4 * q + 2] * inv, ev[4 * q + 3] * inv);
            }
        }
        __syncthreads();
    }
}

#if PEER_SIMPLE
__device__ __forceinline__ void d_peer_expert(const P& p, int t, char* shm) {
    float* act = (float*)shm;
    float* red = (float*)(shm + 512);
    const int tid = threadIdx.x, wid = tid >> 6, lane = tid & 63;
    const float rstd = row_rstd(p, t);
    const float* h2 = WS(float, OFF_H2) + (size_t)t * DM;
    float xn[16];
#pragma unroll
    for (int i = 0; i < 4; ++i) {
        const float4 v = ((const float4*)h2)[lane * 4 + i];
        const float4 g = ((const float4*)p.g_ffn)[lane * 4 + i];
        xn[4 * i + 0] = v.x * rstd * g.x; xn[4 * i + 1] = v.y * rstd * g.y; xn[4 * i + 2] = v.z * rstd * g.z; xn[4 * i + 3] = v.w * rstd * g.w;
    }
    const int* idx = WS(int, OFF_PIDX) + (size_t)t * 128;
    const float* gate = WS(float, OFF_PGATE) + (size_t)t * 128;
    const bf16_t* edn = WS(bf16_t, OFF_EDN);
    const bf16_t* eup = WS(bf16_t, OFF_EUP);
    for (int e = wid; e < 128; e += 4) {
        const bf16_t* row = edn + (size_t)idx[e] * DM + lane * 16;
        const uint4 a = ((const uint4*)row)[0], c = ((const uint4*)row)[1];
        const uint32_t w[8] = {a.x, a.y, a.z, a.w, c.x, c.y, c.z, c.w};
        float s = 0.f;
#pragma unroll
        for (int i = 0; i < 8; ++i) s += xn[2 * i] * __uint_as_float(w[i] << 16) + xn[2 * i + 1] * __uint_as_float(w[i] & 0xFFFF0000u);
        s = wave_sum(s);
        if (lane == 0) act[e] = 0.5f * s * (1.f + erff(s * 0.70710678118654752f)) * gate[e];
    }
    __syncthreads();
    float y0 = 0.f, y1 = 0.f, y2 = 0.f, y3 = 0.f;
    for (int e = 0; e < 128; ++e) {
        const float a = act[e];
        const uint2 w = *(const uint2*)(eup + (size_t)idx[e] * DM + tid * 4);
        y0 += a * __uint_as_float(w.x << 16); y1 += a * __uint_as_float(w.x & 0xFFFF0000u);
        y2 += a * __uint_as_float(w.y << 16); y3 += a * __uint_as_float(w.y & 0xFFFF0000u);
    }
    const float4 hv = ((const float4*)h2)[tid];
    const float o0 = hv.x + y0, o1 = hv.y + y1, o2 = hv.z + y2, o3 = hv.w + y3;
    float ss = wave_sum(o0 * o0 + o1 * o1 + o2 * o2 + o3 * o3);
    if (lane == 0) red[wid] = ss;
    __syncthreads();
    ss = red[0] + red[1] + red[2] + red[3];
    const float rs = rsqrtf(ss * (1.f / DM) + EPS);
    const float4 g = ((const float4*)p.g_fin)[tid];
    float4 ov; ov.x = o0 * rs * g.x; ov.y = o1 * rs * g.y; ov.z = o2 * rs * g.z; ov.w = o3 * rs * g.w;
    ((float4*)(p.out + (size_t)t * DM))[tid] = ov;
    __syncthreads();
}

#endif
__device__ __forceinline__ float* part_ptr(const P& p, int c) {
    return WS(float, OFF_PART) + (size_t)c * T * 128;
}
__device__ __forceinline__ unsigned xcc_id() { return (unsigned)__builtin_amdgcn_s_getreg((3 << 11) | 20) & 7u; }

#define MEMFENCE() asm volatile("" ::: "memory")
__device__ __forceinline__ void d_peer_e1(const P& p, int t, int c, int lane) {
    const int g = lane >> 4, ch = lane & 15;
    const float rstd = WS(float, OFF_RSTD)[t];
    int idx[32];
    {
        const int4* ip = (const int4*)(WS(int, OFF_PIDX) + (size_t)t * 128 + 32 * g);
#pragma unroll
        for (int k = 0; k < 8; ++k) { const int4 v = ip[k]; idx[4 * k] = v.x; idx[4 * k + 1] = v.y; idx[4 * k + 2] = v.z; idx[4 * k + 3] = v.w; }
    }
    const bf16_t* tab = WS(bf16_t, OFF_EDN) + 128 * c + 8 * ch;
    uint4 wa[8], wb[8];
#pragma unroll
    for (int k = 0; k < 8; ++k) wa[k] = *(const uint4*)(tab + (size_t)idx[k] * DM);
#pragma unroll
    for (int k = 0; k < 8; ++k) wb[k] = *(const uint4*)(tab + (size_t)idx[8 + k] * DM);
    uint32_t xp[4];
    {
        const uint4 hb = *(const uint4*)(WS(bf16_t, OFF_H2B) + (size_t)t * DM + 128 * c + 8 * ch);
        const float* gp = p.g_ffn + 128 * c + 8 * ch;
        const float4 g0 = *(const float4*)gp, g1 = *(const float4*)(gp + 4);
        xp[0] = pack2(__uint_as_float(hb.x << 16) * rstd * g0.x, __uint_as_float(hb.x & 0xFFFF0000u) * rstd * g0.y);
        xp[1] = pack2(__uint_as_float(hb.y << 16) * rstd * g0.z, __uint_as_float(hb.y & 0xFFFF0000u) * rstd * g0.w);
        xp[2] = pack2(__uint_as_float(hb.z << 16) * rstd * g1.x, __uint_as_float(hb.z & 0xFFFF0000u) * rstd * g1.y);
        xp[3] = pack2(__uint_as_float(hb.w << 16) * rstd * g1.z, __uint_as_float(hb.w & 0xFFFF0000u) * rstd * g1.w);
    }
    MEMFENCE();
    float res0 = 0.f, res1 = 0.f;
#define E1_PROC(W, BASE) _Pragma("unroll") for (int k = 0; k < 8; ++k) { \
        float s = dot2bf(W[k].x, xp[0], 0.f); s = dot2bf(W[k].y, xp[1], s); s = dot2bf(W[k].z, xp[2], s); s = dot2bf(W[k].w, xp[3], s); \
        s = row_sum16(s); \
        if ((BASE) < 16) res0 = ((((BASE) + k) & 15) == ch) ? s : res0; else res1 = ((((BASE) + k) & 15) == ch) ? s : res1; }
    E1_PROC(wa, 0)
#pragma unroll
    for (int k = 0; k < 8; ++k) wa[k] = *(const uint4*)(tab + (size_t)idx[16 + k] * DM);
    MEMFENCE();
    E1_PROC(wb, 8)
#pragma unroll
    for (int k = 0; k < 8; ++k) wb[k] = *(const uint4*)(tab + (size_t)idx[24 + k] * DM);
    MEMFENCE();
    E1_PROC(wa, 16)
    E1_PROC(wb, 24)
    float* pp = part_ptr(p, c) + (size_t)t * 128 + 32 * g + ch;
    pp[0] = res0; pp[16] = res1;
}

__device__ __forceinline__ void d_peer_e2(const P& p, int t, int c, int lane, float* sact  ) {
    const int g = lane >> 4, ch = lane & 15;
    int idx[32];
    {
        const int4* ip = (const int4*)(WS(int, OFF_PIDX) + (size_t)t * 128 + 32 * g);
#pragma unroll
        for (int k = 0; k < 8; ++k) { const int4 q = ip[k]; idx[4 * k] = q.x; idx[4 * k + 1] = q.y; idx[4 * k + 2] = q.z; idx[4 * k + 3] = q.w; }
    }
    const bf16_t* tab = WS(bf16_t, OFF_EUP) + 128 * c + 8 * ch;
    uint4 wa[8], wb[8];
#pragma unroll
    for (int k = 0; k < 8; ++k) wa[k] = *(const uint4*)(tab + (size_t)idx[k] * DM);
    {
        float pu[2][8];
#pragma unroll
        for (int k = 0; k < 2; ++k)
#pragma unroll
            for (int cc = 0; cc < 8; ++cc) pu[k][cc] = part_ptr(p, cc)[(size_t)t * 128 + lane + 64 * k];
        const float g0 = WS(float, OFF_PGATE)[(size_t)t * 128 + lane], g1 = WS(float, OFF_PGATE)[(size_t)t * 128 + lane + 64];
        MEMFENCE();
        const float u0 = ((pu[0][0] + pu[0][1]) + (pu[0][2] + pu[0][3])) + ((pu[0][4] + pu[0][5]) + (pu[0][6] + pu[0][7]));
        const float u1 = ((pu[1][0] + pu[1][1]) + (pu[1][2] + pu[1][3])) + ((pu[1][4] + pu[1][5]) + (pu[1][6] + pu[1][7]));
        sact[lane] = 0.5f * u0 * (1.f + erff(u0 * 0.70710678118654752f)) * g0;
        sact[lane + 64] = 0.5f * u1 * (1.f + erff(u1 * 0.70710678118654752f)) * g1;
    }
    __syncthreads();
    float a[32];
    {
        const float4* ap = (const float4*)(sact + 32 * g);
#pragma unroll
        for (int k = 0; k < 8; ++k) { const float4 v = ap[k]; a[4 * k] = v.x; a[4 * k + 1] = v.y; a[4 * k + 2] = v.z; a[4 * k + 3] = v.w; }
    }
    __syncthreads();
#pragma unroll
    for (int k = 0; k < 8; ++k) wb[k] = *(const uint4*)(tab + (size_t)idx[8 + k] * DM);
    MEMFENCE();
    float y[8];
#pragma unroll
    for (int k = 0; k < 8; ++k) y[k] = 0.f;
#define E2_PROC(W, BASE) _Pragma("unroll") for (int k = 0; k < 8; ++k) { const float av = a[(BASE) + k]; \
        y[0] += av * __uint_as_float(W[k].x << 16); y[1] += av * __uint_as_float(W[k].x & 0xFFFF0000u); \
        y[2] += av * __uint_as_float(W[k].y << 16); y[3] += av * __uint_as_float(W[k].y & 0xFFFF0000u); \
        y[4] += av * __uint_as_float(W[k].z << 16); y[5] += av * __uint_as_float(W[k].z & 0xFFFF0000u); \
        y[6] += av * __uint_as_float(W[k].w << 16); y[7] += av * __uint_as_float(W[k].w & 0xFFFF0000u); }
    E2_PROC(wa, 0)
#pragma unroll
    for (int k = 0; k < 8; ++k) wa[k] = *(const uint4*)(tab + (size_t)idx[16 + k] * DM);
    MEMFENCE();
    E2_PROC(wb, 8)
#pragma unroll
    for (int k = 0; k < 8; ++k) wb[k] = *(const uint4*)(tab + (size_t)idx[24 + k] * DM);
    MEMFENCE();
    E2_PROC(wa, 16)
    E2_PROC(wb, 24)
#pragma unroll
    for (int k = 0; k < 8; ++k) { y[k] += __shfl_xor(y[k], 16); y[k] += __shfl_xor(y[k], 32); }
    if (g == 0) {
        const uint4 hb = *(const uint4*)(WS(bf16_t, OFF_H2B) + (size_t)t * DM + 128 * c + 8 * ch);
        float4 o0, o1;
        o0.x = __uint_as_float(hb.x << 16) + y[0]; o0.y = __uint_as_float(hb.x & 0xFFFF0000u) + y[1];
        o0.z = __uint_as_float(hb.y << 16) + y[2]; o0.w = __uint_as_float(hb.y & 0xFFFF0000u) + y[3];
        o1.x = __uint_as_float(hb.z << 16) + y[4]; o1.y = __uint_as_float(hb.z & 0xFFFF0000u) + y[5];
        o1.z = __uint_as_float(hb.w << 16) + y[6]; o1.w = __uint_as_float(hb.w & 0xFFFF0000u) + y[7];
        float* op = p.out + (size_t)t * DM + 128 * c + 8 * ch;
        *(float4*)op = o0; *(float4*)(op + 4) = o1;
        float ss = o0.x * o0.x + o0.y * o0.y + o0.z * o0.z + o0.w * o0.w + o1.x * o1.x + o1.y * o1.y + o1.z * o1.z + o1.w * o1.w;
        ss = row_sum16(ss);
        if (ch == 0) WS(float, OFF_SSQ2)[(size_t)c * T + t] = ss;
    }
}

template <int PHASE> __device__ __forceinline__ void ph_peer_sliced(const P& p, char* shm, int rep) {
    int* s_tile = (int*)shm;
    float* sact = (float*)(shm + 64) + (threadIdx.x >> 6) * 128;
    const int tid = threadIdx.x, lane = tid & 63, wid = tid >> 6;
    unsigned* qc = WS(unsigned, OFF_QCNT) + (PHASE == 2 ? 8 : 0) + 16 * rep;
    const unsigned x0 = xcc_id();
    for (int dc = 0; dc < 8; ++dc) {
        const int c = (int)((x0 + dc) & 7u);
        for (;;) {
            __syncthreads();
            if (tid == 0) *s_tile = (int)atomicAdd(&qc[c], 1u);
            __syncthreads();
            const int tile = *s_tile;
            if (tile >= T / 16) break;
#pragma unroll 1
            for (int k = 0; k < 4; ++k) {
                const int t = tile * 16 + wid * 4 + k;
                if (PHASE == 1) d_peer_e1(p, t, c, lane); else d_peer_e2(p, t, c, lane, sact);
            }
        }
    }
}

__device__ __forceinline__ void d_peer_e3(const P& p, int t) {
    const int tid = threadIdx.x;
    float s = 0.f;
#pragma unroll
    for (int c = 0; c < 8; ++c) s += WS(float, OFF_SSQ2)[(size_t)c * T + t];
    const float rs = rsqrtf(s * (1.f / DM) + EPS);
    float4* op = (float4*)(p.out + (size_t)t * DM) + tid;
    const float4 g = ((const float4*)p.g_fin)[tid];
    float4 v = *op;
    v.x *= rs * g.x; v.y *= rs * g.y; v.z *= rs * g.z; v.w *= rs * g.w;
    *op = v;
}

#define XB_TMO      128
#define XB_XCNT(j)  (256  + 64 * (j))
#define XB_XSUB(j)  (1280 + 64 * (j))
#define XB_XGEN(j)  (2304 + 64 * (j))
#define XB_TOP      3328
#define XB_TOPGEN   3392
#define XCD_BAR_WORDS 3456
#define XB_SPIN_CAP (1u << 22)
#define LAS __attribute__((address_space(3)))
__device__ __forceinline__ unsigned xb_ld(unsigned* p) { return __hip_atomic_load(p, __ATOMIC_RELAXED, __HIP_MEMORY_SCOPE_AGENT); }
__device__ __forceinline__ unsigned xb_add(unsigned* p, unsigned v) { return __hip_atomic_fetch_add(p, v, __ATOMIC_RELAXED, __HIP_MEMORY_SCOPE_AGENT); }
__device__ __forceinline__ unsigned xb_xcc_id() { return (unsigned)__builtin_amdgcn_s_getreg((3 << 11) | 20) & 0xFu; }
#define XB_SPIN(cond, bar) do { unsigned _sp = 0; while (cond) { __builtin_amdgcn_s_sleep(1); \
    if ((++_sp & 255u) == 0u) { if (xb_ld(&(bar)[XB_TMO])) break; if (_sp > XB_SPIN_CAP) { atomicAdd(&(bar)[XB_TMO], 1u); break; } } } } while (0)
struct XcdBarrier { unsigned* bar; unsigned x; volatile LAS unsigned* st; };
__device__ __forceinline__ XcdBarrier xcd_barrier_post(unsigned* bar, volatile LAS unsigned* st) {
    XcdBarrier b; b.bar = bar; b.x = xb_xcc_id(); b.st = st;
    if (threadIdx.x == 0) (void)xb_add(&bar[XB_XCNT(b.x)], 1u);
    return b;
}
__device__ __forceinline__ void xcd_barrier_complete(unsigned* bar, unsigned x, unsigned& nloc, unsigned& nx) {
    const unsigned G = gridDim.x * gridDim.y * gridDim.z;
    unsigned sum, cnt, mine, sp = 0u;
    for (;;) {
        sum = 0u; cnt = 0u; mine = 0u;
#pragma unroll
        for (unsigned j = 0; j < 16; ++j) { const unsigned c = xb_ld(&bar[XB_XCNT(j)]); sum += c; cnt += (c > 0u) ? 1u : 0u; mine = (j == x) ? c : mine; }
        if (sum == G) break;
        __builtin_amdgcn_s_sleep(1);
        if ((++sp & 255u) == 0u) { if (xb_ld(&bar[XB_TMO])) break; if (sp > XB_SPIN_CAP) { atomicAdd(&bar[XB_TMO], 1u); break; } }
    }
    nloc = mine > 0u ? mine : 1u; nx = cnt > 0u ? cnt : 1u;
}
__device__ __forceinline__ void xcd_barrier(const XcdBarrier& b) {
    asm volatile("s_waitcnt vmcnt(0)" ::: "memory");
    __syncthreads();
    if (threadIdx.x == 0) {
        unsigned* bar = b.bar;
        __builtin_amdgcn_s_waitcnt(0);
        unsigned nloc = b.st[0], nx = b.st[1];
        if (nloc == 0u) { xcd_barrier_complete(bar, b.x, nloc, nx); b.st[0] = nloc; b.st[1] = nx; }
        const unsigned old = xb_add(&bar[XB_XSUB(b.x)], 1u);
        const unsigned gen = old / nloc;
        if (old + 1u == (gen + 1u) * nloc) {
            __builtin_amdgcn_fence(__ATOMIC_RELEASE, "agent");
            asm volatile("s_waitcnt vmcnt(0)" ::: "memory");
            const unsigned og = xb_add(&bar[XB_TOP], 1u);
            const unsigned tg = og / nx;
            if (og + 1u == (tg + 1u) * nx) xb_add(&bar[XB_TOPGEN], 1u);
            else XB_SPIN(xb_ld(&bar[XB_TOPGEN]) == tg, bar);
            __builtin_amdgcn_fence(__ATOMIC_ACQUIRE, "agent");
            xb_add(&bar[XB_XGEN(b.x)], 1u);
            asm volatile("s_waitcnt vmcnt(0)" ::: "memory");
        } else {
            XB_SPIN(xb_ld(&bar[XB_XGEN(b.x)]) == gen, bar);
            __builtin_amdgcn_fence(__ATOMIC_ACQUIRE, "agent");
            asm volatile("s_waitcnt vmcnt(0)" ::: "memory");
        }
    }
    __syncthreads();
}

#define REP_P0 1
#define REP_P1 1
#define REP_P2 1
#define REP_P2C 1
#define REP_P3 1
#define REP_P4G 1
#define REP_P4C 1
#define REP_P5 1
#define REP_P6 1
#define REP_P9 1
#define REP_E1 1
#define REP_E2 1
#define REPEAT(N) for (int rep_ = 0; rep_ < (N); ++rep_)
constexpr int SHM_BYTES = 65536;
__global__ void __launch_bounds__(256, 2) mega(P p) {
    __shared__ __attribute__((aligned(16))) char shm[SHM_BYTES + 16];
    cg::grid_group grid = cg::this_grid();
    const int G = gridDim.x, bid = blockIdx.x;
    volatile LAS unsigned* xst = (volatile LAS unsigned*)(shm + SHM_BYTES);
    if (threadIdx.x == 0) { xst[0] = 0u; xst[1] = 0u; }
    __syncthreads();
    const XcdBarrier xb = xcd_barrier_post(WS(unsigned, OFF_BAR), xst);

    {
        constexpr int U_WIN = (NIN / 32) * 32, U_WUA = 32 * 16, U_WUR = 32 * 16, U_WOUT = 32 * 32, U_WQ = 32 * 32, U_KEYS = 32, U_MISC = (LP * 8 + 255) / 256;
        constexpr int E0 = U_WIN, E1 = E0 + U_WUA, E2 = E1 + U_WUR, E3 = E2 + U_WOUT, E4 = E3 + U_WQ, E5 = E4 + U_KEYS, E6 = E5 + U_MISC, E7 = E6 + R;
        if (bid == 0 && threadIdx.x < 64) WS(unsigned, OFF_QCNT)[threadIdx.x] = 0u;
        REPEAT(REP_P0)
        for (int u = bid; u < E7; u += G) {
            if (u < E0) d_transpose(p.w_in, WS(bf16_t, OFF_WIN), 1024, NIN, nullptr, u, shm);
            else if (u < E1) d_transpose(p.w_ua, WS(bf16_t, OFF_WUA), 512, 1024, nullptr, u - E0, shm);
            else if (u < E2) d_transpose(p.w_ur, WS(bf16_t, OFF_WUR), 512, 1024, nullptr, u - E1, shm);
            else if (u < E3) d_transpose(p.w_out, WS(bf16_t, OFF_WOUT), 1024, 1024, nullptr, u - E2, shm);
            else if (u < E4) d_transpose(p.w_q, WS(bf16_t, OFF_WQ), 1024, 1024, p.g_ffn, u - E3, shm);
            else if (u < E5) d_cvt(p.keys, WS(bf16_t, OFF_KEYS), (size_t)16 * 128 * 64 / 4, u - E4, U_KEYS);
            else if (u < E6) d_misc(p, u - E5);
            else d_rmsnorm_in(p, u - E6, shm);
        }
    }
    grid.sync();
    REPEAT(REP_P1) ph_gemm_inproj(p, shm);
    xcd_barrier(xb);
    REPEAT(REP_P2)
    for (int u = bid; u < 2048; u += G) { if (u < 1024) d_hgrn_A(p, u, shm); else d_attn(p, u - 1024, shm); }
    xcd_barrier(xb);
    for (int u = bid; u < 512; u += G) d_hgrn_scan(p, u);
    xcd_barrier(xb);
    REPEAT(REP_P2C)
    for (int u = bid; u < 1024; u += G) d_hgrn_C(p, u, shm);
    xcd_barrier(xb);
    REPEAT(REP_P3) ph_gemm_merge(p, shm);
    xcd_barrier(xb);
    REPEAT(REP_P4G) ph_gemm_out(p, shm);
    REPEAT(REP_P4C) {
    d_cvt(p.edown, WS(bf16_t, OFF_EDN), (size_t)16384 * 1024 / 4, bid, G);
    d_cvt(p.eup, WS(bf16_t, OFF_EUP), (size_t)16384 * 1024 / 4, bid, G); }
    xcd_barrier(xb);
    REPEAT(REP_P5) ph_peer_qry_topk(p, shm);
    xcd_barrier(xb);
    REPEAT(REP_E1) ph_peer_sliced<1>(p, shm, rep_);
    xcd_barrier(xb);
    REPEAT(REP_E2) ph_peer_sliced<2>(p, shm, rep_);
    xcd_barrier(xb);
    REPEAT(REP_P9)
    for (int t = bid; t < T; t += G) d_peer_e3(p, t);
}

extern "C" void kernel_launch(void* const* d_in, const int* in_sizes, int n_in, void* d_out, int out_size, void* d_ws, size_t ws_size, hipStream_t stream) {
    P p{};
    p.x = (const float*)d_in[0]; p.meta = (const float*)d_in[1]; p.g_mix = (const float*)d_in[2]; p.w_in = (const float*)d_in[3];
    p.b_in = (const float*)d_in[4]; p.sinks = (const float*)d_in[5]; p.lb_logits = (const float*)d_in[6]; p.g_rec = (const float*)d_in[7];
    p.w_ua = (const float*)d_in[8]; p.w_ur = (const float*)d_in[9]; p.w_out = (const float*)d_in[10]; p.g_ffn = (const float*)d_in[11];
    p.w_q = (const float*)d_in[12]; p.keys = (const float*)d_in[13]; p.edown = (const float*)d_in[14]; p.eup = (const float*)d_in[15];
    p.g_fin = (const float*)d_in[16];
    p.out = (float*)d_out; p.ws = (char*)d_ws;
    static int grid_blocks = 0;
    if (!grid_blocks) {
        int dev = 0, cus = 0, per_cu = 0;
        (void)hipGetDevice(&dev);
        (void)hipDeviceGetAttribute(&cus, hipDeviceAttributeMultiprocessorCount, dev);
        (void)hipOccupancyMaxActiveBlocksPerMultiprocessor(&per_cu, mega, 256, 0);
        if (per_cu > 2) per_cu = 2;
        if (per_cu < 1) per_cu = 1;
        grid_blocks = cus * per_cu;
    }
    (void)hipMemsetAsync((char*)d_ws + OFF_BAR, 0, XCD_BAR_WORDS * 4, stream);
    void* args[] = {&p};
    hipError_t e = hipLaunchCooperativeKernel((void*)mega, dim3(grid_blocks), dim3(256), args, 0, stream);
    if (e != hipSuccess) fprintf(stderr, "cooperative launch failed: %s (grid %d)\n", hipGetErrorString(e), grid_blocks);
}
```

```cpp
#include <hip/hip_runtime.h>
#include <hip/hip_cooperative_groups.h>
#include <stdint.h>
#include <stdio.h>
namespace cg = cooperative_groups;

typedef unsigned short bf16_t;
typedef short bf16x8 __attribute__((ext_vector_type(8)));
typedef float f32x4 __attribute__((ext_vector_type(4)));

constexpr int NB = 4, SEQ = 4096, DM = 1024, LP = 4224, PADF = 112;
constexpr int R = NB * LP;
constexpr int T = NB * SEQ;
constexpr int NIN = 4864;
constexpr float EPS = 1e-6f;

constexpr size_t MiB = 1024 * 1024;
constexpr size_t OFF_WUA = 0;
constexpr size_t OFF_WUR = 1 * MiB;
constexpr size_t OFF_WOUT = 2 * MiB;
constexpr size_t OFF_WQ = 4 * MiB;
constexpr size_t OFF_KEYS = 6 * MiB;
constexpr size_t OFF_ROPE = 6 * MiB + 256 * 1024;
constexpr size_t OFF_LB = OFF_ROPE + 272 * 1024;
constexpr size_t OFF_SSQ = 7 * MiB;
constexpr size_t OFF_B = 8 * MiB;
constexpr size_t OFF_QB = OFF_B;
constexpr size_t OFF_KB = OFF_QB + (size_t)R * 512 * 2;
constexpr size_t OFF_VB = OFF_KB + (size_t)R * 128 * 2;
constexpr size_t OFF_RQ = OFF_VB + (size_t)R * 128 * 2;
constexpr size_t OFF_LOGF = OFF_RQ + (size_t)R * 512 * 2;
constexpr size_t OFF_RI = OFF_LOGF + (size_t)R * 512 * 4;
constexpr size_t OFF_RG = OFF_RI + (size_t)R * 512 * 2;
constexpr size_t OFF_GA = OFF_RG + (size_t)R * 512 * 2;
constexpr size_t OFF_GR = OFF_GA + (size_t)R * 1024 * 2;
constexpr size_t OFF_C = OFF_GR + (size_t)R * 1024 * 2;
constexpr size_t OFF_XN = OFF_C;
constexpr size_t OFF_WIN = OFF_XN + (size_t)R * 1024 * 2;
constexpr size_t OFF_TAIL = OFF_WIN + (size_t)NIN * 1024 * 2;
constexpr size_t OFF_DS = OFF_TAIL;
constexpr size_t OFF_ATT = OFF_C;
constexpr size_t OFF_REC = OFF_ATT + (size_t)T * 512 * 2;
constexpr size_t OFF_MRG = OFF_LOGF;
constexpr size_t OFF_H2B = OFF_RI;
constexpr size_t OFF_EDN = OFF_C;
constexpr size_t OFF_EUP = OFF_EDN + (size_t)16384 * 1024;
constexpr size_t OFF_QRY = OFF_QB;
constexpr size_t OFF_PIDX = OFF_MRG;
constexpr size_t OFF_PGATE = OFF_PIDX + (size_t)T * 128 * 4;
constexpr size_t OFF_RSTD = OFF_LB + 4096;
constexpr size_t OFF_BAR = 6 * MiB + 640 * 1024;
constexpr size_t OFF_QCNT = OFF_LB + 2048;
constexpr size_t OFF_PART = OFF_GA;
constexpr size_t OFF_SSQ2 = OFF_QB;
static_assert(OFF_SSQ2 + (size_t)8 * T * 4 <= OFF_LOGF, "ssq2 overlay");
static_assert(OFF_PART + 8 * (size_t)T * 128 * 4 <= OFF_C, "part overlay");
static_assert(OFF_QCNT + 256 <= OFF_RSTD && OFF_RSTD + (size_t)T * 4 <= OFF_BAR && OFF_BAR + 3456 * 4 <= OFF_SSQ, "qcnt/rstd/bar");
static_assert(OFF_EUP + (size_t)16384 * 1024 * 2 <= 256 * MiB, "ws overflow");
static_assert(OFF_DS + (size_t)16 * 64 * 16384 * 2 <= 256 * MiB, "ws overflow");
static_assert(OFF_REC + (size_t)T * 512 * 2 <= OFF_TAIL, "overlay");
static_assert(OFF_QRY + (size_t)T * 1024 * 2 <= OFF_LOGF, "qry overlay");
static_assert(OFF_PGATE + (size_t)T * 128 * 4 <= OFF_RI, "pidx overlay");

struct P {
    const float *x, *meta, *g_mix, *w_in, *b_in, *sinks, *lb_logits, *g_rec, *w_ua, *w_ur, *w_out, *g_ffn, *w_q, *keys, *edown, *eup, *g_fin;
    float* out;
    char* ws;
};
#define WS(type, off) ((type*)(p.ws + (off)))

__device__ __forceinline__ bf16_t f2bf(float f) {
    uint32_t u = __float_as_uint(f);
    u += 0x7FFFu + ((u >> 16) & 1u);
    return (bf16_t)(u >> 16);
}
__device__ __forceinline__ float bf2f(bf16_t h) { return __uint_as_float(((uint32_t)h) << 16); }
__device__ __forceinline__ uint32_t pack2(float lo, float hi) { return (uint32_t)f2bf(lo) | ((uint32_t)f2bf(hi) << 16); }
__device__ __forceinline__ float sigmoidf_(float v) { return 1.f / (1.f + __expf(-v)); }

__device__ __forceinline__ float wave_sum(float v) {
#pragma unroll
    for (int o = 32; o > 0; o >>= 1) v += __shfl_xor(v, o);
    return v;
}

typedef __bf16 bf16v2 __attribute__((ext_vector_type(2)));
__device__ __forceinline__ float dot2bf(uint32_t a, uint32_t b, float c) {
    union { uint32_t u; bf16v2 v; } x, y; x.u = a; y.u = b;
    return __builtin_amdgcn_fdot2_f32_bf16(x.v, y.v, c, false);
}
__device__ __forceinline__ float row_sum16(float v) {
    v += __builtin_amdgcn_update_dpp(0.f, v, 0xB1, 0xF, 0xF, false);
    v += __builtin_amdgcn_update_dpp(0.f, v, 0x4E, 0xF, 0xF, false);
    v += __builtin_amdgcn_update_dpp(0.f, v, 0x141, 0xF, 0xF, false);
    v += __builtin_amdgcn_update_dpp(0.f, v, 0x140, 0xF, 0xF, false);
    return v;
}
__device__ __forceinline__ void d_transpose(const float* __restrict__ W, bf16_t* __restrict__ Wt, int K, int N, const float* __restrict__ rs, int unit, char* shm) {
    float (*tile)[33] = (float (*)[33])shm;
    const int ntn = N / 32;
    const int k0 = (unit / ntn) * 32, n0 = (unit % ntn) * 32, tx = threadIdx.x & 31, ty = threadIdx.x >> 5;
#pragma unroll
    for (int i = 0; i < 4; ++i) {
        const int k = k0 + ty + i * 8;
        tile[ty + i * 8][tx] = W[(size_t)k * N + n0 + tx] * (rs ? rs[k] : 1.f);
    }
    __syncthreads();
#pragma unroll
    for (int i = 0; i < 4; ++i) {
        const int n = n0 + ty + i * 8;
        Wt[(size_t)n * K + k0 + tx] = f2bf(tile[tx][ty + i * 8]);
    }
    __syncthreads();
}

__device__ __forceinline__ void d_cvt(const float* __restrict__ src, bf16_t* __restrict__ dst, size_t n4, int vblk, int nvblk) {
    for (size_t i = (size_t)vblk * 256 + threadIdx.x; i < n4; i += (size_t)nvblk * 256) {
        const float4 v = ((const float4*)src)[i];
        ushort4 o; o.x = f2bf(v.x); o.y = f2bf(v.y); o.z = f2bf(v.z); o.w = f2bf(v.w);
        ((ushort4*)dst)[i] = o;
    }
}

__device__ __forceinline__ void d_cvt8(const float* __restrict__ src, unsigned char* __restrict__ dst, size_t n16, float scale, int vblk, int nvblk) {
    for (size_t i = (size_t)vblk * 256 + threadIdx.x; i < n16; i += (size_t)nvblk * 256) {
        const float4* s = (const float4*)src + i * 4;
        uint32_t w[4];
#pragma unroll
        for (int q = 0; q < 4; ++q) {
            const float4 v = s[q];
            int pk = 0;
            pk = __builtin_amdgcn_cvt_pk_fp8_f32(v.x * scale, v.y * scale, pk, false);
            pk = __builtin_amdgcn_cvt_pk_fp8_f32(v.z * scale, v.w * scale, pk, true);
            w[q] = (uint32_t)pk;
        }
        ((uint4*)dst)[i] = make_uint4(w[0], w[1], w[2], w[3]);
    }
}

__device__ __forceinline__ void d_misc(const P& p, int unit) {
    const int gid = unit * 256 + threadIdx.x;
    if (gid < LP * 8) {
        const int pp = gid >> 3, i = gid & 7;
        const double inv = pow(500000.0, -(double)i / 8.0);
        const double ang = (double)(pp - PADF) * inv;
        float2 cs; cs.x = (float)cos(ang); cs.y = (float)sin(ang);
        WS(float2, OFF_ROPE)[gid] = cs;
    }
    if (gid < 512) {
        const float l0 = p.lb_logits[gid], l1 = p.lb_logits[512 + gid];
        WS(float, OFF_LB)[gid] = 1.f / (1.f + expf(l1 - l0));
    }
}

__device__ __forceinline__ void d_rmsnorm_in(const P& p, int r, char* shm) {
    float* red = (float*)shm;
    const int b = r / LP, pp = r % LP, tid = threadIdx.x;
    bf16_t* dst = WS(bf16_t, OFF_XN) + (size_t)r * DM;
    if (pp < PADF) { ((ushort4*)dst)[tid] = make_ushort4(0, 0, 0, 0); return; }
    const float* src = (pp < 128) ? (p.meta + (size_t)(pp - PADF) * DM) : (p.x + ((size_t)b * SEQ + (pp - 128)) * DM);
    const float4 v = ((const float4*)src)[tid];
    float ss = v.x * v.x + v.y * v.y + v.z * v.z + v.w * v.w;
    ss = wave_sum(ss);
    if ((tid & 63) == 0) red[tid >> 6] = ss;
    __syncthreads();
    ss = red[0] + red[1] + red[2] + red[3];
    const float rstd = rsqrtf(ss * (1.f / DM) + EPS);
    const float4 g = ((const float4*)p.g_mix)[tid];
    ushort4 o; o.x = f2bf(v.x * rstd * g.x); o.y = f2bf(v.y * rstd * g.y); o.z = f2bf(v.z * rstd * g.z); o.w = f2bf(v.w * rstd * g.w);
    ((ushort4*)dst)[tid] = o;
    __syncthreads();
}

__device__ __forceinline__ void glds16(const void* src, void* lds) { __builtin_amdgcn_global_load_lds((const unsigned*)src, (unsigned*)lds, 16, 0, 0); }

__device__ __forceinline__ void gemm_kloop(const bf16_t* __restrict__ A, int lda, const bf16_t* __restrict__ Bt, int ldb, int K, int brow, int bcol,
                                           f32x4 (&acc)[4][4], char* shm) {
    const int tid = threadIdx.x, wid = tid >> 6, lane = tid & 63, wr = wid >> 1, wc = wid & 1, fr = lane & 15, fq = lane >> 4;
    const int sr = tid >> 3, sc = ((tid & 7) ^ ((sr >> 1) & 7)) * 8;
    const bf16_t* ag = A + (size_t)(brow + sr) * lda + sc;
    const bf16_t* bg = Bt + (size_t)(bcol + sr) * ldb + sc;
    const int nt = K >> 6;
#pragma unroll
    for (int i = 0; i < 4; ++i) {
        glds16(ag + (size_t)(32 * i) * lda, shm + tid * 16 + i * 4096);
        glds16(bg + (size_t)(32 * i) * ldb, shm + 16384 + tid * 16 + i * 4096);
    }
    asm volatile("s_waitcnt vmcnt(0)" ::: "memory");
    __syncthreads();
    const int arow = wr * 64 + fr, brw = wc * 64 + fr;
    const int swz = (fr >> 1) & 7;
    for (int kt = 0; kt < nt; ++kt) {
        char* SA = shm + (kt & 1) * 32768;
        char* SB = SA + 16384;
        if (kt + 1 < nt) {
            char* NA = shm + ((kt + 1) & 1) * 32768;
#pragma unroll
            for (int i = 0; i < 4; ++i) {
                glds16(ag + (size_t)(32 * i) * lda + (kt + 1) * 64, NA + tid * 16 + i * 4096);
                glds16(bg + (size_t)(32 * i) * ldb + (kt + 1) * 64, NA + 16384 + tid * 16 + i * 4096);
            }
        }
#pragma unroll
        for (int ks = 0; ks < 2; ++ks) {
            bf16x8 a[4], b[4];
            const int coff = (((ks * 4 + fq) ^ swz) << 4);
#pragma unroll
            for (int m = 0; m < 4; ++m) a[m] = *(const bf16x8*)(SA + (arow + m * 16) * 128 + coff);
#pragma unroll
            for (int n = 0; n < 4; ++n) b[n] = *(const bf16x8*)(SB + (brw + n * 16) * 128 + coff);
#pragma unroll
            for (int m = 0; m < 4; ++m)
#pragma unroll
                for (int n = 0; n < 4; ++n) acc[m][n] = __builtin_amdgcn_mfma_f32_16x16x32_bf16(a[m], b[n], acc[m][n], 0, 0, 0);
        }
        asm volatile("s_waitcnt vmcnt(0)" ::: "memory");
        __syncthreads();
    }
}

__device__ __forceinline__ void zero_acc(f32x4 (&acc)[4][4]) {
#pragma unroll
    for (int m = 0; m < 4; ++m)
#pragma unroll
        for (int n = 0; n < 4; ++n) acc[m][n] = (f32x4){0.f, 0.f, 0.f, 0.f};
}

constexpr int EPI_LD = 136;
__device__ __forceinline__ void tile_store_bf16(const char* shm, bf16_t* dst, int ld) {
    __syncthreads();
#pragma unroll
    for (int i = 0; i < 8; ++i) {
        const int q = threadIdx.x + 256 * i, r = q >> 4, c = q & 15;
        *(uint4*)(dst + (size_t)r * ld + c * 8) = *(const uint4*)(shm + (r * EPI_LD + c * 8) * 2);
    }
    __syncthreads();
}

__device__ __forceinline__ void tile_load_bf16(char* shm, const bf16_t* srcp, int ld) {
#pragma unroll
    for (int i = 0; i < 8; ++i) {
        const int q = threadIdx.x + 256 * i, r = q >> 4, c = q & 15;
        *(uint4*)(shm + (r * EPI_LD + c * 8) * 2) = *(const uint4*)(srcp + (size_t)r * ld + c * 8);
    }
}

__device__ __forceinline__ void ph_gemm_inproj(const P& p, char* shm) {
    const int tid = threadIdx.x, wid = tid >> 6, lane = tid & 63, wr = wid >> 1, wc = wid & 1, fr = lane & 15, fq = lane >> 4;
    constexpr int NT_N = NIN / 128, NT_M = R / 128;
    const float2* rope = WS(float2, OFF_ROPE);
    const float* lbv = WS(float, OFF_LB);
    for (int tile = blockIdx.x; tile < NT_N * NT_M; tile += gridDim.x) {
        const int pm = tile / NT_N, pn = tile % NT_N, brow_ = pm * 128, bcol_ = pn * 128;
        f32x4 acc[4][4]; zero_acc(acc);
        int brow = brow_, bcol = bcol_;
        gemm_kloop(WS(bf16_t, OFF_XN), DM, WS(bf16_t, OFF_WIN), DM, DM, brow, bcol, acc, shm);
        asm volatile("" : "+s"(brow), "+s"(bcol));
        if (bcol >= 1280 && bcol < 1792) {
#pragma unroll
            for (int n = 0; n < 4; ++n) {
                const int col = bcol + wc * 64 + n * 16 + fr;
                const float bv = p.b_in[col], lb = lbv[col - 1280];
                float run = 0.f;
#pragma unroll
                for (int m = 0; m < 4; ++m) {
                    float c[4];
#pragma unroll
                    for (int j = 0; j < 4; ++j) {
                        const int row = brow + wr * 64 + m * 16 + fq * 4 + j;
                        const float v = acc[m][n][j] + bv;
                        const float f = lb + (1.f - lb) * sigmoidf_(v);
                        const float lf = ((row % LP) < PADF) ? 0.f : __logf(f);
                        c[j] = lf + (j ? c[j - 1] : 0.f);
                    }
                    const float x = c[3];
                    const float y = __shfl_up(x, 16);
                    float incl = x + (fq >= 1 ? y : 0.f);
                    const float z = __shfl_up(incl, 32);
                    incl += (fq >= 2 ? z : 0.f);
                    const float excl = incl - x;
                    const float tot = __shfl(incl, fr + 48);
#pragma unroll
                    for (int j = 0; j < 4; ++j) {
                        const int row = brow + wr * 64 + m * 16 + fq * 4 + j;
                        WS(float, OFF_LOGF)[(size_t)row * 512 + (col - 1280)] = run + excl + c[j];
                    }
                    run += tot;
                }
            }
        } else {
            bf16_t* st = (bf16_t*)shm;
            const int kind = (bcol < 512) ? 0 : (bcol < 640) ? 1 : (bcol < 2304) ? 2 : (bcol < 2816) ? 3 : 4;
#pragma unroll
            for (int m = 0; m < 4; ++m)
#pragma unroll
                for (int n = 0; n < 4; ++n) {
                    const int cl = wc * 64 + n * 16 + fr;
                    const float bv = p.b_in[bcol + cl];
#pragma unroll
                    for (int j = 0; j < 4; ++j) {
                        const int rl = wr * 64 + m * 16 + fq * 4 + j;
                        float v = acc[m][n][j] + bv;
                        if (kind <= 1) {
                            if (n == 0) {
                                const float other = __shfl_xor(v, 8);
                                const float2 cs = rope[((brow + rl) % LP) * 8 + (fr & 7)];
                                v = (fr < 8) ? (v * cs.x - other * cs.y) : (v * cs.x + other * cs.y);
                            }
                            if (kind == 0) v *= 0.125f;
                        } else if (kind == 3) v = v * sigmoidf_(v);
                        else if (kind == 4) v = sigmoidf_(v);
                        st[rl * EPI_LD + cl] = f2bf(v);
                    }
                }
            bf16_t* dst; int ld;
            if (bcol < 512) { dst = WS(bf16_t, OFF_QB) + bcol; ld = 512; }
            else if (bcol < 640) { dst = WS(bf16_t, OFF_KB); ld = 128; }
            else if (bcol < 768) { dst = WS(bf16_t, OFF_VB); ld = 128; }
            else if (bcol < 1280) { dst = WS(bf16_t, OFF_RQ) + (bcol - 768); ld = 512; }
            else if (bcol < 2304) { dst = WS(bf16_t, OFF_RI) + (bcol - 1792); ld = 512; }
            else if (bcol < 2816) { dst = WS(bf16_t, OFF_RG) + (bcol - 2304); ld = 512; }
            else if (bcol < 3840) { dst = WS(bf16_t, OFF_GA) + (bcol - 2816); ld = 1024; }
            else { dst = WS(bf16_t, OFF_GR) + (bcol - 3840); ld = 1024; }
            tile_store_bf16(shm, dst + (size_t)brow * ld, ld);
        }
    }
}

__device__ __forceinline__ void ph_gemm_merge(const P& p, char* shm) {
    const int tid = threadIdx.x, wid = tid >> 6, lane = tid & 63, wr = wid >> 1, wc = wid & 1, fr = lane & 15, fq = lane >> 4;
    constexpr int NT_N = 8, NT_M = T / 128;
    bf16_t* st = (bf16_t*)shm;
    for (int tile = blockIdx.x; tile < NT_N * NT_M; tile += gridDim.x) {
        const int pm = tile / NT_N, pn = tile % NT_N, brow = pm * 128, bcol = pn * 128;
        f32x4 acc[4][4];
        uint32_t tt[4][4][2];
#pragma unroll 1
        for (int pass = 0; pass < 2; ++pass) {
            zero_acc(acc);
            gemm_kloop(WS(bf16_t, pass ? OFF_REC : OFF_ATT), 512, WS(bf16_t, pass ? OFF_WUR : OFF_WUA), 512, 512, brow, bcol, acc, shm);
            int erow = brow, ecol = bcol;
            asm volatile("" : "+s"(erow), "+s"(ecol));
            tile_load_bf16(shm, WS(bf16_t, pass ? OFF_GR : OFF_GA) + (size_t)(erow + 128 * (erow / SEQ + 1)) * 1024 + ecol, 1024);
            __syncthreads();
#pragma unroll
            for (int m = 0; m < 4; ++m)
#pragma unroll
                for (int n = 0; n < 4; ++n) {
                    const int cl = wc * 64 + n * 16 + fr;
                    float v[4];
#pragma unroll
                    for (int j = 0; j < 4; ++j) v[j] = acc[m][n][j] * bf2f(st[(wr * 64 + m * 16 + fq * 4 + j) * EPI_LD + cl]);
                    if (pass == 0) { tt[m][n][0] = pack2(v[0], v[1]); tt[m][n][1] = pack2(v[2], v[3]); }
                    else {
                        st[(wr * 64 + m * 16 + fq * 4 + 0) * EPI_LD + cl] = f2bf(v[0] + __uint_as_float(tt[m][n][0] << 16));
                        st[(wr * 64 + m * 16 + fq * 4 + 1) * EPI_LD + cl] = f2bf(v[1] + __uint_as_float(tt[m][n][0] & 0xFFFF0000u));
                        st[(wr * 64 + m * 16 + fq * 4 + 2) * EPI_LD + cl] = f2bf(v[2] + __uint_as_float(tt[m][n][1] << 16));
                        st[(wr * 64 + m * 16 + fq * 4 + 3) * EPI_LD + cl] = f2bf(v[3] + __uint_as_float(tt[m][n][1] & 0xFFFF0000u));
                    }
                }
            if (pass == 0) __syncthreads();
            else tile_store_bf16(shm, WS(bf16_t, OFF_MRG) + (size_t)erow * 1024 + ecol, 1024);
        }
    }
}

__device__ __forceinline__ void ph_gemm_out(const P& p, char* shm) {
    const int tid = threadIdx.x, wid = tid >> 6, lane = tid & 63, wr = wid >> 1, wc = wid & 1, fr = lane & 15, fq = lane >> 4;
    constexpr int NT_N = 8, NT_M = T / 128;
    bf16_t* st = (bf16_t*)shm;
    for (int tile = blockIdx.x; tile < NT_N * NT_M; tile += gridDim.x) {
        const int pm = tile / NT_N, pn = tile % NT_N, brow_ = pm * 128, bcol_ = pn * 128;
        f32x4 acc[4][4]; zero_acc(acc);
        int brow = brow_, bcol = bcol_;
        gemm_kloop(WS(bf16_t, OFF_MRG), 1024, WS(bf16_t, OFF_WOUT), 1024, 1024, brow, bcol, acc, shm);
        asm volatile("" : "+s"(brow), "+s"(bcol));
#pragma unroll
        for (int m = 0; m < 4; ++m)
#pragma unroll
            for (int n = 0; n < 4; ++n)
#pragma unroll
                for (int j = 0; j < 4; ++j) st[(wr * 64 + m * 16 + fq * 4 + j) * EPI_LD + wc * 64 + n * 16 + fr] = f2bf(acc[m][n][j]);
        __syncthreads();
#pragma unroll 2
        for (int i = 0; i < 8; ++i) {
            const int q = tid + 256 * i, r = q >> 4, c = q & 15;
            const uint4 a = *(const uint4*)(shm + (r * EPI_LD + c * 8) * 2);
            const float* xp = p.x + (size_t)(brow + r) * DM + bcol + c * 8;
            const float4 x0 = *(const float4*)xp, x1 = *(const float4*)(xp + 4);
            const float h0 = x0.x + __uint_as_float(a.x << 16), h1 = x0.y + __uint_as_float(a.x & 0xFFFF0000u);
            const float h2 = x0.z + __uint_as_float(a.y << 16), h3 = x0.w + __uint_as_float(a.y & 0xFFFF0000u);
            const float h4 = x1.x + __uint_as_float(a.z << 16), h5 = x1.y + __uint_as_float(a.z & 0xFFFF0000u);
            const float h6 = x1.z + __uint_as_float(a.w << 16), h7 = x1.w + __uint_as_float(a.w & 0xFFFF0000u);
            *(uint4*)(WS(bf16_t, OFF_H2B) + (size_t)(brow + r) * DM + bcol + c * 8) = make_uint4(pack2(h0, h1), pack2(h2, h3), pack2(h4, h5), pack2(h6, h7));
            float ss = (h0 * h0 + h1 * h1) + (h2 * h2 + h3 * h3) + (h4 * h4 + h5 * h5) + (h6 * h6 + h7 * h7);
            ss = row_sum16(ss);
            if (c == 0) WS(float, OFF_SSQ)[(size_t)pn * T + brow + r] = ss;
        }
        __syncthreads();
    }
}

__device__ __forceinline__ float row_rstd(const P& p, int row) {
    float s = 0.f;
#pragma unroll
    for (int i = 0; i < 8; ++i) s += WS(float, OFF_SSQ)[(size_t)i * T + row];
    return rsqrtf(s * (1.f / DM) + EPS);
}

__device__ __forceinline__ void ph_gemm_qry(const P& p, char* shm) {
    const int tid = threadIdx.x, wid = tid >> 6, lane = tid & 63, wr = wid >> 1, wc = wid & 1, fr = lane & 15, fq = lane >> 4;
    constexpr int NT_N = 8, NT_M = T / 128;
    for (int tile = blockIdx.x; tile < NT_N * NT_M; tile += gridDim.x) {
        const int pm = tile / NT_N, pn = tile % NT_N, brow_ = pm * 128, bcol_ = pn * 128;
        f32x4 acc[4][4]; zero_acc(acc);
        int brow = brow_, bcol = bcol_;
        gemm_kloop(WS(bf16_t, OFF_H2B), 1024, WS(bf16_t, OFF_WQ), 1024, 1024, brow, bcol, acc, shm);
        asm volatile("" : "+s"(brow), "+s"(bcol));
#pragma unroll
        for (int m = 0; m < 4; ++m)
#pragma unroll
            for (int j = 0; j < 4; ++j) {
                const int row = brow + wr * 64 + m * 16 + fq * 4 + j;
                const float rstd = row_rstd(p, row);
                if (bcol == 0 && wc == 0 && fr == 0) WS(float, OFF_RSTD)[row] = rstd;
#pragma unroll
                for (int n = 0; n < 4; ++n) {
                    const int col = bcol + wc * 64 + n * 16 + fr;
                    WS(bf16_t, OFF_QRY)[(size_t)row * DM + col] = f2bf(acc[m][n][j] * rstd);
                }
            }
    }
}

#if ATTN_SIMPLE
__device__ __forceinline__ void d_attn_simple(const P& p, int unit) {
    const int gid = unit * 256 + threadIdx.x;
    const int hq = gid / T, t = gid % T, b = t / SEQ, s = t % SEQ, pq = 128 + s, kvh = hq >> 2;
    const bf16_t* qp = WS(bf16_t, OFF_QB) + ((size_t)b * LP + pq) * 512 + hq * 64;
    float q[64], o[64];
#pragma unroll
    for (int d = 0; d < 64; ++d) { q[d] = bf2f(qp[d]); o[d] = 0.f; }
    float m = p.sinks[hq], l = 1.f;
    const bf16_t* kbase = WS(bf16_t, OFF_KB) + (size_t)b * LP * 128 + kvh * 64;
    const bf16_t* vbase = WS(bf16_t, OFF_VB) + (size_t)b * LP * 128 + kvh * 64;
    const int lo = (pq - 127 > 128) ? (pq - 127) : 128;
    const int nkeys = 16 + (pq - lo + 1);
    for (int i = 0; i < nkeys; ++i) {
        const int pk = (i < 16) ? (PADF + i) : (lo + i - 16);
        const bf16_t* kp = kbase + (size_t)pk * 128;
        const bf16_t* vp = vbase + (size_t)pk * 128;
        float sc = 0.f;
#pragma unroll
        for (int d = 0; d < 64; ++d) sc += q[d] * bf2f(kp[d]);
        const float mn = fmaxf(m, sc), a = __expf(m - mn), e = __expf(sc - mn);
        l = l * a + e;
#pragma unroll
        for (int d = 0; d < 64; ++d) o[d] = o[d] * a + e * bf2f(vp[d]);
        m = mn;
    }
    const float inv = 1.f / l;
    bf16_t* op = WS(bf16_t, OFF_ATT) + (size_t)t * 512 + hq * 64;
#pragma unroll
    for (int d = 0; d < 64; ++d) op[d] = f2bf(o[d] * inv);
}

#endif
constexpr int LDV = 280;
__device__ __forceinline__ void d_attn(const P& p, int unit, char* shm) {
    bf16_t* VT = (bf16_t*)shm;
    const int tid = threadIdx.x, lane = tid & 63, fr = lane & 15, fq = lane >> 4;
    const int w = __builtin_amdgcn_readfirstlane(tid >> 6);
    const int hq = unit & 7, n = ((unit >> 3) & 31) + 1, b = unit >> 8, kvh = hq >> 2;
    const size_t rb = (size_t)b * LP;
    const int kb0 = 128 * (n - 1);
    const bf16_t* kbp = WS(bf16_t, OFF_KB) + kvh * 64;
    const bf16_t* vbp = WS(bf16_t, OFF_VB) + kvh * 64;
#pragma unroll 1
    for (int i = 0; i < 9; ++i) {
        const int c = tid + 256 * i;
        if (c < 2176) {
            const int x = c >> 3, dc = c & 7;
            const int pos = (x < 256) ? (kb0 + x) : (PADF + x - 256);
            const uint4 v = *(const uint4*)(vbp + (rb + pos) * 128 + 8 * dc);
            bf16_t* dst = VT + (8 * dc) * LDV + x;
            dst[0 * LDV] = (bf16_t)(v.x & 0xFFFF); dst[1 * LDV] = (bf16_t)(v.x >> 16);
            dst[2 * LDV] = (bf16_t)(v.y & 0xFFFF); dst[3 * LDV] = (bf16_t)(v.y >> 16);
            dst[4 * LDV] = (bf16_t)(v.z & 0xFFFF); dst[5 * LDV] = (bf16_t)(v.z >> 16);
            dst[6 * LDV] = (bf16_t)(v.w & 0xFFFF); dst[7 * LDV] = (bf16_t)(v.w >> 16);
        }
    }
    __syncthreads();
    bf16x8 qf[2][2];
#pragma unroll
    for (int u = 0; u < 2; ++u)
#pragma unroll
        for (int ks = 0; ks < 2; ++ks)
            qf[u][ks] = *(const bf16x8*)(WS(bf16_t, OFF_QB) + (rb + 128 * n + 32 * w + 16 * u + fr) * 512 + hq * 64 + 32 * ks + 8 * fq);
    f32x4 s[11][2];
#pragma unroll
    for (int tt = 0; tt < 11; ++tt) {
        const int x0 = (tt < 10) ? (32 * w + 16 * tt) : 256;
        const int pos = ((tt < 10) ? (kb0 + x0) : PADF) + fr;
        const bf16x8 k0 = *(const bf16x8*)(kbp + (rb + pos) * 128 + 8 * fq);
        const bf16x8 k1 = *(const bf16x8*)(kbp + (rb + pos) * 128 + 32 + 8 * fq);
#pragma unroll
        for (int u = 0; u < 2; ++u) {
            f32x4 c = (f32x4){0.f, 0.f, 0.f, 0.f};
            c = __builtin_amdgcn_mfma_f32_16x16x32_bf16(k0, qf[u][0], c, 0, 0, 0);
            c = __builtin_amdgcn_mfma_f32_16x16x32_bf16(k1, qf[u][1], c, 0, 0, 0);
            if (tt < 10) {
                const int xq = 128 + 32 * w + 16 * u + fr;
#pragma unroll
                for (int j = 0; j < 4; ++j) {
                    const int x = x0 + 4 * fq + j, dq = xq - x;
                    const bool ok = (dq >= 0) && (dq < 128) && (kb0 + x >= 128);
                    c[j] = ok ? c[j] : -1.0e30f;
                }
            }
            s[tt][u] = c;
        }
    }
    const float sink = p.sinks[hq];
    float inv[2];
#pragma unroll
    for (int u = 0; u < 2; ++u) {
        float m = sink;
#pragma unroll
        for (int tt = 0; tt < 11; ++tt)
#pragma unroll
            for (int j = 0; j < 4; ++j) m = fmaxf(m, s[tt][u][j]);
        m = fmaxf(m, __shfl_xor(m, 16)); m = fmaxf(m, __shfl_xor(m, 32));
        float l = 0.f;
#pragma unroll
        for (int tt = 0; tt < 11; ++tt)
#pragma unroll
            for (int j = 0; j < 4; ++j) { const float e = __expf(s[tt][u][j] - m); s[tt][u][j] = e; l += e; }
        l += __shfl_xor(l, 16); l += __shfl_xor(l, 32);
        l += __expf(sink - m);
        inv[u] = 1.f / l;
    }
    f32x4 o[4][2];
#pragma unroll
    for (int dt = 0; dt < 4; ++dt)
#pragma unroll
        for (int u = 0; u < 2; ++u) o[dt][u] = (f32x4){0.f, 0.f, 0.f, 0.f};
#pragma unroll
    for (int g = 0; g < 6; ++g) {
        const int xa = (g < 5) ? (32 * w + 32 * g) : 256, xb = (g < 5) ? (xa + 16) : 256;
        bf16x8 pf[2];
#pragma unroll
        for (int u = 0; u < 2; ++u) {
#pragma unroll
            for (int j = 0; j < 4; ++j) {
                pf[u][j] = (short)f2bf(s[2 * g][u][j]);
                pf[u][4 + j] = (g < 5) ? (short)f2bf(s[(g < 5) ? (2 * g + 1) : 0][u][j]) : (short)0;
            }
        }
#pragma unroll
        for (int dt = 0; dt < 4; ++dt) {
            const uint2 a0 = *(const uint2*)(VT + (16 * dt + fr) * LDV + xa + 4 * fq);
            const uint2 a1 = *(const uint2*)(VT + (16 * dt + fr) * LDV + xb + 4 * fq);
            union { uint4 q; bf16x8 v; } av; av.q = make_uint4(a0.x, a0.y, a1.x, a1.y);
#pragma unroll
            for (int u = 0; u < 2; ++u) o[dt][u] = __builtin_amdgcn_mfma_f32_16x16x32_bf16(av.v, pf[u], o[dt][u], 0, 0, 0);
        }
    }
#pragma unroll
    for (int u = 0; u < 2; ++u) {
        const size_t t = (size_t)b * SEQ + 128 * (n - 1) + 32 * w + 16 * u + fr;
#pragma unroll
        for (int dt = 0; dt < 4; ++dt) {
            uint2 ov;
            ov.x = pack2(o[dt][u][0] * inv[u], o[dt][u][1] * inv[u]);
            ov.y = pack2(o[dt][u][2] * inv[u], o[dt][u][3] * inv[u]);
            *(uint2*)(WS(bf16_t, OFF_ATT) + t * 512 + hq * 64 + 16 * dt + 4 * fq) = ov;
        }
    }
    __syncthreads();
}

#if HGRN_SIMPLE
__device__ __forceinline__ void d_hgrn_simple(const P& p, int bh, char* shm) {
    float (*fs)[128] = (float (*)[128])shm;
    float (*ks)[128] = (float (*)[128])(shm + 4096);
    float (*qs)[128] = (float (*)[128])(shm + 8192);
    float (*os)[128] = (float (*)[128])(shm + 12288);
    float (*red)[2] = (float (*)[2])(shm + 16384);
    const int b = bh >> 2, h = bh & 3, e = threadIdx.x & 127;
    const bool act = threadIdx.x < 128;
    float S[128];
#pragma unroll
    for (int d = 0; d < 128; ++d) S[d] = 0.f;
    const float g = p.g_rec[h * 128 + e];
    for (int p0 = PADF; p0 < LP; p0 += 8) {
        float v[8];
        if (act) {
#pragma unroll
            for (int i = 0; i < 8; ++i) {
                const size_t r = (size_t)b * LP + p0 + i;
                const float lf = WS(float, OFF_LOGF)[r * 512 + h * 128 + e] - (((p0 + i) & 63) ? WS(float, OFF_LOGF)[(r - 1) * 512 + h * 128 + e] : 0.f);
                const float f = __expf(lf);
                fs[i][e] = f; ks[i][e] = 1.f - f;
                qs[i][e] = bf2f(WS(bf16_t, OFF_RQ)[r * 512 + h * 128 + e]);
                v[i] = bf2f(WS(bf16_t, OFF_RI)[r * 512 + h * 128 + e]);
            }
        }
        __syncthreads();
        if (act) {
#pragma unroll
            for (int i = 0; i < 8; ++i) {
                float o = 0.f;
#pragma unroll
                for (int d = 0; d < 128; ++d) { S[d] = fs[i][d] * S[d] + ks[i][d] * v[i]; o += qs[i][d] * S[d]; }
                os[i][e] = o;
                const float ss = wave_sum(o * o);
                if ((e & 63) == 0) red[i][e >> 6] = ss;
            }
        }
        __syncthreads();
        if (act && p0 >= 128) {
#pragma unroll
            for (int i = 0; i < 8; ++i) {
                const size_t r = (size_t)b * LP + p0 + i;
                const size_t t = (size_t)b * SEQ + (p0 + i - 128);
                const float rstd = rsqrtf((red[i][0] + red[i][1]) * (1.f / 128.f) + EPS);
                const float val = os[i][e] * rstd * g * bf2f(WS(bf16_t, OFF_RG)[r * 512 + h * 128 + e]);
                WS(bf16_t, OFF_REC)[t * 512 + h * 128 + e] = f2bf(val);
            }
        }
        __syncthreads();
    }
}

#endif

constexpr int LD64 = 72;
constexpr int LD128 = 136;

__device__ __forceinline__ void d_hgrn_A(const P& p, int unit, char* shm) {
    bf16_t* VT = (bf16_t*)shm;
    bf16_t* KT = (bf16_t*)(shm + 128 * LD64 * 2);
    const int tid = threadIdx.x, wid = tid >> 6, lane = tid & 63, fr = lane & 15, fq = lane >> 4;
    const int bh = unit >> 6, n = (unit & 63) + 1, b = bh >> 2, h = bh & 3;
    const int c = tid & 127, half = tid >> 7;
    const size_t r0 = (size_t)b * LP + 64 * n;
    const float* bb = WS(float, OFF_LOGF) + r0 * 512 + h * 128 + c;
    const bf16_t* vv = WS(bf16_t, OFF_RI) + r0 * 512 + h * 128 + c;
    {
        const float blast = bb[63 * 512];
        float prev = half ? bb[31 * 512] : 0.f;
        const float* bp = bb + (size_t)(32 * half) * 512;
        const bf16_t* vp_ = vv + (size_t)(32 * half) * 512;
#pragma unroll 1
        for (int g = 0; g < 4; ++g) {
            float bs[8]; uint32_t vs[8];
#pragma unroll
            for (int i = 0; i < 8; ++i) { bs[i] = bp[i * 512]; vs[i] = vp_[i * 512]; }
            uint32_t kp[4], vp[4];
#pragma unroll
            for (int i = 0; i < 8; i += 2) {
                const float k0 = (1.f - __expf(bs[i] - prev)) * __expf(blast - bs[i]);
                const float k1 = (1.f - __expf(bs[i + 1] - bs[i])) * __expf(blast - bs[i + 1]);
                prev = bs[i + 1];
                kp[i >> 1] = pack2(k0, k1);
                vp[i >> 1] = vs[i] | (vs[i + 1] << 16);
            }
            *(uint4*)(KT + c * LD64 + 32 * half + 8 * g) = make_uint4(kp[0], kp[1], kp[2], kp[3]);
            *(uint4*)(VT + c * LD64 + 32 * half + 8 * g) = make_uint4(vp[0], vp[1], vp[2], vp[3]);
            bp += 8 * 512; vp_ += 8 * 512;
        }
    }
    __syncthreads();
    f32x4 acc[2][8];
#pragma unroll
    for (int mi = 0; mi < 2; ++mi)
#pragma unroll
        for (int n8 = 0; n8 < 8; ++n8) acc[mi][n8] = (f32x4){0.f, 0.f, 0.f, 0.f};
#pragma unroll
    for (int ks = 0; ks < 2; ++ks) {
        bf16x8 a[2];
#pragma unroll
        for (int mi = 0; mi < 2; ++mi) a[mi] = *(const bf16x8*)(VT + (32 * wid + 16 * mi + fr) * LD64 + 32 * ks + 8 * fq);
#pragma unroll
        for (int n8 = 0; n8 < 8; ++n8) {
            const bf16x8 bf = *(const bf16x8*)(KT + (16 * n8 + fr) * LD64 + 32 * ks + 8 * fq);
#pragma unroll
            for (int mi = 0; mi < 2; ++mi) acc[mi][n8] = __builtin_amdgcn_mfma_f32_16x16x32_bf16(a[mi], bf, acc[mi][n8], 0, 0, 0);
        }
    }
    bf16_t* dst = WS(bf16_t, OFF_DS) + (size_t)unit * 16384;
#pragma unroll
    for (int mi = 0; mi < 2; ++mi)
#pragma unroll
        for (int n8 = 0; n8 < 8; ++n8)
#pragma unroll
            for (int j = 0; j < 4; ++j) dst[(32 * wid + 16 * mi + 4 * fq + j) * 128 + 16 * n8 + fr] = f2bf(acc[mi][n8][j]);
    __syncthreads();
}

__device__ __forceinline__ void d_hgrn_scan(const P& p, int unit) {
    const int gid = unit * 256 + threadIdx.x;
    const int bh = gid >> 13, rem = gid & 8191, e = rem >> 6, d2 = (rem & 63) * 2;
    uint32_t* base = (uint32_t*)(WS(bf16_t, OFF_DS) + (size_t)bh * 64 * 16384 + e * 128 + d2);
    const float* bb = WS(float, OFF_LOGF) + ((size_t)(bh >> 2) * LP + 64 + 63) * 512 + (bh & 3) * 128 + d2;
    float s0 = 0.f, s1 = 0.f;
#pragma unroll 8
    for (int j = 0; j < 64; ++j) {
        const uint32_t x = base[(size_t)j * 8192];
        const float2 bl = *(const float2*)(bb + (size_t)j * 64 * 512);
        s0 = __expf(bl.x) * s0 + __uint_as_float(x << 16);
        s1 = __expf(bl.y) * s1 + __uint_as_float(x & 0xFFFF0000u);
        base[(size_t)j * 8192] = pack2(s0, s1);
    }
}

__device__ __forceinline__ void d_hgrn_C(const P& p, int unit, char* shm) {
    bf16_t* KS = (bf16_t*)shm;
    bf16_t* KD = KS + 64 * LD128;
    bf16_t* VT = KD + 64 * LD128;
    bf16_t* AM = VT + 128 * LD64;
    const int tid = threadIdx.x, lane = tid & 63, fr = lane & 15, fq = lane >> 4;
    const int wi = __builtin_amdgcn_readfirstlane(tid >> 6);
    const int bh = unit >> 6, n = (unit & 63) + 2, b = bh >> 2, h = bh & 3;
    const size_t r0 = (size_t)b * LP + 64 * n;
    const size_t t0 = (size_t)b * SEQ + 64 * n - 128;
    {
        const int c = tid & 127, half = tid >> 7;
        const float* bb = WS(float, OFF_LOGF) + r0 * 512 + h * 128 + c;
        const bf16_t* vv = WS(bf16_t, OFF_RI) + r0 * 512 + h * 128 + c;
        float prev = half ? bb[31 * 512] : 0.f;
        const float* bp = bb + (size_t)(32 * half) * 512;
        const bf16_t* vp_ = vv + (size_t)(32 * half) * 512;
#pragma unroll 1
        for (int g = 0; g < 4; ++g) {
            const int s0 = 32 * half + 8 * g, sb = s0 & ~15;
            const float bend = bb[(size_t)(sb + 15) * 512];
            const float bref = (sb == 0) ? 0.f : bb[(size_t)(sb - 1) * 512];
            float bs[8]; uint32_t vs[8];
#pragma unroll
            for (int i = 0; i < 8; ++i) { bs[i] = bp[i * 512]; vs[i] = vp_[i * 512]; }
#pragma unroll
            for (int i = 0; i < 8; ++i) {
                const float k = 1.f - __expf(bs[i] - prev);
                prev = bs[i];
                KS[(s0 + i) * LD128 + c] = f2bf(k * __expf(bend - bs[i]));
                KD[(s0 + i) * LD128 + c] = f2bf(k * __expf(bref - bs[i]));
            }
            *(uint4*)(VT + c * LD64 + s0) = make_uint4(vs[0] | (vs[1] << 16), vs[2] | (vs[3] << 16), vs[4] | (vs[5] << 16), vs[6] | (vs[7] << 16));
            bp += 8 * 512; vp_ += 8 * 512;
        }
#pragma unroll
        for (int i = 0; i < 9; ++i) ((uint32_t*)AM)[tid + 256 * i] = 0u;
    }
    __syncthreads();
    const int tl = 16 * wi + fr;
    bf16x8 qf[4]; float bt[4][8];
    {
        const bf16_t* qrow = WS(bf16_t, OFF_RQ) + (r0 + tl) * 512 + h * 128 + 8 * fq;
        const float* brow = WS(float, OFF_LOGF) + (r0 + tl) * 512 + h * 128 + 8 * fq;
#pragma unroll
        for (int ks = 0; ks < 4; ++ks) {
            qf[ks] = *(const bf16x8*)(qrow + 32 * ks);
            const float4 x0 = *(const float4*)(brow + 32 * ks), x1 = *(const float4*)(brow + 32 * ks + 4);
            bt[ks][0] = x0.x; bt[ks][1] = x0.y; bt[ks][2] = x0.z; bt[ks][3] = x0.w; bt[ks][4] = x1.x; bt[ks][5] = x1.y; bt[ks][6] = x1.z; bt[ks][7] = x1.w;
        }
    }
    auto qfrag = [&](int ks, const float* refrow) -> bf16x8 {
        float rf[8];
        if (refrow) {
            const float4 x0 = *(const float4*)(refrow + 32 * ks), x1 = *(const float4*)(refrow + 32 * ks + 4);
            rf[0] = x0.x; rf[1] = x0.y; rf[2] = x0.z; rf[3] = x0.w; rf[4] = x1.x; rf[5] = x1.y; rf[6] = x1.z; rf[7] = x1.w;
        } else {
#pragma unroll
            for (int jj = 0; jj < 8; ++jj) rf[jj] = 0.f;
        }
        bf16x8 o;
#pragma unroll
        for (int jj = 0; jj < 8; ++jj) o[jj] = (short)f2bf(bf2f((bf16_t)qf[ks][jj]) * __expf(bt[ks][jj] - rf[jj]));
        return o;
    };
    const float* bchunk = WS(float, OFF_LOGF) + r0 * 512 + h * 128 + 8 * fq;
    f32x4 acc[8];
#pragma unroll
    for (int n8 = 0; n8 < 8; ++n8) acc[n8] = (f32x4){0.f, 0.f, 0.f, 0.f};
    {
        const bf16_t* sp = WS(bf16_t, OFF_DS) + (size_t)unit * 16384 + fr * 128 + 8 * fq;
#pragma unroll
        for (int ks = 0; ks < 4; ++ks) {
            const bf16x8 a = qfrag(ks, nullptr);
#pragma unroll
            for (int n8 = 0; n8 < 8; ++n8) {
                const bf16x8 bf = *(const bf16x8*)(sp + (size_t)n8 * 16 * 128 + 32 * ks);
                acc[n8] = __builtin_amdgcn_mfma_f32_16x16x32_bf16(a, bf, acc[n8], 0, 0, 0);
            }
        }
    }
    for (int j = 0; j < wi; ++j) {
        f32x4 c4 = (f32x4){0.f, 0.f, 0.f, 0.f};
        const float* refrow = bchunk + (size_t)(16 * j + 15) * 512;
#pragma unroll
        for (int ks = 0; ks < 4; ++ks) {
            const bf16x8 a = qfrag(ks, refrow);
            const bf16x8 bf = *(const bf16x8*)(KS + (16 * j + fr) * LD128 + 32 * ks + 8 * fq);
            c4 = __builtin_amdgcn_mfma_f32_16x16x32_bf16(a, bf, c4, 0, 0, 0);
        }
#pragma unroll
        for (int jj = 0; jj < 4; ++jj) AM[(16 * wi + 4 * fq + jj) * LD64 + 16 * j + fr] = f2bf(c4[jj]);
    }
    {
        f32x4 c4 = (f32x4){0.f, 0.f, 0.f, 0.f};
        const float* refrow = (wi > 0) ? (bchunk + (size_t)(16 * wi - 1) * 512) : nullptr;
#pragma unroll
        for (int ks = 0; ks < 4; ++ks) {
            const bf16x8 a = qfrag(ks, refrow);
            const bf16x8 bf = *(const bf16x8*)(KD + (16 * wi + fr) * LD128 + 32 * ks + 8 * fq);
            c4 = __builtin_amdgcn_mfma_f32_16x16x32_bf16(a, bf, c4, 0, 0, 0);
        }
#pragma unroll
        for (int jj = 0; jj < 4; ++jj) AM[(16 * wi + 4 * fq + jj) * LD64 + 16 * wi + fr] = f2bf((fr <= 4 * fq + jj) ? c4[jj] : 0.f);
    }
    __syncthreads();
#pragma unroll
    for (int ks = 0; ks < 2; ++ks) {
        const bf16x8 a = *(const bf16x8*)(AM + (16 * wi + fr) * LD64 + 32 * ks + 8 * fq);
#pragma unroll
        for (int n8 = 0; n8 < 8; ++n8) {
            const bf16x8 bf = *(const bf16x8*)(VT + (16 * n8 + fr) * LD64 + 32 * ks + 8 * fq);
            acc[n8] = __builtin_amdgcn_mfma_f32_16x16x32_bf16(a, bf, acc[n8], 0, 0, 0);
        }
    }
#pragma unroll
    for (int jj = 0; jj < 4; ++jj) {
        float ss = 0.f;
#pragma unroll
        for (int n8 = 0; n8 < 8; ++n8) ss += acc[n8][jj] * acc[n8][jj];
        ss += __shfl_xor(ss, 1); ss += __shfl_xor(ss, 2); ss += __shfl_xor(ss, 4); ss += __shfl_xor(ss, 8);
        const float rstd = rsqrtf(ss * (1.f / 128.f) + EPS);
        const int trow = 16 * wi + 4 * fq + jj;
#pragma unroll
        for (int n8 = 0; n8 < 8; ++n8) {
            const int e = 16 * n8 + fr;
            const float val = acc[n8][jj] * rstd * p.g_rec[h * 128 + e] * bf2f(WS(bf16_t, OFF_RG)[(r0 + trow) * 512 + h * 128 + e]);
            WS(bf16_t, OFF_REC)[(t0 + trow) * 512 + h * 128 + e] = f2bf(val);
        }
        asm volatile("" ::: "memory");
    }
    __syncthreads();
}

#if TOPK_SIMPLE
__device__ __forceinline__ void d_peer_topk_simple(const P& p, int unit) {
    const int t = (unit >> 3) * 256 + threadIdx.x, h = unit & 7;
    const bf16_t* qp = WS(bf16_t, OFF_QRY) + (size_t)t * DM + h * 128;
    float tv[2][16]; int ti[2][16];
#pragma unroll
    for (int pp = 0; pp < 2; ++pp) {
        float q[64];
#pragma unroll
        for (int d = 0; d < 64; ++d) q[d] = bf2f(qp[pp * 64 + d]);
#pragma unroll
        for (int i = 0; i < 16; ++i) { tv[pp][i] = -3.0e38f; ti[pp][i] = 0; }
        const bf16_t* kp = WS(bf16_t, OFF_KEYS) + (size_t)(h * 2 + pp) * 128 * 64;
        for (int n = 0; n < 128; ++n) {
            float sc = 0.f;
#pragma unroll
            for (int d = 0; d < 64; ++d) sc += q[d] * bf2f(kp[n * 64 + d]);
            float xv = sc; int xi = n;
#pragma unroll
            for (int i = 0; i < 16; ++i) {
                if (xv > tv[pp][i]) { const float tf = tv[pp][i]; const int tn = ti[pp][i]; tv[pp][i] = xv; ti[pp][i] = xi; xv = tf; xi = tn; }
            }
        }
    }
    float bv[16]; int bi[16];
#pragma unroll
    for (int i = 0; i < 16; ++i) { bv[i] = -3.0e38f; bi[i] = 0; }
#pragma unroll
    for (int i = 0; i < 16; ++i)
#pragma unroll
        for (int j = 0; j < 16; ++j) {
            if ((i + 1) * (j + 1) <= 16) {
                float xv = tv[0][i] + tv[1][j]; int xi = ti[0][i] * 128 + ti[1][j];
#pragma unroll
                for (int k = 0; k < 16; ++k) {
                    if (xv > bv[k]) { const float tf = bv[k]; const int tn = bi[k]; bv[k] = xv; bi[k] = xi; xv = tf; xi = tn; }
                }
            }
        }
    float se = 0.f, ev[16];
#pragma unroll
    for (int k = 0; k < 16; ++k) { ev[k] = __expf(bv[k] - bv[0]); se += ev[k]; }
    const float inv = 1.f / se;
#pragma unroll
    for (int k = 0; k < 16; ++k) {
        WS(int, OFF_PIDX)[(size_t)t * 128 + h * 16 + k] = bi[k];
        WS(float, OFF_PGATE)[(size_t)t * 128 + h * 16 + k] = ev[k] * inv;
    }
}

#endif
template <int N> __device__ __forceinline__ void bitonic_sort_desc(float (&v)[N]) {
#pragma unroll
    for (int k = 2; k <= N; k <<= 1)
#pragma unroll
        for (int j = k >> 1; j > 0; j >>= 1)
#pragma unroll
            for (int i = 0; i < N; ++i) {
                const int l = i ^ j;
                if (l > i) {
                    const bool desc = ((i & k) == 0);
                    const float a = v[i], b = v[l];
                    const float hi = fmaxf(a, b), lo = fminf(a, b);
                    v[i] = desc ? hi : lo; v[l] = desc ? lo : hi;
                }
            }
}
template <int N> __device__ __forceinline__ void bitonic_merge_desc(float (&v)[N]) {
#pragma unroll
    for (int j = N >> 1; j > 0; j >>= 1)
#pragma unroll
        for (int i = 0; i < N; ++i) {
            const int l = i ^ j;
            if (l > i) { const float a = v[i], b = v[l]; v[i] = fmaxf(a, b); v[l] = fminf(a, b); }
        }
}
__device__ __forceinline__ void ph_peer_qry_topk(const P& p, char* shm) {
    const int tid = threadIdx.x, wid = tid >> 6, lane = tid & 63, wr = wid >> 1, wc = wid & 1, fr = lane & 15, fq = lane >> 4;
    float* tops = (float*)shm;
    for (int unit = blockIdx.x; unit < (T / 128) * 8; unit += gridDim.x) {
        const int h = unit & 7, t0 = (unit >> 3) * 128;
        f32x4 acc[4][4]; zero_acc(acc);
        gemm_kloop(WS(bf16_t, OFF_WQ), 1024, WS(bf16_t, OFF_H2B), 1024, 1024, h * 128, t0, acc, shm);
        int tb = t0 + wc * 64 + fr;
        asm volatile("" : "+v"(tb));
        const bf16_t* kbase = WS(bf16_t, OFF_KEYS) + (size_t)((h * 2 + wr) * 128 + fr) * 64 + 4 * fq;
#pragma unroll
        for (int n = 0; n < 4; ++n) {
            const int t = tb + n * 16;
            const float rstd = row_rstd(p, t);
            if (wr == 0 && fq == 0 && h == 0) WS(float, OFF_RSTD)[t] = rstd;
            bf16x8 bq[2];
#pragma unroll
            for (int ks = 0; ks < 2; ++ks)
#pragma unroll
                for (int j = 0; j < 4; ++j) { bq[ks][j] = (short)f2bf(acc[2 * ks][n][j] * rstd); bq[ks][4 + j] = (short)f2bf(acc[2 * ks + 1][n][j] * rstd); }
            float v[32];
#pragma unroll
            for (int mk = 0; mk < 8; ++mk) {
                f32x4 c = (f32x4){0.f, 0.f, 0.f, 0.f};
#pragma unroll
                for (int ks = 0; ks < 2; ++ks) {
                    const uint2 a0 = *(const uint2*)(kbase + (size_t)mk * 16 * 64 + 32 * ks);
                    const uint2 a1 = *(const uint2*)(kbase + (size_t)mk * 16 * 64 + 32 * ks + 16);
                    union { uint4 q; bf16x8 v; } av; av.q = make_uint4(a0.x, a0.y, a1.x, a1.y);
                    c = __builtin_amdgcn_mfma_f32_16x16x32_bf16(av.v, bq[ks], c, 0, 0, 0);
                }
#pragma unroll
                for (int j = 0; j < 4; ++j) v[4 * mk + j] = __uint_as_float((__float_as_uint(c[j]) & ~0x7Fu) | (unsigned)(16 * mk + 4 * fq + j));
            }
            float m[16];
            {
                float h0[16], h1[16];
#pragma unroll
                for (int i = 0; i < 16; ++i) { h0[i] = v[i]; h1[i] = v[16 + i]; }
                bitonic_sort_desc<16>(h0); bitonic_sort_desc<16>(h1);
#pragma unroll
                for (int i = 0; i < 16; ++i) m[i] = fmaxf(h0[i], h1[15 - i]);
                bitonic_merge_desc<16>(m);
            }
#pragma unroll
            for (int off = 16; off <= 32; off <<= 1) {
                float o[16];
#pragma unroll
                for (int i = 0; i < 16; ++i) o[i] = __shfl_xor(m[i], off);
#pragma unroll
                for (int i = 0; i < 16; ++i) m[i] = fmaxf(m[i], o[15 - i]);
                bitonic_merge_desc<16>(m);
            }
            if (fq == 0) {
                float4* dst = (float4*)(tops + ((size_t)wr * 128 + wc * 64 + n * 16 + fr) * 16);
                dst[0] = make_float4(m[0], m[1], m[2], m[3]); dst[1] = make_float4(m[4], m[5], m[6], m[7]);
                dst[2] = make_float4(m[8], m[9], m[10], m[11]); dst[3] = make_float4(m[12], m[13], m[14], m[15]);
            }
        }
        __syncthreads();
        if (tid < 128) {
            const float* ta = tops + (size_t)tid * 16;
            const float* tbp = tops + (size_t)(128 + tid) * 16;
            float a[16], b[16];
#pragma unroll
            for (int i = 0; i < 16; ++i) { a[i] = __uint_as_float(__float_as_uint(ta[i]) & ~0x7Fu); b[i] = __uint_as_float(__float_as_uint(tbp[i]) & ~0x7Fu); }
            float cand[64];
            int k = 0;
#pragma unroll
            for (int i = 0; i < 16; ++i)
#pragma unroll
                for (int j = 0; j < 16; ++j)
                    if ((i + 1) * (j + 1) <= 16) { cand[k] = __uint_as_float((__float_as_uint(a[i] + b[j]) & ~0xFFu) | (unsigned)(i * 16 + j)); ++k; }
#pragma unroll
            for (int kk = 50; kk < 64; ++kk) cand[kk] = -3.0e38f;
            bitonic_sort_desc<64>(cand);
            float ev[16], se = 0.f; int ex[16];
            const float best = __uint_as_float(__float_as_uint(cand[0]) & ~0xFFu);
#pragma unroll
            for (int q = 0; q < 16; ++q) {
                const unsigned bits = __float_as_uint(cand[q]);
                const int ci = (bits >> 4) & 15, cj = bits & 15;
                const int ia = (int)(__float_as_uint(ta[ci]) & 0x7Fu), ib = (int)(__float_as_uint(tbp[cj]) & 0x7Fu);
                ex[q] = ia * 128 + ib;
                ev[q] = __expf(__uint_as_float(bits & ~0xFFu) - best); se += ev[q];
            }
            const float inv = 1.f / se;
            int4* pi = (int4*)(WS(int, OFF_PIDX) + (size_t)(t0 + tid) * 128 + h * 16);
            float4* pg = (float4*)(WS(float, OFF_PGATE) + (size_t)(t0 + tid) * 128 + h * 16);
#pragma unroll
            for (int q = 0; q < 4; ++q) {
                pi[q] = make_int4(ex[4 * q], ex[4 * q + 1], ex[4 * q + 2], ex[4 * q + 3]);
                pg[q] = make_float4(ev[4 * q] * inv, ev[4 * q + 1] * inv, ev[4 * q + 2] * inv, ev[4 * q + 3] * inv);
            }
        }
        __syncthreads();
    }
}

#if PEER_SIMPLE
__device__ __forceinline__ void d_peer_expert(const P& p, int t, char* shm) {
    float* act = (float*)shm;
    float* red = (float*)(shm + 512);
    const int tid = threadIdx.x, wid = tid >> 6, lane = tid & 63;
    const float rstd = row_rstd(p, t);
    const float* h2 = WS(float, OFF_H2) + (size_t)t * DM;
    float xn[16];
#pragma unroll
    for (int i = 0; i < 4; ++i) {
        const float4 v = ((const float4*)h2)[lane * 4 + i];
        const float4 g = ((const float4*)p.g_ffn)[lane * 4 + i];
        xn[4 * i + 0] = v.x * rstd * g.x; xn[4 * i + 1] = v.y * rstd * g.y; xn[4 * i + 2] = v.z * rstd * g.z; xn[4 * i + 3] = v.w * rstd * g.w;
    }
    const int* idx = WS(int, OFF_PIDX) + (size_t)t * 128;
    const float* gate = WS(float, OFF_PGATE) + (size_t)t * 128;
    const bf16_t* edn = WS(bf16_t, OFF_EDN);
    const bf16_t* eup = WS(bf16_t, OFF_EUP);
    for (int e = wid; e < 128; e += 4) {
        const bf16_t* row = edn + (size_t)idx[e] * DM + lane * 16;
        const uint4 a = ((const uint4*)row)[0], c = ((const uint4*)row)[1];
        const uint32_t w[8] = {a.x, a.y, a.z, a.w, c.x, c.y, c.z, c.w};
        float s = 0.f;
#pragma unroll
        for (int i = 0; i < 8; ++i) s += xn[2 * i] * __uint_as_float(w[i] << 16) + xn[2 * i + 1] * __uint_as_float(w[i] & 0xFFFF0000u);
        s = wave_sum(s);
        if (lane == 0) act[e] = 0.5f * s * (1.f + erff(s * 0.70710678118654752f)) * gate[e];
    }
    __syncthreads();
    float y0 = 0.f, y1 = 0.f, y2 = 0.f, y3 = 0.f;
    for (int e = 0; e < 128; ++e) {
        const float a = act[e];
        const uint2 w = *(const uint2*)(eup + (size_t)idx[e] * DM + tid * 4);
        y0 += a * __uint_as_float(w.x << 16); y1 += a * __uint_as_float(w.x & 0xFFFF0000u);
        y2 += a * __uint_as_float(w.y << 16); y3 += a * __uint_as_float(w.y & 0xFFFF0000u);
    }
    const float4 hv = ((const float4*)h2)[tid];
    const float o0 = hv.x + y0, o1 = hv.y + y1, o2 = hv.z + y2, o3 = hv.w + y3;
    float ss = wave_sum(o0 * o0 + o1 * o1 + o2 * o2 + o3 * o3);
    if (lane == 0) red[wid] = ss;
    __syncthreads();
    ss = red[0] + red[1] + red[2] + red[3];
    const float rs = rsqrtf(ss * (1.f / DM) + EPS);
    const float4 g = ((const float4*)p.g_fin)[tid];
    float4 ov; ov.x = o0 * rs * g.x; ov.y = o1 * rs * g.y; ov.z = o2 * rs * g.z; ov.w = o3 * rs * g.w;
    ((float4*)(p.out + (size_t)t * DM))[tid] = ov;
    __syncthreads();
}

#endif
__device__ __forceinline__ float* part_ptr(const P& p, int c) {
    return WS(float, OFF_PART) + (size_t)c * T * 128;
}
__device__ __forceinline__ unsigned xcc_id() { return (unsigned)__builtin_amdgcn_s_getreg((3 << 11) | 20) & 7u; }

#define MEMFENCE() asm volatile("" ::: "memory")
typedef float f32x2_t __attribute__((ext_vector_type(2)));
__device__ __forceinline__ float dpp_xor1(float v) { return __builtin_amdgcn_update_dpp(0.f, v, 0xB1, 0xF, 0xF, false); }
__device__ __forceinline__ float dpp_xor2(float v) { return __builtin_amdgcn_update_dpp(0.f, v, 0x4E, 0xF, 0xF, false); }
__device__ __forceinline__ float swz_xor4(float v) { return __int_as_float(__builtin_amdgcn_ds_swizzle(__float_as_int(v), 0x101F)); }
__device__ __forceinline__ float gelu_as(float v) {
    const float av = fabsf(v), t = __builtin_amdgcn_rcpf(av * 0.2316418882f + 1.0f);
    float q = t * 0.5307027145f + (-0.7265760135f); q = q * t + 0.7107068705f; q = q * t + (-0.142248368f); q = q * t + 0.127414796f; q = q * t;
    const float m = v * (q * __builtin_amdgcn_exp2f((v * v) * (-0.72134752044f)));
    return v < 0.f ? m : v - m;
}
__device__ __forceinline__ float group8_transpose_sum(const float (&s)[8], int ch) {
    const bool b0 = ch & 1, b1 = (ch >> 1) & 1, b2 = (ch >> 2) & 1;
    float r4[4], r2[2];
#pragma unroll
    for (int j = 0; j < 4; ++j) { const float keep = b0 ? s[2 * j + 1] : s[2 * j], send = b0 ? s[2 * j] : s[2 * j + 1]; r4[j] = keep + dpp_xor1(send); }
#pragma unroll
    for (int j = 0; j < 2; ++j) { const float keep = b1 ? r4[2 * j + 1] : r4[2 * j], send = b1 ? r4[2 * j] : r4[2 * j + 1]; r2[j] = keep + dpp_xor2(send); }
    const float keep = b2 ? r2[1] : r2[0], send = b2 ? r2[0] : r2[1];
    return keep + swz_xor4(send);
}
constexpr int PEER_TILE = 32;
constexpr int PEER_WTOK = PEER_TILE / 4;
__device__ __forceinline__ void d_peer_e1_run(const P& p, int t0, int c, int lane) {
    const int g8 = lane >> 3, ch = lane & 7;
    const unsigned char* tab = WS(unsigned char, OFF_EDN);
    const unsigned loff = 128u * (unsigned)c + 16u * (unsigned)ch;
    float4 gf[4];
#pragma unroll
    for (int q = 0; q < 4; ++q) gf[q] = *(const float4*)(p.g_ffn + 128 * c + 16 * ch + 4 * q);
    const int4* ip = (const int4*)(WS(int, OFF_PIDX) + (size_t)t0 * 128 + 16 * g8);
    int4 nidx[4];
#pragma unroll
    for (int k = 0; k < 4; ++k) nidx[k] = ip[k];
#pragma unroll 1
    for (int tk = 0; tk < PEER_WTOK; ++tk) {
        const int t = t0 + tk;
        const unsigned idx[16] = {(unsigned)nidx[0].x, (unsigned)nidx[0].y, (unsigned)nidx[0].z, (unsigned)nidx[0].w, (unsigned)nidx[1].x, (unsigned)nidx[1].y, (unsigned)nidx[1].z, (unsigned)nidx[1].w,
                                  (unsigned)nidx[2].x, (unsigned)nidx[2].y, (unsigned)nidx[2].z, (unsigned)nidx[2].w, (unsigned)nidx[3].x, (unsigned)nidx[3].y, (unsigned)nidx[3].z, (unsigned)nidx[3].w};
        uint4 w[16];
#pragma unroll
        for (int k = 0; k < 16; ++k) w[k] = *(const uint4*)(tab + (idx[k] * 1024u + loff));
        const bf16_t* hp = WS(bf16_t, OFF_H2B) + (size_t)t * DM + 128 * c + 16 * ch;
        const uint4 h0 = *(const uint4*)hp, h1 = *(const uint4*)(hp + 8);
        const float rstd = WS(float, OFF_RSTD)[t];
        if (tk + 1 < PEER_WTOK) {
#pragma unroll
            for (int k = 0; k < 4; ++k) nidx[k] = ip[(tk + 1) * 32 + k];
        }
        MEMFENCE();
        f32x2_t x[8];
        {
            const uint32_t hw[8] = {h0.x, h0.y, h0.z, h0.w, h1.x, h1.y, h1.z, h1.w};
#pragma unroll
            for (int q = 0; q < 4; ++q) {
                x[2 * q] = (f32x2_t){__uint_as_float(hw[2 * q] << 16) * rstd * gf[q].x, __uint_as_float(hw[2 * q] & 0xFFFF0000u) * rstd * gf[q].y};
                x[2 * q + 1] = (f32x2_t){__uint_as_float(hw[2 * q + 1] << 16) * rstd * gf[q].z, __uint_as_float(hw[2 * q + 1] & 0xFFFF0000u) * rstd * gf[q].w};
            }
        }
        float res[2];
#pragma unroll
        for (int hh = 0; hh < 2; ++hh) {
            float s[8];
#pragma unroll
            for (int k = 0; k < 8; ++k) {
                const uint4 wk = w[8 * hh + k];
                f32x2_t a2 = __builtin_amdgcn_cvt_pk_f32_fp8((int)wk.x, false) * x[0];
                a2 = __builtin_elementwise_fma(__builtin_amdgcn_cvt_pk_f32_fp8((int)wk.x, true), x[1], a2);
                a2 = __builtin_elementwise_fma(__builtin_amdgcn_cvt_pk_f32_fp8((int)wk.y, false), x[2], a2);
                a2 = __builtin_elementwise_fma(__builtin_amdgcn_cvt_pk_f32_fp8((int)wk.y, true), x[3], a2);
                a2 = __builtin_elementwise_fma(__builtin_amdgcn_cvt_pk_f32_fp8((int)wk.z, false), x[4], a2);
                a2 = __builtin_elementwise_fma(__builtin_amdgcn_cvt_pk_f32_fp8((int)wk.z, true), x[5], a2);
                a2 = __builtin_elementwise_fma(__builtin_amdgcn_cvt_pk_f32_fp8((int)wk.w, false), x[6], a2);
                a2 = __builtin_elementwise_fma(__builtin_amdgcn_cvt_pk_f32_fp8((int)wk.w, true), x[7], a2);
                s[k] = a2[0] + a2[1];
            }
            res[hh] = group8_transpose_sum(s, ch);
        }
        float* pp = part_ptr(p, c) + (size_t)t * 128 + 16 * g8 + ch;
        pp[0] = res[0]; pp[8] = res[1];
    }
}

__device__ __forceinline__ void d_peer_e2_run(const P& p, int t0, int c, int lane, float* sact) {
    const int g8 = lane >> 3, ch = lane & 7;
    const unsigned char* tab = WS(unsigned char, OFF_EUP);
    const unsigned loff = 128u * (unsigned)c + 16u * (unsigned)ch;
    const bool b3 = (lane >> 3) & 1, b4 = (lane >> 4) & 1, b5 = (lane >> 5) & 1;
    const int col = 128 * c + 16 * ch + 8 * (int)b3 + 4 * (int)b4 + 2 * (int)b5;
    const int4* ip = (const int4*)(WS(int, OFF_PIDX) + (size_t)t0 * 128 + 16 * g8);
    int4 nidx[4];
    float npu[2][8], ngt[2];
#pragma unroll
    for (int k = 0; k < 4; ++k) nidx[k] = ip[k];
#pragma unroll
    for (int k = 0; k < 2; ++k) {
#pragma unroll
        for (int cc = 0; cc < 8; ++cc) npu[k][cc] = part_ptr(p, cc)[(size_t)t0 * 128 + lane + 64 * k];
        ngt[k] = WS(float, OFF_PGATE)[(size_t)t0 * 128 + lane + 64 * k];
    }
#pragma unroll 1
    for (int tk = 0; tk < PEER_WTOK; ++tk) {
        const int t = t0 + tk;
        const unsigned idx[16] = {(unsigned)nidx[0].x, (unsigned)nidx[0].y, (unsigned)nidx[0].z, (unsigned)nidx[0].w, (unsigned)nidx[1].x, (unsigned)nidx[1].y, (unsigned)nidx[1].z, (unsigned)nidx[1].w,
                                  (unsigned)nidx[2].x, (unsigned)nidx[2].y, (unsigned)nidx[2].z, (unsigned)nidx[2].w, (unsigned)nidx[3].x, (unsigned)nidx[3].y, (unsigned)nidx[3].z, (unsigned)nidx[3].w};
        uint4 w[16];
#pragma unroll
        for (int k = 0; k < 16; ++k) w[k] = *(const uint4*)(tab + (idx[k] * 1024u + loff));
        const uint32_t hb = *(const uint32_t*)(WS(bf16_t, OFF_H2B) + (size_t)t * DM + col);
        {
            const float u0 = (((npu[0][0] + npu[0][1]) + (npu[0][2] + npu[0][3])) + ((npu[0][4] + npu[0][5]) + (npu[0][6] + npu[0][7]))) * (1.f / 64.f);
            const float u1 = (((npu[1][0] + npu[1][1]) + (npu[1][2] + npu[1][3])) + ((npu[1][4] + npu[1][5]) + (npu[1][6] + npu[1][7]))) * (1.f / 64.f);
            sact[lane] = gelu_as(u0) * ngt[0] * 0.125f;
            sact[lane + 64] = gelu_as(u1) * ngt[1] * 0.125f;
        }
        if (tk + 1 < PEER_WTOK) {
#pragma unroll
            for (int k = 0; k < 4; ++k) nidx[k] = ip[(tk + 1) * 32 + k];
#pragma unroll
            for (int k = 0; k < 2; ++k) {
#pragma unroll
                for (int cc = 0; cc < 8; ++cc) npu[k][cc] = part_ptr(p, cc)[(size_t)(t + 1) * 128 + lane + 64 * k];
                ngt[k] = WS(float, OFF_PGATE)[(size_t)(t + 1) * 128 + lane + 64 * k];
            }
        }
        MEMFENCE();
        asm volatile("s_waitcnt lgkmcnt(0)" ::: "memory");
        float a[16];
        {
            const float4* ap = (const float4*)(sact + 16 * g8);
#pragma unroll
            for (int k = 0; k < 4; ++k) { const float4 v = ap[k]; a[4 * k] = v.x; a[4 * k + 1] = v.y; a[4 * k + 2] = v.z; a[4 * k + 3] = v.w; }
        }
        f32x2_t y[8];
#pragma unroll
        for (int k = 0; k < 8; ++k) y[k] = (f32x2_t){0.f, 0.f};
#pragma unroll
        for (int k = 0; k < 16; ++k) {
            const f32x2_t av = (f32x2_t){a[k], a[k]};
            const uint4 wk = w[k];
            y[0] = __builtin_elementwise_fma(__builtin_amdgcn_cvt_pk_f32_fp8((int)wk.x, false), av, y[0]);
            y[1] = __builtin_elementwise_fma(__builtin_amdgcn_cvt_pk_f32_fp8((int)wk.x, true), av, y[1]);
            y[2] = __builtin_elementwise_fma(__builtin_amdgcn_cvt_pk_f32_fp8((int)wk.y, false), av, y[2]);
            y[3] = __builtin_elementwise_fma(__builtin_amdgcn_cvt_pk_f32_fp8((int)wk.y, true), av, y[3]);
            y[4] = __builtin_elementwise_fma(__builtin_amdgcn_cvt_pk_f32_fp8((int)wk.z, false), av, y[4]);
            y[5] = __builtin_elementwise_fma(__builtin_amdgcn_cvt_pk_f32_fp8((int)wk.z, true), av, y[5]);
            y[6] = __builtin_elementwise_fma(__builtin_amdgcn_cvt_pk_f32_fp8((int)wk.w, false), av, y[6]);
            y[7] = __builtin_elementwise_fma(__builtin_amdgcn_cvt_pk_f32_fp8((int)wk.w, true), av, y[7]);
        }
        f32x2_t k4[4], k2[2], k1;
#pragma unroll
        for (int k = 0; k < 4; ++k) {
            const f32x2_t keep = b3 ? y[4 + k] : y[k], send = b3 ? y[k] : y[4 + k];
            k4[k] = keep + (f32x2_t){__shfl_xor(send[0], 8), __shfl_xor(send[1], 8)};
        }
#pragma unroll
        for (int k = 0; k < 2; ++k) {
            const f32x2_t keep = b4 ? k4[2 + k] : k4[k], send = b4 ? k4[k] : k4[2 + k];
            k2[k] = keep + (f32x2_t){__shfl_xor(send[0], 16), __shfl_xor(send[1], 16)};
        }
        {
            const f32x2_t keep = b5 ? k2[1] : k2[0], send = b5 ? k2[0] : k2[1];
            k1 = keep + (f32x2_t){__shfl_xor(send[0], 32), __shfl_xor(send[1], 32)};
        }
        float2 o;
        o.x = __uint_as_float(hb << 16) + k1[0]; o.y = __uint_as_float(hb & 0xFFFF0000u) + k1[1];
        *(float2*)(p.out + (size_t)t * DM + col) = o;
        const float ss = wave_sum(o.x * o.x + o.y * o.y);
        if (lane == 0) WS(float, OFF_SSQ2)[(size_t)c * T + t] = ss;
    }
}

template <int PHASE> __device__ __forceinline__ void ph_peer_sliced(const P& p, char* shm, int rep) {
    int* s_tile = (int*)shm;
    float* sact = (float*)(shm + 64) + (threadIdx.x >> 6) * 128;
    const int tid = threadIdx.x, lane = tid & 63, wid = tid >> 6;
    unsigned* qc = WS(unsigned, OFF_QCNT) + (PHASE == 2 ? 8 : 0) + 16 * rep;
    const unsigned x0 = xcc_id();
    for (int dc = 0; dc < 8; ++dc) {
        const int c = (int)((x0 + dc) & 7u);
        __syncthreads();
        if (tid == 0) *s_tile = (int)atomicAdd(&qc[c], 1u);
        __syncthreads();
        int tile = *s_tile;
        while (tile < T / PEER_TILE) {
            __syncthreads();
            int nxt = 0;
            if (tid == 0) nxt = (int)atomicAdd(&qc[c], 1u);
            const int t0 = tile * PEER_TILE + wid * PEER_WTOK;
            if (PHASE == 1) d_peer_e1_run(p, t0, c, lane); else d_peer_e2_run(p, t0, c, lane, sact);
            if (tid == 0) *s_tile = nxt;
            __syncthreads();
            tile = *s_tile;
        }
    }
}

__device__ __forceinline__ void d_peer_e3(const P& p, int t) {
    const int tid = threadIdx.x;
    float s = 0.f;
#pragma unroll
    for (int c = 0; c < 8; ++c) s += WS(float, OFF_SSQ2)[(size_t)c * T + t];
    const float rs = rsqrtf(s * (1.f / DM) + EPS);
    float4* op = (float4*)(p.out + (size_t)t * DM) + tid;
    const float4 g = ((const float4*)p.g_fin)[tid];
    float4 v = *op;
    v.x *= rs * g.x; v.y *= rs * g.y; v.z *= rs * g.z; v.w *= rs * g.w;
    *op = v;
}

#define XB_TMO      128
#define XB_XCNT(j)  (256  + 64 * (j))
#define XB_XSUB(j)  (1280 + 64 * (j))
#define XB_XGEN(j)  (2304 + 64 * (j))
#define XB_TOP      3328
#define XB_TOPGEN   3392
#define XCD_BAR_WORDS 3456
#define XB_SPIN_CAP (1u << 22)
#define LAS __attribute__((address_space(3)))
__device__ __forceinline__ unsigned xb_ld(unsigned* p) { return __hip_atomic_load(p, __ATOMIC_RELAXED, __HIP_MEMORY_SCOPE_AGENT); }
__device__ __forceinline__ unsigned xb_add(unsigned* p, unsigned v) { return __hip_atomic_fetch_add(p, v, __ATOMIC_RELAXED, __HIP_MEMORY_SCOPE_AGENT); }
__device__ __forceinline__ unsigned xb_xcc_id() { return (unsigned)__builtin_amdgcn_s_getreg((3 << 11) | 20) & 0xFu; }
#define XB_SPIN(cond, bar) do { unsigned _sp = 0; while (cond) { __builtin_amdgcn_s_sleep(1); \
    if ((++_sp & 255u) == 0u) { if (xb_ld(&(bar)[XB_TMO])) break; if (_sp > XB_SPIN_CAP) { atomicAdd(&(bar)[XB_TMO], 1u); break; } } } } while (0)
struct XcdBarrier { unsigned* bar; unsigned x; volatile LAS unsigned* st; };
__device__ __forceinline__ XcdBarrier xcd_barrier_post(unsigned* bar, volatile LAS unsigned* st) {
    XcdBarrier b; b.bar = bar; b.x = xb_xcc_id(); b.st = st;
    if (threadIdx.x == 0) (void)xb_add(&bar[XB_XCNT(b.x)], 1u);
    return b;
}
__device__ __forceinline__ void xcd_barrier_complete(unsigned* bar, unsigned x, unsigned& nloc, unsigned& nx) {
    const unsigned G = gridDim.x * gridDim.y * gridDim.z;
    unsigned sum, cnt, mine, sp = 0u;
    for (;;) {
        sum = 0u; cnt = 0u; mine = 0u;
#pragma unroll
        for (unsigned j = 0; j < 16; ++j) { const unsigned c = xb_ld(&bar[XB_XCNT(j)]); sum += c; cnt += (c > 0u) ? 1u : 0u; mine = (j == x) ? c : mine; }
        if (sum == G) break;
        __builtin_amdgcn_s_sleep(1);
        if ((++sp & 255u) == 0u) { if (xb_ld(&bar[XB_TMO])) break; if (sp > XB_SPIN_CAP) { atomicAdd(&bar[XB_TMO], 1u); break; } }
    }
    nloc = mine > 0u ? mine : 1u; nx = cnt > 0u ? cnt : 1u;
}
__device__ __forceinline__ void xcd_barrier(const XcdBarrier& b) {
    asm volatile("s_waitcnt vmcnt(0)" ::: "memory");
    __syncthreads();
    if (threadIdx.x == 0) {
        unsigned* bar = b.bar;
        __builtin_amdgcn_s_waitcnt(0);
        unsigned nloc = b.st[0], nx = b.st[1];
        if (nloc == 0u) { xcd_barrier_complete(bar, b.x, nloc, nx); b.st[0] = nloc; b.st[1] = nx; }
        const unsigned old = xb_add(&bar[XB_XSUB(b.x)], 1u);
        const unsigned gen = old / nloc;
        if (old + 1u == (gen + 1u) * nloc) {
            __builtin_amdgcn_fence(__ATOMIC_RELEASE, "agent");
            asm volatile("s_waitcnt vmcnt(0)" ::: "memory");
            const unsigned og = xb_add(&bar[XB_TOP], 1u);
            const unsigned tg = og / nx;
            if (og + 1u == (tg + 1u) * nx) xb_add(&bar[XB_TOPGEN], 1u);
            else XB_SPIN(xb_ld(&bar[XB_TOPGEN]) == tg, bar);
            __builtin_amdgcn_fence(__ATOMIC_ACQUIRE, "agent");
            xb_add(&bar[XB_XGEN(b.x)], 1u);
            asm volatile("s_waitcnt vmcnt(0)" ::: "memory");
        } else {
            XB_SPIN(xb_ld(&bar[XB_XGEN(b.x)]) == gen, bar);
            __builtin_amdgcn_fence(__ATOMIC_ACQUIRE, "agent");
            asm volatile("s_waitcnt vmcnt(0)" ::: "memory");
        }
    }
    __syncthreads();
}

#define REP_P0 1
#define REP_P1 1
#define REP_P2 1
#define REP_P2C 1
#define REP_P3 1
#define REP_P4G 1
#define REP_P4C 1
#define REP_P5 1
#define REP_P6 1
#define REP_P9 1
#define REP_E1 1
#define REP_E2 1
#define REPEAT(N) for (int rep_ = 0; rep_ < (N); ++rep_)
constexpr int SHM_BYTES = 65536;
__global__ void __launch_bounds__(256, 2) mega(P p) {
    __shared__ __attribute__((aligned(16))) char shm[SHM_BYTES + 16];
    const int G = gridDim.x, bid = blockIdx.x;
    volatile LAS unsigned* xst = (volatile LAS unsigned*)(shm + SHM_BYTES);
    if (threadIdx.x == 0) { xst[0] = 0u; xst[1] = 0u; }
    __syncthreads();
    const XcdBarrier xb = xcd_barrier_post(WS(unsigned, OFF_BAR), xst);

    {
        constexpr int U_WIN = (NIN / 32) * 32, U_WUA = 32 * 16, U_WUR = 32 * 16, U_WOUT = 32 * 32, U_WQ = 32 * 32, U_KEYS = 32, U_MISC = (LP * 8 + 255) / 256;
        constexpr int E0 = U_WIN, E1 = E0 + U_WUA, E2 = E1 + U_WUR, E3 = E2 + U_WOUT, E4 = E3 + U_WQ, E5 = E4 + U_KEYS, E6 = E5 + U_MISC, E7 = E6 + R;
        if (bid == 0 && threadIdx.x < 64) WS(unsigned, OFF_QCNT)[threadIdx.x] = 0u;
        REPEAT(REP_P0)
        for (int u = bid; u < E7; u += G) {
            if (u < E0) d_transpose(p.w_in, WS(bf16_t, OFF_WIN), 1024, NIN, nullptr, u, shm);
            else if (u < E1) d_transpose(p.w_ua, WS(bf16_t, OFF_WUA), 512, 1024, nullptr, u - E0, shm);
            else if (u < E2) d_transpose(p.w_ur, WS(bf16_t, OFF_WUR), 512, 1024, nullptr, u - E1, shm);
            else if (u < E3) d_transpose(p.w_out, WS(bf16_t, OFF_WOUT), 1024, 1024, nullptr, u - E2, shm);
            else if (u < E4) d_transpose(p.w_q, WS(bf16_t, OFF_WQ), 1024, 1024, p.g_ffn, u - E3, shm);
            else if (u < E5) d_cvt(p.keys, WS(bf16_t, OFF_KEYS), (size_t)16 * 128 * 64 / 4, u - E4, U_KEYS);
            else if (u < E6) d_misc(p, u - E5);
            else d_rmsnorm_in(p, u - E6, shm);
        }
    }
    xcd_barrier(xb);
    REPEAT(REP_P1) ph_gemm_inproj(p, shm);
    xcd_barrier(xb);
    REPEAT(REP_P2)
    for (int u = bid; u < 2048; u += G) { if (u < 1024) d_hgrn_A(p, u, shm); else d_attn(p, u - 1024, shm); }
    xcd_barrier(xb);
    for (int u = bid; u < 512; u += G) d_hgrn_scan(p, u);
    xcd_barrier(xb);
    REPEAT(REP_P2C)
    for (int u = bid; u < 1024; u += G) d_hgrn_C(p, u, shm);
    xcd_barrier(xb);
    REPEAT(REP_P3) ph_gemm_merge(p, shm);
    xcd_barrier(xb);
    REPEAT(REP_P4G) ph_gemm_out(p, shm);
    REPEAT(REP_P4C) {
    d_cvt8(p.edown, WS(unsigned char, OFF_EDN), (size_t)16384 * 1024 / 16, 64.f, bid, G);
    d_cvt8(p.eup, WS(unsigned char, OFF_EUP), (size_t)16384 * 1024 / 16, 8.f, bid, G); }
    xcd_barrier(xb);
    REPEAT(REP_P5) ph_peer_qry_topk(p, shm);
    xcd_barrier(xb);
    REPEAT(REP_E1) ph_peer_sliced<1>(p, shm, rep_);
    xcd_barrier(xb);
    REPEAT(REP_E2) ph_peer_sliced<2>(p, shm, rep_);
    xcd_barrier(xb);
    REPEAT(REP_P9)
    for (int t = bid; t < T; t += G) d_peer_e3(p, t);
}

extern "C" void kernel_launch(void* const* d_in, const int* in_sizes, int n_in, void* d_out, int out_size, void* d_ws, size_t ws_size, hipStream_t stream) {
    P p{};
    p.x = (const float*)d_in[0]; p.meta = (const float*)d_in[1]; p.g_mix = (const float*)d_in[2]; p.w_in = (const float*)d_in[3];
    p.b_in = (const float*)d_in[4]; p.sinks = (const float*)d_in[5]; p.lb_logits = (const float*)d_in[6]; p.g_rec = (const float*)d_in[7];
    p.w_ua = (const float*)d_in[8]; p.w_ur = (const float*)d_in[9]; p.w_out = (const float*)d_in[10]; p.g_ffn = (const float*)d_in[11];
    p.w_q = (const float*)d_in[12]; p.keys = (const float*)d_in[13]; p.edown = (const float*)d_in[14]; p.eup = (const float*)d_in[15];
    p.g_fin = (const float*)d_in[16];
    p.out = (float*)d_out; p.ws = (char*)d_ws;
    static int grid_blocks = 0;
    if (!grid_blocks) {
        int dev = 0, cus = 0, per_cu = 0;
        (void)hipGetDevice(&dev);
        (void)hipDeviceGetAttribute(&cus, hipDeviceAttributeMultiprocessorCount, dev);
        (void)hipOccupancyMaxActiveBlocksPerMultiprocessor(&per_cu, mega, 256, 0);
        if (per_cu > 2) per_cu = 2;
        if (per_cu < 1) per_cu = 1;
        grid_blocks = cus * per_cu;
    }
    (void)hipMemsetAsync((char*)d_ws + OFF_BAR, 0, XCD_BAR_WORDS * 4, stream);
    void* args[] = {&p};
    hipError_t e = hipLaunchCooperativeKernel((void*)mega, dim3(grid_blocks), dim3(256), args, 0, stream);
    if (e != hipSuccess) fprintf(stderr, "cooperative launch failed: %s (grid %d)\n", hipGetErrorString(e), grid_blocks);
}
```

```cpp
#include <hip/hip_runtime.h>
#include <hip/hip_cooperative_groups.h>
#include <stdint.h>
#include <stdio.h>
namespace cg = cooperative_groups;

typedef unsigned short bf16_t;
typedef short bf16x8 __attribute__((ext_vector_type(8)));
typedef float f32x4 __attribute__((ext_vector_type(4)));

constexpr int NB = 4, SEQ = 4096, DM = 1024, LP = 4224, PADF = 112;
constexpr int R = NB * LP;
constexpr int T = NB * SEQ;
constexpr int NIN = 4864;
constexpr float EPS = 1e-6f;

constexpr size_t MiB = 1024 * 1024;
constexpr size_t OFF_WUA = 0;
constexpr size_t OFF_WUR = 1 * MiB;
constexpr size_t OFF_WOUT = 2 * MiB;
constexpr size_t OFF_WQ = 4 * MiB;
constexpr size_t OFF_KEYS = 6 * MiB;
constexpr size_t OFF_ROPE = 6 * MiB + 256 * 1024;
constexpr size_t OFF_LB = OFF_ROPE + 272 * 1024;
constexpr size_t OFF_SSQ = 7 * MiB;
constexpr size_t OFF_B = 8 * MiB;
constexpr size_t OFF_QB = OFF_B;
constexpr size_t OFF_KB = OFF_QB + (size_t)R * 512 * 2;
constexpr size_t OFF_VB = OFF_KB + (size_t)R * 128 * 2;
constexpr size_t OFF_RQ = OFF_VB + (size_t)R * 128 * 2;
constexpr size_t OFF_LOGF = OFF_RQ + (size_t)R * 512 * 2;
constexpr size_t OFF_RI = OFF_LOGF + (size_t)R * 512 * 4;
constexpr size_t OFF_RG = OFF_RI + (size_t)R * 512 * 2;
constexpr size_t OFF_GA = OFF_RG + (size_t)R * 512 * 2;
constexpr size_t OFF_GR = OFF_GA + (size_t)R * 1024 * 2;
constexpr size_t OFF_C = OFF_GR + (size_t)R * 1024 * 2;
constexpr size_t OFF_XN = OFF_C;
constexpr size_t OFF_WIN = OFF_XN + (size_t)R * 1024 * 2;
constexpr size_t OFF_TAIL = OFF_WIN + (size_t)NIN * 1024 * 2;
constexpr size_t OFF_DS = OFF_TAIL;
constexpr size_t OFF_ATT = OFF_GA;
constexpr size_t OFF_REC = OFF_ATT + (size_t)T * 512 * 2;
constexpr size_t OFF_MRG = OFF_LOGF;
constexpr size_t OFF_H2B = OFF_RI;
constexpr size_t OFF_EDN = OFF_C;
constexpr size_t OFF_EUP = OFF_EDN + (size_t)16384 * 1024;
constexpr size_t OFF_QRY = OFF_QB;
constexpr size_t OFF_PIDX = OFF_MRG;
constexpr size_t OFF_PGATE = OFF_PIDX + (size_t)T * 128 * 4;
constexpr size_t OFF_RSTD = OFF_LB + 4096;
constexpr size_t OFF_BAR = 6 * MiB + 640 * 1024;
constexpr size_t OFF_QCNT = OFF_LB + 2048;
constexpr size_t OFF_PART = OFF_GA;
constexpr size_t OFF_SSQ2 = OFF_QB;
static_assert(OFF_SSQ2 + (size_t)8 * T * 4 <= OFF_LOGF, "ssq2 overlay");
static_assert(OFF_PART + 8 * (size_t)T * 128 * 4 <= OFF_C, "part overlay");
static_assert(OFF_QCNT + 256 <= OFF_RSTD && OFF_RSTD + (size_t)T * 4 <= OFF_BAR && OFF_BAR + 3456 * 4 <= OFF_SSQ, "qcnt/rstd/bar");
static_assert(OFF_EUP + (size_t)16384 * 1024 * 2 <= 256 * MiB, "ws overflow");
static_assert(OFF_DS + (size_t)16 * 64 * 16384 * 2 <= 256 * MiB, "ws overflow");
static_assert(OFF_REC + (size_t)T * 512 * 2 <= OFF_C, "overlay");
static_assert(OFF_QRY + (size_t)T * 1024 * 2 <= OFF_LOGF, "qry overlay");
static_assert(OFF_PGATE + (size_t)T * 128 * 4 <= OFF_RI, "pidx overlay");

struct P {
    const float *x, *meta, *g_mix, *w_in, *b_in, *sinks, *lb_logits, *g_rec, *w_ua, *w_ur, *w_out, *g_ffn, *w_q, *keys, *edown, *eup, *g_fin;
    float* out;
    char* ws;
};
#define WS(type, off) ((type*)(p.ws + (off)))

__device__ __forceinline__ int ltid() { int t = threadIdx.x; asm volatile("" : "+v"(t)); return t; }
__device__ __forceinline__ bf16_t f2bf(float f) {
    uint32_t u = __float_as_uint(f);
    u += 0x7FFFu + ((u >> 16) & 1u);
    return (bf16_t)(u >> 16);
}
__device__ __forceinline__ float bf2f(bf16_t h) { return __uint_as_float(((uint32_t)h) << 16); }
__device__ __forceinline__ uint32_t pack2(float lo, float hi) { return (uint32_t)f2bf(lo) | ((uint32_t)f2bf(hi) << 16); }
__device__ __forceinline__ float sigmoidf_(float v) { return 1.f / (1.f + __expf(-v)); }

__device__ __forceinline__ float wave_sum(float v) {
#pragma unroll
    for (int o = 32; o > 0; o >>= 1) v += __shfl_xor(v, o);
    return v;
}

typedef __bf16 bf16v2 __attribute__((ext_vector_type(2)));
__device__ __forceinline__ float dot2bf(uint32_t a, uint32_t b, float c) {
    union { uint32_t u; bf16v2 v; } x, y; x.u = a; y.u = b;
    return __builtin_amdgcn_fdot2_f32_bf16(x.v, y.v, c, false);
}
__device__ __forceinline__ float row_sum16(float v) {
    v += __builtin_amdgcn_update_dpp(0.f, v, 0xB1, 0xF, 0xF, false);
    v += __builtin_amdgcn_update_dpp(0.f, v, 0x4E, 0xF, 0xF, false);
    v += __builtin_amdgcn_update_dpp(0.f, v, 0x141, 0xF, 0xF, false);
    v += __builtin_amdgcn_update_dpp(0.f, v, 0x140, 0xF, 0xF, false);
    return v;
}
__device__ __forceinline__ void d_transpose(const float* __restrict__ W, bf16_t* __restrict__ Wt, int K, int N, const float* __restrict__ rs, int unit, char* shm) {
    float (*tile)[33] = (float (*)[33])shm;
    const int ntn = N / 32;
    const int k0 = (unit / ntn) * 32, n0 = (unit % ntn) * 32, tx = ltid() & 31, ty = ltid() >> 5;
#pragma unroll
    for (int i = 0; i < 4; ++i) {
        const int k = k0 + ty + i * 8;
        tile[ty + i * 8][tx] = W[(size_t)k * N + n0 + tx] * (rs ? rs[k] : 1.f);
    }
    __syncthreads();
#pragma unroll
    for (int i = 0; i < 4; ++i) {
        const int n = n0 + ty + i * 8;
        Wt[(size_t)n * K + k0 + tx] = f2bf(tile[tx][ty + i * 8]);
    }
    __syncthreads();
}

__device__ __forceinline__ void d_cvt(const float* __restrict__ src, bf16_t* __restrict__ dst, size_t n4, int vblk, int nvblk) {
    for (size_t i = (size_t)vblk * 256 + ltid(); i < n4; i += (size_t)nvblk * 256) {
        const float4 v = ((const float4*)src)[i];
        ushort4 o; o.x = f2bf(v.x); o.y = f2bf(v.y); o.z = f2bf(v.z); o.w = f2bf(v.w);
        ((ushort4*)dst)[i] = o;
    }
}

__device__ __forceinline__ void d_cvt8(const float* __restrict__ src, unsigned char* __restrict__ dst, size_t n16, float scale, int vblk, int nvblk) {
    for (size_t i = (size_t)vblk * 256 + ltid(); i < n16; i += (size_t)nvblk * 256) {
        const float4* s = (const float4*)src + i * 4;
        uint32_t w[4];
#pragma unroll
        for (int q = 0; q < 4; ++q) {
            const float4 v = s[q];
            int pk = 0;
            pk = __builtin_amdgcn_cvt_pk_fp8_f32(v.x * scale, v.y * scale, pk, false);
            pk = __builtin_amdgcn_cvt_pk_fp8_f32(v.z * scale, v.w * scale, pk, true);
            w[q] = (uint32_t)pk;
        }
        ((uint4*)dst)[i] = make_uint4(w[0], w[1], w[2], w[3]);
    }
}

__device__ __forceinline__ void d_misc(const P& p, int unit) {
    const int gid = unit * 256 + ltid();
    if (gid < LP * 8) {
        const int pp = gid >> 3, i = gid & 7;
        const double inv = pow(500000.0, -(double)i / 8.0);
        const double ang = (double)(pp - PADF) * inv;
        float2 cs; cs.x = (float)cos(ang); cs.y = (float)sin(ang);
        WS(float2, OFF_ROPE)[gid] = cs;
    }
    if (gid < 512) {
        const float l0 = p.lb_logits[gid], l1 = p.lb_logits[512 + gid];
        WS(float, OFF_LB)[gid] = 1.f / (1.f + expf(l1 - l0));
    }
}

__device__ __forceinline__ void d_rmsnorm_in(const P& p, int unit) {
    const int lane = ltid() & 63, r = unit * 4 + (ltid() >> 6), b = r / LP, pp = r % LP;
    bf16_t* dst = WS(bf16_t, OFF_XN) + (size_t)r * DM;
    if (pp < PADF) {
#pragma unroll
        for (int i = 0; i < 2; ++i) ((uint4*)dst)[lane + 64 * i] = make_uint4(0, 0, 0, 0);
        return;
    }
    const float* src = (pp < 128) ? (p.meta + (size_t)(pp - PADF) * DM) : (p.x + ((size_t)b * SEQ + (pp - 128)) * DM);
    float4 v[4];
#pragma unroll
    for (int i = 0; i < 4; ++i) v[i] = ((const float4*)src)[lane * 2 + (i & 1) + 128 * (i >> 1)];
    float ss = 0.f;
#pragma unroll
    for (int i = 0; i < 4; ++i) ss += (v[i].x * v[i].x + v[i].y * v[i].y) + (v[i].z * v[i].z + v[i].w * v[i].w);
    ss = wave_sum(ss);
    const float rstd = rsqrtf(ss * (1.f / DM) + EPS);
#pragma unroll
    for (int hh = 0; hh < 2; ++hh) {
        const float4 g0 = ((const float4*)p.g_mix)[lane * 2 + 128 * hh], g1 = ((const float4*)p.g_mix)[lane * 2 + 1 + 128 * hh];
        const float4 a = v[2 * hh], c = v[2 * hh + 1];
        ((uint4*)dst)[lane + 64 * hh] = make_uint4(pack2(a.x * rstd * g0.x, a.y * rstd * g0.y), pack2(a.z * rstd * g0.z, a.w * rstd * g0.w),
                                                   pack2(c.x * rstd * g1.x, c.y * rstd * g1.y), pack2(c.z * rstd * g1.z, c.w * rstd * g1.w));
    }
}

__device__ __forceinline__ void glds16(const void* src, void* lds) { __builtin_amdgcn_global_load_lds((const unsigned*)src, (unsigned*)lds, 16, 0, 0); }

__device__ __forceinline__ void gemm_kloop(const bf16_t* __restrict__ A, int lda, const bf16_t* __restrict__ Bt, int ldb, int K, int brow, int bcol,
                                           f32x4 (&acc)[4][4], char* shm) {
    const int tid = ltid(), wid = tid >> 6, lane = tid & 63, wr = wid >> 1, wc = wid & 1, fr = lane & 15, fq = lane >> 4;
    const int sr = tid >> 3, sc = ((tid & 7) ^ ((sr >> 1) & 7)) * 8;
    const bf16_t* ag = A + (size_t)(brow + sr) * lda + sc;
    const bf16_t* bg = Bt + (size_t)(bcol + sr) * ldb + sc;
    const int nt = K >> 6;
#pragma unroll
    for (int i = 0; i < 4; ++i) {
        glds16(ag + (size_t)(32 * i) * lda, shm + tid * 16 + i * 4096);
        glds16(bg + (size_t)(32 * i) * ldb, shm + 16384 + tid * 16 + i * 4096);
    }
    asm volatile("s_waitcnt vmcnt(0)" ::: "memory");
    __syncthreads();
    const int arow = wr * 64 + fr, brw = wc * 64 + fr;
    const int swz = (fr >> 1) & 7;
    for (int kt = 0; kt < nt; ++kt) {
        char* SA = shm + (kt & 1) * 32768;
        char* SB = SA + 16384;
        if (kt + 1 < nt) {
            char* NA = shm + ((kt + 1) & 1) * 32768;
#pragma unroll
            for (int i = 0; i < 4; ++i) {
                glds16(ag + (size_t)(32 * i) * lda + (kt + 1) * 64, NA + tid * 16 + i * 4096);
                glds16(bg + (size_t)(32 * i) * ldb + (kt + 1) * 64, NA + 16384 + tid * 16 + i * 4096);
            }
        }
#pragma unroll
        for (int ks = 0; ks < 2; ++ks) {
            bf16x8 a[4], b[4];
            const int coff = (((ks * 4 + fq) ^ swz) << 4);
#pragma unroll
            for (int m = 0; m < 4; ++m) a[m] = *(const bf16x8*)(SA + (arow + m * 16) * 128 + coff);
#pragma unroll
            for (int n = 0; n < 4; ++n) b[n] = *(const bf16x8*)(SB + (brw + n * 16) * 128 + coff);
            __builtin_amdgcn_s_setprio(1);
#pragma unroll
            for (int m = 0; m < 4; ++m)
#pragma unroll
                for (int n = 0; n < 4; ++n) acc[m][n] = __builtin_amdgcn_mfma_f32_16x16x32_bf16(a[m], b[n], acc[m][n], 0, 0, 0);
            __builtin_amdgcn_s_setprio(0);
        }
        asm volatile("s_waitcnt vmcnt(0)" ::: "memory");
        __syncthreads();
    }
}

__device__ __forceinline__ void zero_acc(f32x4 (&acc)[4][4]) {
#pragma unroll
    for (int m = 0; m < 4; ++m)
#pragma unroll
        for (int n = 0; n < 4; ++n) acc[m][n] = (f32x4){0.f, 0.f, 0.f, 0.f};
}

constexpr int EPI_LD = 136;
__device__ __forceinline__ void tile_store_bf16(const char* shm, bf16_t* dst, int ld) {
    __syncthreads();
    const int t_ = ltid();
#pragma unroll
    for (int i = 0; i < 8; ++i) {
        const int q = t_ + 256 * i, r = q >> 4, c = q & 15;
        *(uint4*)(dst + (size_t)r * ld + c * 8) = *(const uint4*)(shm + (r * EPI_LD + c * 8) * 2);
    }
    __syncthreads();
}

__device__ __forceinline__ void tile_load_bf16(char* shm, const bf16_t* srcp, int ld) {
    const int t_ = ltid();
#pragma unroll
    for (int i = 0; i < 8; ++i) {
        const int q = t_ + 256 * i, r = q >> 4, c = q & 15;
        *(uint4*)(shm + (r * EPI_LD + c * 8) * 2) = *(const uint4*)(srcp + (size_t)r * ld + c * 8);
    }
}

__device__ __forceinline__ void ph_gemm_inproj(const P& p, char* shm) {
    const int tid = ltid(), wid = tid >> 6, lane = tid & 63, wr = wid >> 1, wc = wid & 1, fr = lane & 15, fq = lane >> 4;
    constexpr int NT_N = 2816 / 128, NT_M = R / 128;
    const float2* rope = WS(float2, OFF_ROPE);
    const float* lbv = WS(float, OFF_LB);
    for (int tile = blockIdx.x; tile < NT_N * NT_M; tile += gridDim.x) {
        const int pm = tile / NT_N, pn = tile % NT_N, brow_ = pm * 128, bcol_ = pn * 128;
        f32x4 acc[4][4]; zero_acc(acc);
        int brow = brow_, bcol = bcol_;
        gemm_kloop(WS(bf16_t, OFF_XN), DM, WS(bf16_t, OFF_WIN), DM, DM, brow, bcol, acc, shm);
        asm volatile("" : "+s"(brow), "+s"(bcol));
        if (bcol >= 1280 && bcol < 1792) {
#pragma unroll
            for (int n = 0; n < 4; ++n) {
                const int col = bcol + wc * 64 + n * 16 + fr;
                const float bv = p.b_in[col], lb = lbv[col - 1280];
                float run = 0.f;
#pragma unroll
                for (int m = 0; m < 4; ++m) {
                    float c[4];
#pragma unroll
                    for (int j = 0; j < 4; ++j) {
                        const int row = brow + wr * 64 + m * 16 + fq * 4 + j;
                        const float v = acc[m][n][j] + bv;
                        const float f = lb + (1.f - lb) * sigmoidf_(v);
                        const float lf = ((row % LP) < PADF) ? 0.f : __logf(f);
                        c[j] = lf + (j ? c[j - 1] : 0.f);
                    }
                    const float x = c[3];
                    const float y = __shfl_up(x, 16);
                    float incl = x + (fq >= 1 ? y : 0.f);
                    const float z = __shfl_up(incl, 32);
                    incl += (fq >= 2 ? z : 0.f);
                    const float excl = incl - x;
                    const float tot = __shfl(incl, fr + 48);
#pragma unroll
                    for (int j = 0; j < 4; ++j) {
                        const int row = brow + wr * 64 + m * 16 + fq * 4 + j;
                        WS(float, OFF_LOGF)[(size_t)row * 512 + (col - 1280)] = run + excl + c[j];
                    }
                    run += tot;
                }
            }
        } else {
            bf16_t* st = (bf16_t*)shm;
            const int kind = (bcol < 512) ? 0 : (bcol < 640) ? 1 : (bcol < 2304) ? 2 : 3;
#pragma unroll
            for (int m = 0; m < 4; ++m)
#pragma unroll
                for (int n = 0; n < 4; ++n) {
                    const int cl = wc * 64 + n * 16 + fr;
                    const float bv = p.b_in[bcol + cl];
#pragma unroll
                    for (int j = 0; j < 4; ++j) {
                        const int rl = wr * 64 + m * 16 + fq * 4 + j;
                        float v = acc[m][n][j] + bv;
                        if (kind <= 1) {
                            if (n == 0) {
                                const float other = __shfl_xor(v, 8);
                                const float2 cs = rope[((brow + rl) % LP) * 8 + (fr & 7)];
                                v = (fr < 8) ? (v * cs.x - other * cs.y) : (v * cs.x + other * cs.y);
                            }
                            if (kind == 0) v *= 0.125f;
                        } else if (kind == 3) v = v * sigmoidf_(v);
                        st[rl * EPI_LD + cl] = f2bf(v);
                    }
                }
            bf16_t* dst; int ld;
            if (bcol < 512) { dst = WS(bf16_t, OFF_QB) + bcol; ld = 512; }
            else if (bcol < 640) { dst = WS(bf16_t, OFF_KB); ld = 128; }
            else if (bcol < 768) { dst = WS(bf16_t, OFF_VB); ld = 128; }
            else if (bcol < 1280) { dst = WS(bf16_t, OFF_RQ) + (bcol - 768); ld = 512; }
            else if (bcol < 2304) { dst = WS(bf16_t, OFF_RI) + (bcol - 1792); ld = 512; }
            else { dst = WS(bf16_t, OFF_RG) + (bcol - 2304); ld = 512; }
            tile_store_bf16(shm, dst + (size_t)brow * ld, ld);
        }
    }
}

__device__ __forceinline__ void ph_gemm_merge(const P& p, char* shm) {
    const int tid = ltid(), wid = tid >> 6, lane = tid & 63, wr = wid >> 1, wc = wid & 1, fr = lane & 15, fq = lane >> 4;
    constexpr int NT_N = 8, NT_M = T / 128;
    bf16_t* st = (bf16_t*)shm;
    for (int tile = blockIdx.x; tile < NT_N * NT_M; tile += gridDim.x) {
        const int pm = tile / NT_N, pn = tile % NT_N, brow = pm * 128, bcol = pn * 128;
        const int prow = brow + 128 * (brow / SEQ + 1);
        f32x4 acc[4][4];
        uint32_t sg[4][4];
#pragma unroll 1
        for (int pass = 0; pass < 2; ++pass) {
            zero_acc(acc);
            gemm_kloop(WS(bf16_t, OFF_XN), DM, WS(bf16_t, OFF_WIN), DM, DM, prow, 2816 + 1024 * pass + bcol, acc, shm);
            int ecol = bcol;
            asm volatile("" : "+s"(ecol));
#pragma unroll
            for (int m = 0; m < 4; ++m)
#pragma unroll
                for (int n = 0; n < 4; ++n) {
                    const float bv = p.b_in[2816 + 1024 * pass + ecol + wc * 64 + n * 16 + fr];
                    uint32_t g8 = 0;
#pragma unroll
                    for (int j = 0; j < 4; ++j) g8 |= (uint32_t)__builtin_rintf(sigmoidf_(acc[m][n][j] + bv) * 255.f) << (8 * j);
                    sg[m][n] = g8;
                }
            zero_acc(acc);
            gemm_kloop(WS(bf16_t, pass ? OFF_REC : OFF_ATT), 512, WS(bf16_t, pass ? OFF_WUR : OFF_WUA), 512, 512, brow, bcol, acc, shm);
            int erow = brow;
            asm volatile("" : "+s"(erow), "+s"(ecol));
            bf16_t* mrg = WS(bf16_t, OFF_MRG) + (size_t)erow * 1024 + ecol;
            if (pass == 1) { tile_load_bf16(shm, mrg, 1024); __syncthreads(); }
#pragma unroll
            for (int m = 0; m < 4; ++m)
#pragma unroll
                for (int n = 0; n < 4; ++n) {
                    float v[4];
#pragma unroll
                    for (int j = 0; j < 4; ++j) v[j] = acc[m][n][j] * ((float)((sg[m][n] >> (8 * j)) & 0xFFu) * (1.f / 255.f));
                    const int cl = wc * 64 + n * 16 + fr, rl = wr * 64 + m * 16 + fq * 4;
#pragma unroll
                    for (int j = 0; j < 4; ++j) {
                        bf16_t* e = st + (rl + j) * EPI_LD + cl;
                        *e = f2bf(pass ? (v[j] + bf2f(*e)) : v[j]);
                    }
                }
            tile_store_bf16(shm, mrg, 1024);
        }
    }
}

__device__ __forceinline__ void ph_gemm_out(const P& p, char* shm) {
    const int tid = ltid(), wid = tid >> 6, lane = tid & 63, wr = wid >> 1, wc = wid & 1, fr = lane & 15, fq = lane >> 4;
    constexpr int NT_N = 8, NT_M = T / 128;
    bf16_t* st = (bf16_t*)shm;
    for (int q = blockIdx.x >> 3; q < NT_N * NT_M / 8; q += gridDim.x >> 3) {
        const int pm = 8 * (q >> 3) + (blockIdx.x & 7), pn = q & 7, brow_ = pm * 128, bcol_ = pn * 128;
        f32x4 acc[4][4]; zero_acc(acc);
        int brow = brow_, bcol = bcol_;
        gemm_kloop(WS(bf16_t, OFF_MRG), 1024, WS(bf16_t, OFF_WOUT), 1024, 1024, brow, bcol, acc, shm);
        asm volatile("" : "+s"(brow), "+s"(bcol));
#pragma unroll
        for (int m = 0; m < 4; ++m)
#pragma unroll
            for (int n = 0; n < 4; ++n)
#pragma unroll
                for (int j = 0; j < 4; ++j) st[(wr * 64 + m * 16 + fq * 4 + j) * EPI_LD + wc * 64 + n * 16 + fr] = f2bf(acc[m][n][j]);
        __syncthreads();
#pragma unroll 2
        for (int i = 0; i < 8; ++i) {
            const int q = tid + 256 * i, r = q >> 4, c = q & 15;
            const uint4 a = *(const uint4*)(shm + (r * EPI_LD + c * 8) * 2);
            const float* xp = p.x + (size_t)(brow + r) * DM + bcol + c * 8;
            const float4 x0 = *(const float4*)xp, x1 = *(const float4*)(xp + 4);
            const float h0 = x0.x + __uint_as_float(a.x << 16), h1 = x0.y + __uint_as_float(a.x & 0xFFFF0000u);
            const float h2 = x0.z + __uint_as_float(a.y << 16), h3 = x0.w + __uint_as_float(a.y & 0xFFFF0000u);
            const float h4 = x1.x + __uint_as_float(a.z << 16), h5 = x1.y + __uint_as_float(a.z & 0xFFFF0000u);
            const float h6 = x1.z + __uint_as_float(a.w << 16), h7 = x1.w + __uint_as_float(a.w & 0xFFFF0000u);
            *(uint4*)(WS(bf16_t, OFF_H2B) + (size_t)(brow + r) * DM + bcol + c * 8) = make_uint4(pack2(h0, h1), pack2(h2, h3), pack2(h4, h5), pack2(h6, h7));
            float ss = (h0 * h0 + h1 * h1) + (h2 * h2 + h3 * h3) + (h4 * h4 + h5 * h5) + (h6 * h6 + h7 * h7);
            ss = row_sum16(ss);
            if (c == 0) WS(float, OFF_SSQ)[(size_t)pn * T + brow + r] = ss;
        }
        __syncthreads();
    }
}

__device__ __forceinline__ float row_rstd(const P& p, int row) {
    float s = 0.f;
#pragma unroll
    for (int i = 0; i < 8; ++i) s += WS(float, OFF_SSQ)[(size_t)i * T + row];
    return rsqrtf(s * (1.f / DM) + EPS);
}

__device__ __forceinline__ void ph_gemm_qry(const P& p, char* shm) {
    const int tid = ltid(), wid = tid >> 6, lane = tid & 63, wr = wid >> 1, wc = wid & 1, fr = lane & 15, fq = lane >> 4;
    constexpr int NT_N = 8, NT_M = T / 128;
    for (int tile = blockIdx.x; tile < NT_N * NT_M; tile += gridDim.x) {
        const int pm = tile / NT_N, pn = tile % NT_N, brow_ = pm * 128, bcol_ = pn * 128;
        f32x4 acc[4][4]; zero_acc(acc);
        int brow = brow_, bcol = bcol_;
        gemm_kloop(WS(bf16_t, OFF_H2B), 1024, WS(bf16_t, OFF_WQ), 1024, 1024, brow, bcol, acc, shm);
        asm volatile("" : "+s"(brow), "+s"(bcol));
#pragma unroll
        for (int m = 0; m < 4; ++m)
#pragma unroll
            for (int j = 0; j < 4; ++j) {
                const int row = brow + wr * 64 + m * 16 + fq * 4 + j;
                const float rstd = row_rstd(p, row);
                if (bcol == 0 && wc == 0 && fr == 0) WS(float, OFF_RSTD)[row] = rstd;
#pragma unroll
                for (int n = 0; n < 4; ++n) {
                    const int col = bcol + wc * 64 + n * 16 + fr;
                    WS(bf16_t, OFF_QRY)[(size_t)row * DM + col] = f2bf(acc[m][n][j] * rstd);
                }
            }
    }
}

#if ATTN_SIMPLE
__device__ __forceinline__ void d_attn_simple(const P& p, int unit) {
    const int gid = unit * 256 + ltid();
    const int hq = gid / T, t = gid % T, b = t / SEQ, s = t % SEQ, pq = 128 + s, kvh = hq >> 2;
    const bf16_t* qp = WS(bf16_t, OFF_QB) + ((size_t)b * LP + pq) * 512 + hq * 64;
    float q[64], o[64];
#pragma unroll
    for (int d = 0; d < 64; ++d) { q[d] = bf2f(qp[d]); o[d] = 0.f; }
    float m = p.sinks[hq], l = 1.f;
    const bf16_t* kbase = WS(bf16_t, OFF_KB) + (size_t)b * LP * 128 + kvh * 64;
    const bf16_t* vbase = WS(bf16_t, OFF_VB) + (size_t)b * LP * 128 + kvh * 64;
    const int lo = (pq - 127 > 128) ? (pq - 127) : 128;
    const int nkeys = 16 + (pq - lo + 1);
    for (int i = 0; i < nkeys; ++i) {
        const int pk = (i < 16) ? (PADF + i) : (lo + i - 16);
        const bf16_t* kp = kbase + (size_t)pk * 128;
        const bf16_t* vp = vbase + (size_t)pk * 128;
        float sc = 0.f;
#pragma unroll
        for (int d = 0; d < 64; ++d) sc += q[d] * bf2f(kp[d]);
        const float mn = fmaxf(m, sc), a = __expf(m - mn), e = __expf(sc - mn);
        l = l * a + e;
#pragma unroll
        for (int d = 0; d < 64; ++d) o[d] = o[d] * a + e * bf2f(vp[d]);
        m = mn;
    }
    const float inv = 1.f / l;
    bf16_t* op = WS(bf16_t, OFF_ATT) + (size_t)t * 512 + hq * 64;
#pragma unroll
    for (int d = 0; d < 64; ++d) op[d] = f2bf(o[d] * inv);
}

#endif
constexpr int LDV = 280;
__device__ __forceinline__ void d_attn(const P& p, int unit, char* shm) {
    bf16_t* VT = (bf16_t*)shm;
    const int tid = ltid(), lane = tid & 63, fr = lane & 15, fq = lane >> 4;
    const int w = __builtin_amdgcn_readfirstlane(tid >> 6);
    const int hq = unit & 7, n = ((unit >> 3) & 31) + 1, b = unit >> 8, kvh = hq >> 2;
    const size_t rb = (size_t)b * LP;
    const int kb0 = 128 * (n - 1);
    const bf16_t* kbp = WS(bf16_t, OFF_KB) + kvh * 64;
    const bf16_t* vbp = WS(bf16_t, OFF_VB) + kvh * 64;
#pragma unroll 1
    for (int i = 0; i < 9; ++i) {
        const int c = tid + 256 * i;
        if (c < 2176) {
            const int x = c >> 3, dc = c & 7;
            const int pos = (x < 256) ? (kb0 + x) : (PADF + x - 256);
            const uint4 v = *(const uint4*)(vbp + (rb + pos) * 128 + 8 * dc);
            bf16_t* dst = VT + (8 * dc) * LDV + x;
            dst[0 * LDV] = (bf16_t)(v.x & 0xFFFF); dst[1 * LDV] = (bf16_t)(v.x >> 16);
            dst[2 * LDV] = (bf16_t)(v.y & 0xFFFF); dst[3 * LDV] = (bf16_t)(v.y >> 16);
            dst[4 * LDV] = (bf16_t)(v.z & 0xFFFF); dst[5 * LDV] = (bf16_t)(v.z >> 16);
            dst[6 * LDV] = (bf16_t)(v.w & 0xFFFF); dst[7 * LDV] = (bf16_t)(v.w >> 16);
        }
    }
    __syncthreads();
    bf16x8 qf[2][2];
#pragma unroll
    for (int u = 0; u < 2; ++u)
#pragma unroll
        for (int ks = 0; ks < 2; ++ks)
            qf[u][ks] = *(const bf16x8*)(WS(bf16_t, OFF_QB) + (rb + 128 * n + 32 * w + 16 * u + fr) * 512 + hq * 64 + 32 * ks + 8 * fq);
    f32x4 s[11][2];
#pragma unroll
    for (int tt = 0; tt < 11; ++tt) {
        const int x0 = (tt < 10) ? (32 * w + 16 * tt) : 256;
        const int pos = ((tt < 10) ? (kb0 + x0) : PADF) + fr;
        const bf16x8 k0 = *(const bf16x8*)(kbp + (rb + pos) * 128 + 8 * fq);
        const bf16x8 k1 = *(const bf16x8*)(kbp + (rb + pos) * 128 + 32 + 8 * fq);
#pragma unroll
        for (int u = 0; u < 2; ++u) {
            f32x4 c = (f32x4){0.f, 0.f, 0.f, 0.f};
            c = __builtin_amdgcn_mfma_f32_16x16x32_bf16(k0, qf[u][0], c, 0, 0, 0);
            c = __builtin_amdgcn_mfma_f32_16x16x32_bf16(k1, qf[u][1], c, 0, 0, 0);
            if (tt < 10) {
                const int xq = 128 + 32 * w + 16 * u + fr;
#pragma unroll
                for (int j = 0; j < 4; ++j) {
                    const int x = x0 + 4 * fq + j, dq = xq - x;
                    const bool ok = (dq >= 0) && (dq < 128) && (kb0 + x >= 128);
                    c[j] = ok ? c[j] : -1.0e30f;
                }
            }
            s[tt][u] = c;
        }
    }
    const float sink = p.sinks[hq];
    float inv[2];
#pragma unroll
    for (int u = 0; u < 2; ++u) {
        float m = sink;
#pragma unroll
        for (int tt = 0; tt < 11; ++tt)
#pragma unroll
            for (int j = 0; j < 4; ++j) m = fmaxf(m, s[tt][u][j]);
        m = fmaxf(m, __shfl_xor(m, 16)); m = fmaxf(m, __shfl_xor(m, 32));
        float l = 0.f;
#pragma unroll
        for (int tt = 0; tt < 11; ++tt)
#pragma unroll
            for (int j = 0; j < 4; ++j) { const float e = __expf(s[tt][u][j] - m); s[tt][u][j] = e; l += e; }
        l += __shfl_xor(l, 16); l += __shfl_xor(l, 32);
        l += __expf(sink - m);
        inv[u] = 1.f / l;
    }
    f32x4 o[4][2];
#pragma unroll
    for (int dt = 0; dt < 4; ++dt)
#pragma unroll
        for (int u = 0; u < 2; ++u) o[dt][u] = (f32x4){0.f, 0.f, 0.f, 0.f};
#pragma unroll
    for (int g = 0; g < 6; ++g) {
        const int xa = (g < 5) ? (32 * w + 32 * g) : 256, xb = (g < 5) ? (xa + 16) : 256;
        bf16x8 pf[2];
#pragma unroll
        for (int u = 0; u < 2; ++u) {
#pragma unroll
            for (int j = 0; j < 4; ++j) {
                pf[u][j] = (short)f2bf(s[2 * g][u][j]);
                pf[u][4 + j] = (g < 5) ? (short)f2bf(s[(g < 5) ? (2 * g + 1) : 0][u][j]) : (short)0;
            }
        }
#pragma unroll
        for (int dt = 0; dt < 4; ++dt) {
            const uint2 a0 = *(const uint2*)(VT + (16 * dt + fr) * LDV + xa + 4 * fq);
            const uint2 a1 = *(const uint2*)(VT + (16 * dt + fr) * LDV + xb + 4 * fq);
            union { uint4 q; bf16x8 v; } av; av.q = make_uint4(a0.x, a0.y, a1.x, a1.y);
#pragma unroll
            for (int u = 0; u < 2; ++u) o[dt][u] = __builtin_amdgcn_mfma_f32_16x16x32_bf16(av.v, pf[u], o[dt][u], 0, 0, 0);
        }
    }
#pragma unroll
    for (int u = 0; u < 2; ++u) {
        const size_t t = (size_t)b * SEQ + 128 * (n - 1) + 32 * w + 16 * u + fr;
#pragma unroll
        for (int dt = 0; dt < 4; ++dt) {
            uint2 ov;
            ov.x = pack2(o[dt][u][0] * inv[u], o[dt][u][1] * inv[u]);
            ov.y = pack2(o[dt][u][2] * inv[u], o[dt][u][3] * inv[u]);
            *(uint2*)(WS(bf16_t, OFF_ATT) + t * 512 + hq * 64 + 16 * dt + 4 * fq) = ov;
        }
    }
    __syncthreads();
}

#if HGRN_SIMPLE
__device__ __forceinline__ void d_hgrn_simple(const P& p, int bh, char* shm) {
    float (*fs)[128] = (float (*)[128])shm;
    float (*ks)[128] = (float (*)[128])(shm + 4096);
    float (*qs)[128] = (float (*)[128])(shm + 8192);
    float (*os)[128] = (float (*)[128])(shm + 12288);
    float (*red)[2] = (float (*)[2])(shm + 16384);
    const int b = bh >> 2, h = bh & 3, e = ltid() & 127;
    const bool act = ltid() < 128;
    float S[128];
#pragma unroll
    for (int d = 0; d < 128; ++d) S[d] = 0.f;
    const float g = p.g_rec[h * 128 + e];
    for (int p0 = PADF; p0 < LP; p0 += 8) {
        float v[8];
        if (act) {
#pragma unroll
            for (int i = 0; i < 8; ++i) {
                const size_t r = (size_t)b * LP + p0 + i;
                const float lf = WS(float, OFF_LOGF)[r * 512 + h * 128 + e] - (((p0 + i) & 63) ? WS(float, OFF_LOGF)[(r - 1) * 512 + h * 128 + e] : 0.f);
                const float f = __expf(lf);
                fs[i][e] = f; ks[i][e] = 1.f - f;
                qs[i][e] = bf2f(WS(bf16_t, OFF_RQ)[r * 512 + h * 128 + e]);
                v[i] = bf2f(WS(bf16_t, OFF_RI)[r * 512 + h * 128 + e]);
            }
        }
        __syncthreads();
        if (act) {
#pragma unroll
            for (int i = 0; i < 8; ++i) {
                float o = 0.f;
#pragma unroll
                for (int d = 0; d < 128; ++d) { S[d] = fs[i][d] * S[d] + ks[i][d] * v[i]; o += qs[i][d] * S[d]; }
                os[i][e] = o;
                const float ss = wave_sum(o * o);
                if ((e & 63) == 0) red[i][e >> 6] = ss;
            }
        }
        __syncthreads();
        if (act && p0 >= 128) {
#pragma unroll
            for (int i = 0; i < 8; ++i) {
                const size_t r = (size_t)b * LP + p0 + i;
                const size_t t = (size_t)b * SEQ + (p0 + i - 128);
                const float rstd = rsqrtf((red[i][0] + red[i][1]) * (1.f / 128.f) + EPS);
                const float val = os[i][e] * rstd * g * bf2f(WS(bf16_t, OFF_RG)[r * 512 + h * 128 + e]);
                WS(bf16_t, OFF_REC)[t * 512 + h * 128 + e] = f2bf(val);
            }
        }
        __syncthreads();
    }
}

#endif

constexpr int LD64 = 72;
constexpr int LD128 = 136;

__device__ __forceinline__ void d_hgrn_A(const P& p, int unit, char* shm) {
    bf16_t* VT = (bf16_t*)shm;
    bf16_t* KT = (bf16_t*)(shm + 128 * LD64 * 2);
    const int tid = ltid(), wid = tid >> 6, lane = tid & 63, fr = lane & 15, fq = lane >> 4;
    const int bh = unit >> 6, n = (unit & 63) + 1, b = bh >> 2, h = bh & 3;
    const int c = tid & 127, half = tid >> 7;
    const size_t r0 = (size_t)b * LP + 64 * n;
    const float* bb = WS(float, OFF_LOGF) + r0 * 512 + h * 128 + c;
    const bf16_t* vv = WS(bf16_t, OFF_RI) + r0 * 512 + h * 128 + c;
    {
        const float blast = bb[63 * 512];
        float prev = half ? bb[31 * 512] : 0.f;
        const float* bp = bb + (size_t)(32 * half) * 512;
        const bf16_t* vp_ = vv + (size_t)(32 * half) * 512;
#pragma unroll 1
        for (int g = 0; g < 4; ++g) {
            float bs[8]; uint32_t vs[8];
#pragma unroll
            for (int i = 0; i < 8; ++i) { bs[i] = bp[i * 512]; vs[i] = vp_[i * 512]; }
            uint32_t kp[4], vp[4];
#pragma unroll
            for (int i = 0; i < 8; i += 2) {
                const float k0 = (1.f - __expf(bs[i] - prev)) * __expf(blast - bs[i]);
                const float k1 = (1.f - __expf(bs[i + 1] - bs[i])) * __expf(blast - bs[i + 1]);
                prev = bs[i + 1];
                kp[i >> 1] = pack2(k0, k1);
                vp[i >> 1] = vs[i] | (vs[i + 1] << 16);
            }
            *(uint4*)(KT + c * LD64 + 32 * half + 8 * g) = make_uint4(kp[0], kp[1], kp[2], kp[3]);
            *(uint4*)(VT + c * LD64 + 32 * half + 8 * g) = make_uint4(vp[0], vp[1], vp[2], vp[3]);
            bp += 8 * 512; vp_ += 8 * 512;
        }
    }
    __syncthreads();
    f32x4 acc[2][8];
#pragma unroll
    for (int mi = 0; mi < 2; ++mi)
#pragma unroll
        for (int n8 = 0; n8 < 8; ++n8) acc[mi][n8] = (f32x4){0.f, 0.f, 0.f, 0.f};
#pragma unroll
    for (int ks = 0; ks < 2; ++ks) {
        bf16x8 a[2];
#pragma unroll
        for (int mi = 0; mi < 2; ++mi) a[mi] = *(const bf16x8*)(VT + (32 * wid + 16 * mi + fr) * LD64 + 32 * ks + 8 * fq);
#pragma unroll
        for (int n8 = 0; n8 < 8; ++n8) {
            const bf16x8 bf = *(const bf16x8*)(KT + (16 * n8 + fr) * LD64 + 32 * ks + 8 * fq);
#pragma unroll
            for (int mi = 0; mi < 2; ++mi) acc[mi][n8] = __builtin_amdgcn_mfma_f32_16x16x32_bf16(a[mi], bf, acc[mi][n8], 0, 0, 0);
        }
    }
    bf16_t* dst = WS(bf16_t, OFF_DS) + (size_t)unit * 16384;
#pragma unroll
    for (int mi = 0; mi < 2; ++mi)
#pragma unroll
        for (int n8 = 0; n8 < 8; ++n8)
#pragma unroll
            for (int j = 0; j < 4; ++j) dst[(32 * wid + 16 * mi + 4 * fq + j) * 128 + 16 * n8 + fr] = f2bf(acc[mi][n8][j]);
    __syncthreads();
}

__device__ __forceinline__ void d_hgrn_scan(const P& p, int unit) {
    const int gid = unit * 256 + ltid();
    const int bh = gid >> 13, rem = gid & 8191, e = rem >> 6, d2 = (rem & 63) * 2;
    uint32_t* base = (uint32_t*)(WS(bf16_t, OFF_DS) + (size_t)bh * 64 * 16384 + e * 128 + d2);
    const float* bb = WS(float, OFF_LOGF) + ((size_t)(bh >> 2) * LP + 64 + 63) * 512 + (bh & 3) * 128 + d2;
    float s0 = 0.f, s1 = 0.f;
#pragma unroll 8
    for (int j = 0; j < 64; ++j) {
        const uint32_t x = base[(size_t)j * 8192];
        const float2 bl = *(const float2*)(bb + (size_t)j * 64 * 512);
        s0 = __expf(bl.x) * s0 + __uint_as_float(x << 16);
        s1 = __expf(bl.y) * s1 + __uint_as_float(x & 0xFFFF0000u);
        base[(size_t)j * 8192] = pack2(s0, s1);
    }
}

__device__ __forceinline__ void d_hgrn_C(const P& p, int unit, char* shm) {
    bf16_t* KS = (bf16_t*)shm;
    bf16_t* KD = KS + 64 * LD128;
    bf16_t* VT = KD + 64 * LD128;
    bf16_t* AM = VT + 128 * LD64;
    const int tid = ltid(), lane = tid & 63, fr = lane & 15, fq = lane >> 4;
    const int wi = __builtin_amdgcn_readfirstlane(tid >> 6);
    const int bh = unit >> 6, n = (unit & 63) + 2, b = bh >> 2, h = bh & 3;
    const size_t r0 = (size_t)b * LP + 64 * n;
    const size_t t0 = (size_t)b * SEQ + 64 * n - 128;
    {
        const int c = tid & 127, half = tid >> 7;
        const float* bb = WS(float, OFF_LOGF) + r0 * 512 + h * 128 + c;
        const bf16_t* vv = WS(bf16_t, OFF_RI) + r0 * 512 + h * 128 + c;
        float prev = half ? bb[31 * 512] : 0.f;
        const float* bp = bb + (size_t)(32 * half) * 512;
        const bf16_t* vp_ = vv + (size_t)(32 * half) * 512;
#pragma unroll 1
        for (int g = 0; g < 4; ++g) {
            const int s0 = 32 * half + 8 * g, sb = s0 & ~15;
            const float bend = bb[(size_t)(sb + 15) * 512];
            const float bref = (sb == 0) ? 0.f : bb[(size_t)(sb - 1) * 512];
            float bs[8]; uint32_t vs[8];
#pragma unroll
            for (int i = 0; i < 8; ++i) { bs[i] = bp[i * 512]; vs[i] = vp_[i * 512]; }
#pragma unroll
            for (int i = 0; i < 8; ++i) {
                const float k = 1.f - __expf(bs[i] - prev);
                prev = bs[i];
                KS[(s0 + i) * LD128 + c] = f2bf(k * __expf(bend - bs[i]));
                KD[(s0 + i) * LD128 + c] = f2bf(k * __expf(bref - bs[i]));
            }
            *(uint4*)(VT + c * LD64 + s0) = make_uint4(vs[0] | (vs[1] << 16), vs[2] | (vs[3] << 16), vs[4] | (vs[5] << 16), vs[6] | (vs[7] << 16));
            bp += 8 * 512; vp_ += 8 * 512;
        }
#pragma unroll
        for (int i = 0; i < 9; ++i) ((uint32_t*)AM)[tid + 256 * i] = 0u;
    }
    __syncthreads();
    const int tl = 16 * wi + fr;
    bf16x8 qf[4]; float bt[4][8];
    {
        const bf16_t* qrow = WS(bf16_t, OFF_RQ) + (r0 + tl) * 512 + h * 128 + 8 * fq;
        const float* brow = WS(float, OFF_LOGF) + (r0 + tl) * 512 + h * 128 + 8 * fq;
#pragma unroll
        for (int ks = 0; ks < 4; ++ks) {
            qf[ks] = *(const bf16x8*)(qrow + 32 * ks);
            const float4 x0 = *(const float4*)(brow + 32 * ks), x1 = *(const float4*)(brow + 32 * ks + 4);
            bt[ks][0] = x0.x; bt[ks][1] = x0.y; bt[ks][2] = x0.z; bt[ks][3] = x0.w; bt[ks][4] = x1.x; bt[ks][5] = x1.y; bt[ks][6] = x1.z; bt[ks][7] = x1.w;
        }
    }
    auto qfrag = [&](int ks, const float* refrow) -> bf16x8 {
        float rf[8];
        if (refrow) {
            const float4 x0 = *(const float4*)(refrow + 32 * ks), x1 = *(const float4*)(refrow + 32 * ks + 4);
            rf[0] = x0.x; rf[1] = x0.y; rf[2] = x0.z; rf[3] = x0.w; rf[4] = x1.x; rf[5] = x1.y; rf[6] = x1.z; rf[7] = x1.w;
        } else {
#pragma unroll
            for (int jj = 0; jj < 8; ++jj) rf[jj] = 0.f;
        }
        bf16x8 o;
#pragma unroll
        for (int jj = 0; jj < 8; ++jj) o[jj] = (short)f2bf(bf2f((bf16_t)qf[ks][jj]) * __expf(bt[ks][jj] - rf[jj]));
        return o;
    };
    const float* bchunk = WS(float, OFF_LOGF) + r0 * 512 + h * 128 + 8 * fq;
    f32x4 acc[8];
#pragma unroll
    for (int n8 = 0; n8 < 8; ++n8) acc[n8] = (f32x4){0.f, 0.f, 0.f, 0.f};
    {
        const bf16_t* sp = WS(bf16_t, OFF_DS) + (size_t)unit * 16384 + fr * 128 + 8 * fq;
#pragma unroll
        for (int ks = 0; ks < 4; ++ks) {
            const bf16x8 a = qfrag(ks, nullptr);
#pragma unroll
            for (int n8 = 0; n8 < 8; ++n8) {
                const bf16x8 bf = *(const bf16x8*)(sp + (size_t)n8 * 16 * 128 + 32 * ks);
                acc[n8] = __builtin_amdgcn_mfma_f32_16x16x32_bf16(a, bf, acc[n8], 0, 0, 0);
            }
        }
    }
    for (int j = 0; j < wi; ++j) {
        f32x4 c4 = (f32x4){0.f, 0.f, 0.f, 0.f};
        const float* refrow = bchunk + (size_t)(16 * j + 15) * 512;
#pragma unroll
        for (int ks = 0; ks < 4; ++ks) {
            const bf16x8 a = qfrag(ks, refrow);
            const bf16x8 bf = *(const bf16x8*)(KS + (16 * j + fr) * LD128 + 32 * ks + 8 * fq);
            c4 = __builtin_amdgcn_mfma_f32_16x16x32_bf16(a, bf, c4, 0, 0, 0);
        }
#pragma unroll
        for (int jj = 0; jj < 4; ++jj) AM[(16 * wi + 4 * fq + jj) * LD64 + 16 * j + fr] = f2bf(c4[jj]);
    }
    {
        f32x4 c4 = (f32x4){0.f, 0.f, 0.f, 0.f};
        const float* refrow = (wi > 0) ? (bchunk + (size_t)(16 * wi - 1) * 512) : nullptr;
#pragma unroll
        for (int ks = 0; ks < 4; ++ks) {
            const bf16x8 a = qfrag(ks, refrow);
            const bf16x8 bf = *(const bf16x8*)(KD + (16 * wi + fr) * LD128 + 32 * ks + 8 * fq);
            c4 = __builtin_amdgcn_mfma_f32_16x16x32_bf16(a, bf, c4, 0, 0, 0);
        }
#pragma unroll
        for (int jj = 0; jj < 4; ++jj) AM[(16 * wi + 4 * fq + jj) * LD64 + 16 * wi + fr] = f2bf((fr <= 4 * fq + jj) ? c4[jj] : 0.f);
    }
    __syncthreads();
#pragma unroll
    for (int ks = 0; ks < 2; ++ks) {
        const bf16x8 a = *(const bf16x8*)(AM + (16 * wi + fr) * LD64 + 32 * ks + 8 * fq);
#pragma unroll
        for (int n8 = 0; n8 < 8; ++n8) {
            const bf16x8 bf = *(const bf16x8*)(VT + (16 * n8 + fr) * LD64 + 32 * ks + 8 * fq);
            acc[n8] = __builtin_amdgcn_mfma_f32_16x16x32_bf16(a, bf, acc[n8], 0, 0, 0);
        }
    }
#pragma unroll
    for (int jj = 0; jj < 4; ++jj) {
        float ss = 0.f;
#pragma unroll
        for (int n8 = 0; n8 < 8; ++n8) ss += acc[n8][jj] * acc[n8][jj];
        ss += __shfl_xor(ss, 1); ss += __shfl_xor(ss, 2); ss += __shfl_xor(ss, 4); ss += __shfl_xor(ss, 8);
        const float rstd = rsqrtf(ss * (1.f / 128.f) + EPS);
        const int trow = 16 * wi + 4 * fq + jj;
#pragma unroll
        for (int n8 = 0; n8 < 8; ++n8) {
            const int e = 16 * n8 + fr;
            const float val = acc[n8][jj] * rstd * p.g_rec[h * 128 + e] * bf2f(WS(bf16_t, OFF_RG)[(r0 + trow) * 512 + h * 128 + e]);
            WS(bf16_t, OFF_REC)[(t0 + trow) * 512 + h * 128 + e] = f2bf(val);
        }
        asm volatile("" ::: "memory");
    }
    __syncthreads();
}

#if TOPK_SIMPLE
__device__ __forceinline__ void d_peer_topk_simple(const P& p, int unit) {
    const int t = (unit >> 3) * 256 + ltid(), h = unit & 7;
    const bf16_t* qp = WS(bf16_t, OFF_QRY) + (size_t)t * DM + h * 128;
    float tv[2][16]; int ti[2][16];
#pragma unroll
    for (int pp = 0; pp < 2; ++pp) {
        float q[64];
#pragma unroll
        for (int d = 0; d < 64; ++d) q[d] = bf2f(qp[pp * 64 + d]);
#pragma unroll
        for (int i = 0; i < 16; ++i) { tv[pp][i] = -3.0e38f; ti[pp][i] = 0; }
        const bf16_t* kp = WS(bf16_t, OFF_KEYS) + (size_t)(h * 2 + pp) * 128 * 64;
        for (int n = 0; n < 128; ++n) {
            float sc = 0.f;
#pragma unroll
            for (int d = 0; d < 64; ++d) sc += q[d] * bf2f(kp[n * 64 + d]);
            float xv = sc; int xi = n;
#pragma unroll
            for (int i = 0; i < 16; ++i) {
                if (xv > tv[pp][i]) { const float tf = tv[pp][i]; const int tn = ti[pp][i]; tv[pp][i] = xv; ti[pp][i] = xi; xv = tf; xi = tn; }
            }
        }
    }
    float bv[16]; int bi[16];
#pragma unroll
    for (int i = 0; i < 16; ++i) { bv[i] = -3.0e38f; bi[i] = 0; }
#pragma unroll
    for (int i = 0; i < 16; ++i)
#pragma unroll
        for (int j = 0; j < 16; ++j) {
            if ((i + 1) * (j + 1) <= 16) {
                float xv = tv[0][i] + tv[1][j]; int xi = ti[0][i] * 128 + ti[1][j];
#pragma unroll
                for (int k = 0; k < 16; ++k) {
                    if (xv > bv[k]) { const float tf = bv[k]; const int tn = bi[k]; bv[k] = xv; bi[k] = xi; xv = tf; xi = tn; }
                }
            }
        }
    float se = 0.f, ev[16];
#pragma unroll
    for (int k = 0; k < 16; ++k) { ev[k] = __expf(bv[k] - bv[0]); se += ev[k]; }
    const float inv = 1.f / se;
#pragma unroll
    for (int k = 0; k < 16; ++k) {
        WS(int, OFF_PIDX)[(size_t)t * 128 + h * 16 + k] = bi[k];
        WS(float, OFF_PGATE)[(size_t)t * 128 + h * 16 + k] = ev[k] * inv;
    }
}

#endif
template <int N> __device__ __forceinline__ void bitonic_sort_desc(float (&v)[N]) {
#pragma unroll
    for (int k = 2; k <= N; k <<= 1)
#pragma unroll
        for (int j = k >> 1; j > 0; j >>= 1)
#pragma unroll
            for (int i = 0; i < N; ++i) {
                const int l = i ^ j;
                if (l > i) {
                    const bool desc = ((i & k) == 0);
                    const float a = v[i], b = v[l];
                    const float hi = fmaxf(a, b), lo = fminf(a, b);
                    v[i] = desc ? hi : lo; v[l] = desc ? lo : hi;
                }
            }
}
template <int N> __device__ __forceinline__ void bitonic_merge_desc(float (&v)[N]) {
#pragma unroll
    for (int j = N >> 1; j > 0; j >>= 1)
#pragma unroll
        for (int i = 0; i < N; ++i) {
            const int l = i ^ j;
            if (l > i) { const float a = v[i], b = v[l]; v[i] = fmaxf(a, b); v[l] = fminf(a, b); }
        }
}
__device__ __forceinline__ void ph_peer_qry_topk(const P& p, char* shm) {
    const int tid = ltid(), wid = tid >> 6, lane = tid & 63, wr = wid >> 1, wc = wid & 1, fr = lane & 15, fq = lane >> 4;
    float* tops = (float*)shm;
    for (int q = blockIdx.x >> 3; q < T / 128; q += gridDim.x >> 3) {
        const int h = q & 7, t0 = (8 * (q >> 3) + (blockIdx.x & 7)) * 128;
        f32x4 acc[4][4]; zero_acc(acc);
        gemm_kloop(WS(bf16_t, OFF_WQ), 1024, WS(bf16_t, OFF_H2B), 1024, 1024, h * 128, t0, acc, shm);
        int tb = t0 + wc * 64 + fr;
        asm volatile("" : "+v"(tb));
        {
            const bf16_t* ksrc = WS(bf16_t, OFF_KEYS) + (size_t)h * 2 * 128 * 64;
#pragma unroll
            for (int i = 0; i < 8; ++i) {
                const int q = tid + 256 * i, r = q >> 3, c8 = q & 7;
                *(uint4*)(shm + 16384 + (r * 72 + c8 * 8) * 2) = *(const uint4*)(ksrc + (size_t)r * 64 + c8 * 8);
            }
        }
        __syncthreads();
        const bf16_t* kbase = (const bf16_t*)(shm + 16384) + (size_t)(wr * 128 + fr) * 72 + 4 * fq;
#pragma unroll
        for (int n = 0; n < 4; ++n) {
            const int t = tb + n * 16;
            const float rstd = row_rstd(p, t);
            if (wr == 0 && fq == 0 && h == 0) WS(float, OFF_RSTD)[t] = rstd;
            bf16x8 bq[2];
#pragma unroll
            for (int ks = 0; ks < 2; ++ks)
#pragma unroll
                for (int j = 0; j < 4; ++j) { bq[ks][j] = (short)f2bf(acc[2 * ks][n][j] * rstd); bq[ks][4 + j] = (short)f2bf(acc[2 * ks + 1][n][j] * rstd); }
            float v[32];
#pragma unroll
            for (int mk = 0; mk < 8; ++mk) {
                f32x4 c = (f32x4){0.f, 0.f, 0.f, 0.f};
#pragma unroll
                for (int ks = 0; ks < 2; ++ks) {
                    const uint2 a0 = *(const uint2*)(kbase + mk * 16 * 72 + 32 * ks);
                    const uint2 a1 = *(const uint2*)(kbase + mk * 16 * 72 + 32 * ks + 16);
                    union { uint4 q; bf16x8 v; } av; av.q = make_uint4(a0.x, a0.y, a1.x, a1.y);
                    c = __builtin_amdgcn_mfma_f32_16x16x32_bf16(av.v, bq[ks], c, 0, 0, 0);
                }
#pragma unroll
                for (int j = 0; j < 4; ++j) v[4 * mk + j] = __uint_as_float((__float_as_uint(c[j]) & ~0x7Fu) | (unsigned)(16 * mk + 4 * fq + j));
            }
            float m[16];
            {
                float h0[16], h1[16];
#pragma unroll
                for (int i = 0; i < 16; ++i) { h0[i] = v[i]; h1[i] = v[16 + i]; }
                bitonic_sort_desc<16>(h0); bitonic_sort_desc<16>(h1);
#pragma unroll
                for (int i = 0; i < 16; ++i) m[i] = fmaxf(h0[i], h1[15 - i]);
                bitonic_merge_desc<16>(m);
            }
#pragma unroll
            for (int off = 16; off <= 32; off <<= 1) {
                float o[16];
#pragma unroll
                for (int i = 0; i < 16; ++i) o[i] = __shfl_xor(m[i], off);
#pragma unroll
                for (int i = 0; i < 16; ++i) m[i] = fmaxf(m[i], o[15 - i]);
                bitonic_merge_desc<16>(m);
            }
            if (fq == 0) {
                float4* dst = (float4*)(tops + ((size_t)wr * 128 + wc * 64 + n * 16 + fr) * 16);
                dst[0] = make_float4(m[0], m[1], m[2], m[3]); dst[1] = make_float4(m[4], m[5], m[6], m[7]);
                dst[2] = make_float4(m[8], m[9], m[10], m[11]); dst[3] = make_float4(m[12], m[13], m[14], m[15]);
            }
        }
        __syncthreads();
        if (tid < 128) {
            const float* ta = tops + (size_t)tid * 16;
            const float* tbp = tops + (size_t)(128 + tid) * 16;
            float a[16], b[16];
#pragma unroll
            for (int i = 0; i < 16; ++i) { a[i] = __uint_as_float(__float_as_uint(ta[i]) & ~0x7Fu); b[i] = __uint_as_float(__float_as_uint(tbp[i]) & ~0x7Fu); }
            float cand[64];
            int k = 0;
#pragma unroll
            for (int i = 0; i < 16; ++i)
#pragma unroll
                for (int j = 0; j < 16; ++j)
                    if ((i + 1) * (j + 1) <= 16) { cand[k] = __uint_as_float((__float_as_uint(a[i] + b[j]) & ~0xFFu) | (unsigned)(i * 16 + j)); ++k; }
#pragma unroll
            for (int kk = 50; kk < 64; ++kk) cand[kk] = -3.0e38f;
            bitonic_sort_desc<64>(cand);
            float ev[16], se = 0.f; int ex[16];
            const float best = __uint_as_float(__float_as_uint(cand[0]) & ~0xFFu);
#pragma unroll
            for (int q = 0; q < 16; ++q) {
                const unsigned bits = __float_as_uint(cand[q]);
                const int ci = (bits >> 4) & 15, cj = bits & 15;
                const int ia = (int)(__float_as_uint(ta[ci]) & 0x7Fu), ib = (int)(__float_as_uint(tbp[cj]) & 0x7Fu);
                ex[q] = ia * 128 + ib;
                ev[q] = __expf(__uint_as_float(bits & ~0xFFu) - best); se += ev[q];
            }
            const float inv = 1.f / se;
            int4* pi = (int4*)(WS(int, OFF_PIDX) + (size_t)(t0 + tid) * 128 + h * 16);
            float4* pg = (float4*)(WS(float, OFF_PGATE) + (size_t)(t0 + tid) * 128 + h * 16);
#pragma unroll
            for (int q = 0; q < 4; ++q) {
                pi[q] = make_int4(ex[4 * q], ex[4 * q + 1], ex[4 * q + 2], ex[4 * q + 3]);
                pg[q] = make_float4(ev[4 * q] * inv, ev[4 * q + 1] * inv, ev[4 * q + 2] * inv, ev[4 * q + 3] * inv);
            }
        }
        __syncthreads();
    }
}

#if PEER_SIMPLE
__device__ __forceinline__ void d_peer_expert(const P& p, int t, char* shm) {
    float* act = (float*)shm;
    float* red = (float*)(shm + 512);
    const int tid = ltid(), wid = tid >> 6, lane = tid & 63;
    const float rstd = row_rstd(p, t);
    const float* h2 = WS(float, OFF_H2) + (size_t)t * DM;
    float xn[16];
#pragma unroll
    for (int i = 0; i < 4; ++i) {
        const float4 v = ((const float4*)h2)[lane * 4 + i];
        const float4 g = ((const float4*)p.g_ffn)[lane * 4 + i];
        xn[4 * i + 0] = v.x * rstd * g.x; xn[4 * i + 1] = v.y * rstd * g.y; xn[4 * i + 2] = v.z * rstd * g.z; xn[4 * i + 3] = v.w * rstd * g.w;
    }
    const int* idx = WS(int, OFF_PIDX) + (size_t)t * 128;
    const float* gate = WS(float, OFF_PGATE) + (size_t)t * 128;
    const bf16_t* edn = WS(bf16_t, OFF_EDN);
    const bf16_t* eup = WS(bf16_t, OFF_EUP);
    for (int e = wid; e < 128; e += 4) {
        const bf16_t* row = edn + (size_t)idx[e] * DM + lane * 16;
        const uint4 a = ((const uint4*)row)[0], c = ((const uint4*)row)[1];
        const uint32_t w[8] = {a.x, a.y, a.z, a.w, c.x, c.y, c.z, c.w};
        float s = 0.f;
#pragma unroll
        for (int i = 0; i < 8; ++i) s += xn[2 * i] * __uint_as_float(w[i] << 16) + xn[2 * i + 1] * __uint_as_float(w[i] & 0xFFFF0000u);
        s = wave_sum(s);
        if (lane == 0) act[e] = 0.5f * s * (1.f + erff(s * 0.70710678118654752f)) * gate[e];
    }
    __syncthreads();
    float y0 = 0.f, y1 = 0.f, y2 = 0.f, y3 = 0.f;
    for (int e = 0; e < 128; ++e) {
        const float a = act[e];
        const uint2 w = *(const uint2*)(eup + (size_t)idx[e] * DM + tid * 4);
        y0 += a * __uint_as_float(w.x << 16); y1 += a * __uint_as_float(w.x & 0xFFFF0000u);
        y2 += a * __uint_as_float(w.y << 16); y3 += a * __uint_as_float(w.y & 0xFFFF0000u);
    }
    const float4 hv = ((const float4*)h2)[tid];
    const float o0 = hv.x + y0, o1 = hv.y + y1, o2 = hv.z + y2, o3 = hv.w + y3;
    float ss = wave_sum(o0 * o0 + o1 * o1 + o2 * o2 + o3 * o3);
    if (lane == 0) red[wid] = ss;
    __syncthreads();
    ss = red[0] + red[1] + red[2] + red[3];
    const float rs = rsqrtf(ss * (1.f / DM) + EPS);
    const float4 g = ((const float4*)p.g_fin)[tid];
    float4 ov; ov.x = o0 * rs * g.x; ov.y = o1 * rs * g.y; ov.z = o2 * rs * g.z; ov.w = o3 * rs * g.w;
    ((float4*)(p.out + (size_t)t * DM))[tid] = ov;
    __syncthreads();
}

#endif
__device__ __forceinline__ float* part_ptr(const P& p, int c) {
    return WS(float, OFF_PART) + (size_t)c * T * 128;
}
__device__ __forceinline__ unsigned xcc_id() { return (unsigned)__builtin_amdgcn_s_getreg((3 << 11) | 20) & 7u; }

#define MEMFENCE() asm volatile("" ::: "memory")
typedef float f32x2_t __attribute__((ext_vector_type(2)));
__device__ __forceinline__ float dpp_xor1(float v) { return __builtin_amdgcn_update_dpp(0.f, v, 0xB1, 0xF, 0xF, false); }
__device__ __forceinline__ float dpp_xor2(float v) { return __builtin_amdgcn_update_dpp(0.f, v, 0x4E, 0xF, 0xF, false); }
__device__ __forceinline__ float swz_xor4(float v) { return __int_as_float(__builtin_amdgcn_ds_swizzle(__float_as_int(v), 0x101F)); }
__device__ __forceinline__ float gelu_as(float v) {
    const float av = fabsf(v), t = __builtin_amdgcn_rcpf(av * 0.2316418882f + 1.0f);
    float q = t * 0.5307027145f + (-0.7265760135f); q = q * t + 0.7107068705f; q = q * t + (-0.142248368f); q = q * t + 0.127414796f; q = q * t;
    const float m = v * (q * __builtin_amdgcn_exp2f((v * v) * (-0.72134752044f)));
    return v < 0.f ? m : v - m;
}
__device__ __forceinline__ float group8_transpose_sum(const float (&s)[8], int ch) {
    const bool b0 = ch & 1, b1 = (ch >> 1) & 1, b2 = (ch >> 2) & 1;
    float r4[4], r2[2];
#pragma unroll
    for (int j = 0; j < 4; ++j) { const float keep = b0 ? s[2 * j + 1] : s[2 * j], send = b0 ? s[2 * j] : s[2 * j + 1]; r4[j] = keep + dpp_xor1(send); }
#pragma unroll
    for (int j = 0; j < 2; ++j) { const float keep = b1 ? r4[2 * j + 1] : r4[2 * j], send = b1 ? r4[2 * j] : r4[2 * j + 1]; r2[j] = keep + dpp_xor2(send); }
    const float keep = b2 ? r2[1] : r2[0], send = b2 ? r2[0] : r2[1];
    return keep + swz_xor4(send);
}
constexpr int PEER_TILE = 32;
constexpr int PEER_WTOK = PEER_TILE / 4;
__device__ __forceinline__ void d_peer_e1_run(const P& p, int t0, int c, int lane) {
    const int g8 = lane >> 3, ch = lane & 7;
    const unsigned char* tab = WS(unsigned char, OFF_EDN);
    const unsigned loff = 128u * (unsigned)c + 16u * (unsigned)ch;
    float4 gf[4];
#pragma unroll
    for (int q = 0; q < 4; ++q) gf[q] = *(const float4*)(p.g_ffn + 128 * c + 16 * ch + 4 * q);
    const int4* ip = (const int4*)(WS(int, OFF_PIDX) + (size_t)t0 * 128 + 16 * g8);
    int4 nidx[4];
#pragma unroll
    for (int k = 0; k < 4; ++k) nidx[k] = ip[k];
#pragma unroll 1
    for (int tk = 0; tk < PEER_WTOK; ++tk) {
        const int t = t0 + tk;
        const unsigned idx[16] = {(unsigned)nidx[0].x, (unsigned)nidx[0].y, (unsigned)nidx[0].z, (unsigned)nidx[0].w, (unsigned)nidx[1].x, (unsigned)nidx[1].y, (unsigned)nidx[1].z, (unsigned)nidx[1].w,
                                  (unsigned)nidx[2].x, (unsigned)nidx[2].y, (unsigned)nidx[2].z, (unsigned)nidx[2].w, (unsigned)nidx[3].x, (unsigned)nidx[3].y, (unsigned)nidx[3].z, (unsigned)nidx[3].w};
        uint4 w[16];
#pragma unroll
        for (int k = 0; k < 16; ++k) w[k] = *(const uint4*)(tab + (idx[k] * 1024u + loff));
        const bf16_t* hp = WS(bf16_t, OFF_H2B) + (size_t)t * DM + 128 * c + 16 * ch;
        const uint4 h0 = *(const uint4*)hp, h1 = *(const uint4*)(hp + 8);
        const float rstd = WS(float, OFF_RSTD)[t];
        if (tk + 1 < PEER_WTOK) {
#pragma unroll
            for (int k = 0; k < 4; ++k) nidx[k] = ip[(tk + 1) * 32 + k];
        }
        MEMFENCE();
        f32x2_t x[8];
        {
            const uint32_t hw[8] = {h0.x, h0.y, h0.z, h0.w, h1.x, h1.y, h1.z, h1.w};
#pragma unroll
            for (int q = 0; q < 4; ++q) {
                x[2 * q] = (f32x2_t){__uint_as_float(hw[2 * q] << 16) * rstd * gf[q].x, __uint_as_float(hw[2 * q] & 0xFFFF0000u) * rstd * gf[q].y};
                x[2 * q + 1] = (f32x2_t){__uint_as_float(hw[2 * q + 1] << 16) * rstd * gf[q].z, __uint_as_float(hw[2 * q + 1] & 0xFFFF0000u) * rstd * gf[q].w};
            }
        }
        float res[2];
#pragma unroll
        for (int hh = 0; hh < 2; ++hh) {
            float s[8];
#pragma unroll
            for (int k = 0; k < 8; ++k) {
                const uint4 wk = w[8 * hh + k];
                f32x2_t a2 = __builtin_amdgcn_cvt_pk_f32_fp8((int)wk.x, false) * x[0];
                a2 = __builtin_elementwise_fma(__builtin_amdgcn_cvt_pk_f32_fp8((int)wk.x, true), x[1], a2);
                a2 = __builtin_elementwise_fma(__builtin_amdgcn_cvt_pk_f32_fp8((int)wk.y, false), x[2], a2);
                a2 = __builtin_elementwise_fma(__builtin_amdgcn_cvt_pk_f32_fp8((int)wk.y, true), x[3], a2);
                a2 = __builtin_elementwise_fma(__builtin_amdgcn_cvt_pk_f32_fp8((int)wk.z, false), x[4], a2);
                a2 = __builtin_elementwise_fma(__builtin_amdgcn_cvt_pk_f32_fp8((int)wk.z, true), x[5], a2);
                a2 = __builtin_elementwise_fma(__builtin_amdgcn_cvt_pk_f32_fp8((int)wk.w, false), x[6], a2);
                a2 = __builtin_elementwise_fma(__builtin_amdgcn_cvt_pk_f32_fp8((int)wk.w, true), x[7], a2);
                s[k] = a2[0] + a2[1];
            }
            res[hh] = group8_transpose_sum(s, ch);
        }
        float* pp = part_ptr(p, c) + (size_t)t * 128 + 16 * g8 + ch;
        pp[0] = res[0]; pp[8] = res[1];
    }
}

__device__ __forceinline__ void d_peer_e2_run(const P& p, int t0, int c, int lane, float* sact) {
    const int g8 = lane >> 3, ch = lane & 7;
    const unsigned char* tab = WS(unsigned char, OFF_EUP);
    const unsigned loff = 128u * (unsigned)c + 16u * (unsigned)ch;
    const bool b3 = (lane >> 3) & 1, b4 = (lane >> 4) & 1, b5 = (lane >> 5) & 1;
    const int col = 128 * c + 16 * ch + 8 * (int)b3 + 4 * (int)b4 + 2 * (int)b5;
    const int4* ip = (const int4*)(WS(int, OFF_PIDX) + (size_t)t0 * 128 + 16 * g8);
    int4 nidx[4];
    float npu[2][8], ngt[2];
#pragma unroll
    for (int k = 0; k < 4; ++k) nidx[k] = ip[k];
#pragma unroll
    for (int k = 0; k < 2; ++k) {
#pragma unroll
        for (int cc = 0; cc < 8; ++cc) npu[k][cc] = part_ptr(p, cc)[(size_t)t0 * 128 + lane + 64 * k];
        ngt[k] = WS(float, OFF_PGATE)[(size_t)t0 * 128 + lane + 64 * k];
    }
#pragma unroll 1
    for (int tk = 0; tk < PEER_WTOK; ++tk) {
        const int t = t0 + tk;
        const unsigned idx[16] = {(unsigned)nidx[0].x, (unsigned)nidx[0].y, (unsigned)nidx[0].z, (unsigned)nidx[0].w, (unsigned)nidx[1].x, (unsigned)nidx[1].y, (unsigned)nidx[1].z, (unsigned)nidx[1].w,
                                  (unsigned)nidx[2].x, (unsigned)nidx[2].y, (unsigned)nidx[2].z, (unsigned)nidx[2].w, (unsigned)nidx[3].x, (unsigned)nidx[3].y, (unsigned)nidx[3].z, (unsigned)nidx[3].w};
        uint4 w[16];
#pragma unroll
        for (int k = 0; k < 16; ++k) w[k] = *(const uint4*)(tab + (idx[k] * 1024u + loff));
        const uint32_t hb = *(const uint32_t*)(WS(bf16_t, OFF_H2B) + (size_t)t * DM + col);
        {
            const float u0 = (((npu[0][0] + npu[0][1]) + (npu[0][2] + npu[0][3])) + ((npu[0][4] + npu[0][5]) + (npu[0][6] + npu[0][7]))) * (1.f / 64.f);
            const float u1 = (((npu[1][0] + npu[1][1]) + (npu[1][2] + npu[1][3])) + ((npu[1][4] + npu[1][5]) + (npu[1][6] + npu[1][7]))) * (1.f / 64.f);
            sact[lane] = gelu_as(u0) * ngt[0] * 0.125f;
            sact[lane + 64] = gelu_as(u1) * ngt[1] * 0.125f;
        }
        if (tk + 1 < PEER_WTOK) {
#pragma unroll
            for (int k = 0; k < 4; ++k) nidx[k] = ip[(tk + 1) * 32 + k];
#pragma unroll
            for (int k = 0; k < 2; ++k) {
#pragma unroll
                for (int cc = 0; cc < 8; ++cc) npu[k][cc] = part_ptr(p, cc)[(size_t)(t + 1) * 128 + lane + 64 * k];
                ngt[k] = WS(float, OFF_PGATE)[(size_t)(t + 1) * 128 + lane + 64 * k];
            }
        }
        MEMFENCE();
        asm volatile("s_waitcnt lgkmcnt(0)" ::: "memory");
        float a[16];
        {
            const float4* ap = (const float4*)(sact + 16 * g8);
#pragma unroll
            for (int k = 0; k < 4; ++k) { const float4 v = ap[k]; a[4 * k] = v.x; a[4 * k + 1] = v.y; a[4 * k + 2] = v.z; a[4 * k + 3] = v.w; }
        }
        f32x2_t y[8];
#pragma unroll
        for (int k = 0; k < 8; ++k) y[k] = (f32x2_t){0.f, 0.f};
#pragma unroll
        for (int k = 0; k < 16; ++k) {
            const f32x2_t av = (f32x2_t){a[k], a[k]};
            const uint4 wk = w[k];
            y[0] = __builtin_elementwise_fma(__builtin_amdgcn_cvt_pk_f32_fp8((int)wk.x, false), av, y[0]);
            y[1] = __builtin_elementwise_fma(__builtin_amdgcn_cvt_pk_f32_fp8((int)wk.x, true), av, y[1]);
            y[2] = __builtin_elementwise_fma(__builtin_amdgcn_cvt_pk_f32_fp8((int)wk.y, false), av, y[2]);
            y[3] = __builtin_elementwise_fma(__builtin_amdgcn_cvt_pk_f32_fp8((int)wk.y, true), av, y[3]);
            y[4] = __builtin_elementwise_fma(__builtin_amdgcn_cvt_pk_f32_fp8((int)wk.z, false), av, y[4]);
            y[5] = __builtin_elementwise_fma(__builtin_amdgcn_cvt_pk_f32_fp8((int)wk.z, true), av, y[5]);
            y[6] = __builtin_elementwise_fma(__builtin_amdgcn_cvt_pk_f32_fp8((int)wk.w, false), av, y[6]);
            y[7] = __builtin_elementwise_fma(__builtin_amdgcn_cvt_pk_f32_fp8((int)wk.w, true), av, y[7]);
        }
        f32x2_t k4[4], k2[2], k1;
#pragma unroll
        for (int k = 0; k < 4; ++k) {
            const f32x2_t keep = b3 ? y[4 + k] : y[k], send = b3 ? y[k] : y[4 + k];
            k4[k] = keep + (f32x2_t){__shfl_xor(send[0], 8), __shfl_xor(send[1], 8)};
        }
#pragma unroll
        for (int k = 0; k < 2; ++k) {
            const f32x2_t keep = b4 ? k4[2 + k] : k4[k], send = b4 ? k4[k] : k4[2 + k];
            k2[k] = keep + (f32x2_t){__shfl_xor(send[0], 16), __shfl_xor(send[1], 16)};
        }
        {
            const f32x2_t keep = b5 ? k2[1] : k2[0], send = b5 ? k2[0] : k2[1];
            k1 = keep + (f32x2_t){__shfl_xor(send[0], 32), __shfl_xor(send[1], 32)};
        }
        float2 o;
        o.x = __uint_as_float(hb << 16) + k1[0]; o.y = __uint_as_float(hb & 0xFFFF0000u) + k1[1];
        *(float2*)(p.out + (size_t)t * DM + col) = o;
        const float ss = wave_sum(o.x * o.x + o.y * o.y);
        if (lane == 0) WS(float, OFF_SSQ2)[(size_t)c * T + t] = ss;
    }
}

template <int PHASE> __device__ __forceinline__ void ph_peer_sliced(const P& p, char* shm, int rep) {
    int* s_tile = (int*)shm;
    float* sact = (float*)(shm + 64) + (ltid() >> 6) * 128;
    const int tid = ltid(), lane = tid & 63, wid = tid >> 6;
    unsigned* qc = WS(unsigned, OFF_QCNT) + (PHASE == 2 ? 8 : 0) + 16 * rep;
    const unsigned x0 = xcc_id();
    for (int dc = 0; dc < 8; ++dc) {
        const int c = (int)((x0 + dc) & 7u);
        __syncthreads();
        if (tid == 0) *s_tile = (int)atomicAdd(&qc[c], 1u);
        __syncthreads();
        int tile = *s_tile;
        while (tile < T / PEER_TILE) {
            __syncthreads();
            int nxt = 0;
            if (tid == 0) nxt = (int)atomicAdd(&qc[c], 1u);
            const int t0 = tile * PEER_TILE + wid * PEER_WTOK;
            if (PHASE == 1) d_peer_e1_run(p, t0, c, lane); else d_peer_e2_run(p, t0, c, lane, sact);
            if (tid == 0) *s_tile = nxt;
            __syncthreads();
            tile = *s_tile;
        }
    }
}

__device__ __forceinline__ void d_peer_e3(const P& p, int t) {
    const int tid = ltid();
    float s = 0.f;
#pragma unroll
    for (int c = 0; c < 8; ++c) s += WS(float, OFF_SSQ2)[(size_t)c * T + t];
    const float rs = rsqrtf(s * (1.f / DM) + EPS);
    float4* op = (float4*)(p.out + (size_t)t * DM) + tid;
    const float4 g = ((const float4*)p.g_fin)[tid];
    float4 v = *op;
    v.x *= rs * g.x; v.y *= rs * g.y; v.z *= rs * g.z; v.w *= rs * g.w;
    *op = v;
}

#define XB_TMO      128
#define XB_XCNT(j)  (256  + 64 * (j))
#define XB_XSUB(j)  (1280 + 64 * (j))
#define XB_XGEN(j)  (2304 + 64 * (j))
#define XB_TOP      3328
#define XB_TOPGEN   3392
#define XCD_BAR_WORDS 3456
#define XB_SPIN_CAP (1u << 22)
#define LAS __attribute__((address_space(3)))
__device__ __forceinline__ unsigned xb_ld(unsigned* p) { return __hip_atomic_load(p, __ATOMIC_RELAXED, __HIP_MEMORY_SCOPE_AGENT); }
__device__ __forceinline__ unsigned xb_add(unsigned* p, unsigned v) { return __hip_atomic_fetch_add(p, v, __ATOMIC_RELAXED, __HIP_MEMORY_SCOPE_AGENT); }
__device__ __forceinline__ unsigned xb_xcc_id() { return (unsigned)__builtin_amdgcn_s_getreg((3 << 11) | 20) & 0xFu; }
#define XB_SPIN(cond, bar) do { unsigned _sp = 0; while (cond) { __builtin_amdgcn_s_sleep(1); \
    if ((++_sp & 255u) == 0u) { if (xb_ld(&(bar)[XB_TMO])) break; if (_sp > XB_SPIN_CAP) { atomicAdd(&(bar)[XB_TMO], 1u); break; } } } } while (0)
struct XcdBarrier { unsigned* bar; unsigned x; volatile LAS unsigned* st; };
__device__ __forceinline__ XcdBarrier xcd_barrier_post(unsigned* bar, volatile LAS unsigned* st) {
    XcdBarrier b; b.bar = bar; b.x = xb_xcc_id(); b.st = st;
    if (threadIdx.x == 0) (void)xb_add(&bar[XB_XCNT(b.x)], 1u);
    return b;
}
__device__ __forceinline__ void xcd_barrier_complete(unsigned* bar, unsigned x, unsigned& nloc, unsigned& nx) {
    const unsigned G = gridDim.x * gridDim.y * gridDim.z;
    unsigned sum, cnt, mine, sp = 0u;
    for (;;) {
        sum = 0u; cnt = 0u; mine = 0u;
#pragma unroll
        for (unsigned j = 0; j < 16; ++j) { const unsigned c = xb_ld(&bar[XB_XCNT(j)]); sum += c; cnt += (c > 0u) ? 1u : 0u; mine = (j == x) ? c : mine; }
        if (sum == G) break;
        __builtin_amdgcn_s_sleep(1);
        if ((++sp & 255u) == 0u) { if (xb_ld(&bar[XB_TMO])) break; if (sp > XB_SPIN_CAP) { atomicAdd(&bar[XB_TMO], 1u); break; } }
    }
    nloc = mine > 0u ? mine : 1u; nx = cnt > 0u ? cnt : 1u;
}
__device__ __forceinline__ void xcd_barrier(const XcdBarrier& b) {
    asm volatile("s_waitcnt vmcnt(0)" ::: "memory");
    __syncthreads();
    if (threadIdx.x == 0) {
        unsigned* bar = b.bar;
        __builtin_amdgcn_s_waitcnt(0);
        unsigned nloc = b.st[0], nx = b.st[1];
        if (nloc == 0u) { xcd_barrier_complete(bar, b.x, nloc, nx); b.st[0] = nloc; b.st[1] = nx; }
        const unsigned old = xb_add(&bar[XB_XSUB(b.x)], 1u);
        const unsigned gen = old / nloc;
        if (old + 1u == (gen + 1u) * nloc) {
            __builtin_amdgcn_fence(__ATOMIC_RELEASE, "agent");
            asm volatile("s_waitcnt vmcnt(0)" ::: "memory");
            const unsigned og = xb_add(&bar[XB_TOP], 1u);
            const unsigned tg = og / nx;
            if (og + 1u == (tg + 1u) * nx) xb_add(&bar[XB_TOPGEN], 1u);
            else XB_SPIN(xb_ld(&bar[XB_TOPGEN]) == tg, bar);
            __builtin_amdgcn_fence(__ATOMIC_ACQUIRE, "agent");
            xb_add(&bar[XB_XGEN(b.x)], 1u);
            asm volatile("s_waitcnt vmcnt(0)" ::: "memory");
        } else {
            XB_SPIN(xb_ld(&bar[XB_XGEN(b.x)]) == gen, bar);
            __builtin_amdgcn_fence(__ATOMIC_ACQUIRE, "agent");
            asm volatile("s_waitcnt vmcnt(0)" ::: "memory");
        }
    }
    __syncthreads();
}

#define REP_P0 1
#define REP_P1 1
#define REP_P2 1
#define REP_P2C 1
#define REP_P3 1
#define REP_P4G 1
#define REP_P4C 1
#define REP_P5 1
#define REP_P6 1
#define REP_P9 1
#define REP_E1 1
#define REP_E2 1
#define REPEAT(N) for (int rep_ = 0; rep_ < (N); ++rep_)
constexpr int SHM_BYTES = 65536;
__global__ void __launch_bounds__(256, 2) mega(P p) {
    __shared__ __attribute__((aligned(16))) char shm[SHM_BYTES + 16];
    const int G = gridDim.x, bid = blockIdx.x;
    volatile LAS unsigned* xst = (volatile LAS unsigned*)(shm + SHM_BYTES);
    if (threadIdx.x == 0) { xst[0] = 0u; xst[1] = 0u; }
    __syncthreads();
    const XcdBarrier xb = xcd_barrier_post(WS(unsigned, OFF_BAR), xst);

    {
        constexpr int U_WIN = (NIN / 32) * 32, U_WUA = 32 * 16, U_WUR = 32 * 16, U_WOUT = 32 * 32, U_WQ = 32 * 32, U_KEYS = 32, U_MISC = (LP * 8 + 255) / 256;
        constexpr int E0 = U_WIN, E1 = E0 + U_WUA, E2 = E1 + U_WUR, E3 = E2 + U_WOUT, E4 = E3 + U_WQ, E5 = E4 + U_KEYS, E6 = E5 + U_MISC, E7 = E6 + R / 4;
        if (bid == 0 && threadIdx.x < 64) WS(unsigned, OFF_QCNT)[threadIdx.x] = 0u;
        REPEAT(REP_P0)
        for (int u = bid; u < E7; u += G) {
            if (u < E0) d_transpose(p.w_in, WS(bf16_t, OFF_WIN), 1024, NIN, nullptr, u, shm);
            else if (u < E1) d_transpose(p.w_ua, WS(bf16_t, OFF_WUA), 512, 1024, nullptr, u - E0, shm);
            else if (u < E2) d_transpose(p.w_ur, WS(bf16_t, OFF_WUR), 512, 1024, nullptr, u - E1, shm);
            else if (u < E3) d_transpose(p.w_out, WS(bf16_t, OFF_WOUT), 1024, 1024, nullptr, u - E2, shm);
            else if (u < E4) d_transpose(p.w_q, WS(bf16_t, OFF_WQ), 1024, 1024, p.g_ffn, u - E3, shm);
            else if (u < E5) d_cvt(p.keys, WS(bf16_t, OFF_KEYS), (size_t)16 * 128 * 64 / 4, u - E4, U_KEYS);
            else if (u < E6) d_misc(p, u - E5);
            else d_rmsnorm_in(p, u - E6);
        }
    }
    xcd_barrier(xb);
    REPEAT(REP_P1) ph_gemm_inproj(p, shm);
    xcd_barrier(xb);
    REPEAT(REP_P2)
    for (int u = bid; u < 2048; u += G) { if (u < 1024) d_hgrn_A(p, u, shm); else d_attn(p, u - 1024, shm); }
    xcd_barrier(xb);
    for (int u = bid; u < 512; u += G) d_hgrn_scan(p, u);
    xcd_barrier(xb);
    REPEAT(REP_P2C)
    for (int u = bid; u < 1024; u += G) d_hgrn_C(p, u, shm);
    xcd_barrier(xb);
    REPEAT(REP_P3) ph_gemm_merge(p, shm);
    xcd_barrier(xb);
    REPEAT(REP_P4G) ph_gemm_out(p, shm);
    REPEAT(REP_P4C) {
    d_cvt8(p.edown, WS(unsigned char, OFF_EDN), (size_t)16384 * 1024 / 16, 64.f, bid, G);
    d_cvt8(p.eup, WS(unsigned char, OFF_EUP), (size_t)16384 * 1024 / 16, 8.f, bid, G); }
    xcd_barrier(xb);
    REPEAT(REP_P5) ph_peer_qry_topk(p, shm);
    xcd_barrier(xb);
    REPEAT(REP_E1) ph_peer_sliced<1>(p, shm, rep_);
    xcd_barrier(xb);
    REPEAT(REP_E2) ph_peer_sliced<2>(p, shm, rep_);
    xcd_barrier(xb);
    REPEAT(REP_P9)
    for (int t = bid; t < T; t += G) d_peer_e3(p, t);
}

extern "C" void kernel_launch(void* const* d_in, const int* in_sizes, int n_in, void* d_out, int out_size, void* d_ws, size_t ws_size, hipStream_t stream) {
    P p{};
    p.x = (const float*)d_in[0]; p.meta = (const float*)d_in[1]; p.g_mix = (const float*)d_in[2]; p.w_in = (const float*)d_in[3];
    p.b_in = (const float*)d_in[4]; p.sinks = (const float*)d_in[5]; p.lb_logits = (const float*)d_in[6]; p.g_rec = (const float*)d_in[7];
    p.w_ua = (const float*)d_in[8]; p.w_ur = (const float*)d_in[9]; p.w_out = (const float*)d_in[10]; p.g_ffn = (const float*)d_in[11];
    p.w_q = (const float*)d_in[12]; p.keys = (const float*)d_in[13]; p.edown = (const float*)d_in[14]; p.eup = (const float*)d_in[15];
    p.g_fin = (const float*)d_in[16];
    p.out = (float*)d_out; p.ws = (char*)d_ws;
    static int grid_blocks = 0;
    if (!grid_blocks) {
        int dev = 0, cus = 0, per_cu = 0;
        (void)hipGetDevice(&dev);
        (void)hipDeviceGetAttribute(&cus, hipDeviceAttributeMultiprocessorCount, dev);
        (void)hipOccupancyMaxActiveBlocksPerMultiprocessor(&per_cu, mega, 256, 0);
        if (per_cu > 2) per_cu = 2;
        if (per_cu < 1) per_cu = 1;
        grid_blocks = cus * per_cu;
    }
    (void)hipMemsetAsync((char*)d_ws + OFF_BAR, 0, XCD_BAR_WORDS * 4, stream);
    void* args[] = {&p};
    hipError_t e = hipLaunchCooperativeKernel((void*)mega, dim3(grid_blocks), dim3(256), args, 0, stream);
    if (e != hipSuccess) fprintf(stderr, "cooperative launch failed: %s (grid %d)\n", hipGetErrorString(e), grid_blocks);
}
```

```cpp
#include <hip/hip_runtime.h>
#include <hip/hip_cooperative_groups.h>
#include <stdint.h>
#include <stdio.h>
namespace cg = cooperative_groups;

typedef unsigned short bf16_t;
typedef short bf16x8 __attribute__((ext_vector_type(8)));
typedef float f32x4 __attribute__((ext_vector_type(4)));

constexpr int NB = 4, SEQ = 4096, DM = 1024, LP = 4224, PADF = 112;
constexpr int R = NB * LP;
constexpr int T = NB * SEQ;
constexpr int NIN = 4864;
constexpr float EPS = 1e-6f;

constexpr size_t MiB = 1024 * 1024;
constexpr size_t OFF_WUA = 0;
constexpr size_t OFF_WUR = 1 * MiB;
constexpr size_t OFF_WOUT = 2 * MiB;
constexpr size_t OFF_WQ = 4 * MiB;
constexpr size_t OFF_KEYS = 6 * MiB;
constexpr size_t OFF_ROPE = 6 * MiB + 256 * 1024;
constexpr size_t OFF_LB = OFF_ROPE + 272 * 1024;
constexpr size_t OFF_SSQ = 7 * MiB;
constexpr size_t OFF_B = 8 * MiB;
constexpr size_t OFF_QB = OFF_B;
constexpr size_t OFF_KB = OFF_QB + (size_t)R * 512 * 2;
constexpr size_t OFF_VB = OFF_KB + (size_t)R * 128 * 2;
constexpr size_t OFF_RQ = OFF_VB + (size_t)R * 128 * 2;
constexpr size_t OFF_LOGF = OFF_RQ + (size_t)R * 512 * 2;
constexpr size_t OFF_RI = OFF_LOGF + (size_t)R * 512 * 4;
constexpr size_t OFF_RG = OFF_RI + (size_t)R * 512 * 2;
constexpr size_t OFF_GA = OFF_RG + (size_t)R * 512 * 2;
constexpr size_t OFF_GR = OFF_GA + (size_t)R * 1024 * 2;
constexpr size_t OFF_C = OFF_GR + (size_t)R * 1024 * 2;
constexpr size_t OFF_XN = OFF_C;
constexpr size_t OFF_WIN = OFF_XN + (size_t)R * 1024 * 2;
constexpr size_t OFF_TAIL = OFF_WIN + (size_t)NIN * 1024 * 2;
constexpr size_t OFF_DS = OFF_TAIL;
constexpr size_t OFF_ATT = OFF_GA;
constexpr size_t OFF_REC = OFF_ATT + (size_t)T * 512 * 2;
constexpr size_t OFF_MRG = OFF_LOGF;
constexpr size_t OFF_H2B = OFF_RI;
constexpr size_t OFF_EDN = OFF_C;
constexpr size_t OFF_EUP = OFF_EDN + (size_t)16384 * 1024;
constexpr size_t OFF_QRY = OFF_QB;
constexpr size_t OFF_PIDX = OFF_MRG;
constexpr size_t OFF_PGATE = OFF_PIDX + (size_t)T * 128 * 4;
constexpr size_t OFF_RSTD = OFF_LB + 4096;
constexpr size_t OFF_BAR = 6 * MiB + 640 * 1024;
constexpr size_t OFF_QCNT = OFF_LB + 2048;
constexpr size_t OFF_PART = OFF_GA;
constexpr size_t OFF_ACT = OFF_QB + 1 * MiB;
constexpr size_t OFF_SSQ2 = OFF_QB;
static_assert(OFF_SSQ2 + (size_t)8 * T * 4 <= OFF_ACT && OFF_ACT + (size_t)T * 128 * 4 <= OFF_LOGF, "ssq2/act overlay");
static_assert(OFF_PART + 8 * (size_t)T * 128 * 4 <= OFF_C, "part overlay");
static_assert(OFF_QCNT + 256 <= OFF_RSTD && OFF_RSTD + (size_t)T * 4 <= OFF_BAR && OFF_BAR + 3456 * 4 <= OFF_SSQ, "qcnt/rstd/bar");
static_assert(OFF_EUP + (size_t)16384 * 1024 * 2 <= 256 * MiB, "ws overflow");
static_assert(OFF_DS + (size_t)16 * 64 * 16384 * 2 <= 256 * MiB, "ws overflow");
static_assert(OFF_REC + (size_t)T * 512 * 2 <= OFF_C, "overlay");
static_assert(OFF_QRY + (size_t)T * 1024 * 2 <= OFF_LOGF, "qry overlay");
static_assert(OFF_PGATE + (size_t)T * 128 * 4 <= OFF_RI, "pidx overlay");

struct P {
    const float *x, *meta, *g_mix, *w_in, *b_in, *sinks, *lb_logits, *g_rec, *w_ua, *w_ur, *w_out, *g_ffn, *w_q, *keys, *edown, *eup, *g_fin;
    float* out;
    char* ws;
};
#define WS(type, off) ((type*)(p.ws + (off)))

__device__ __forceinline__ int ltid() { int t = threadIdx.x; asm volatile("" : "+v"(t)); return t; }
typedef __bf16 bf16pair_t __attribute__((ext_vector_type(2)));
typedef float f32pair_t __attribute__((ext_vector_type(2)));
__device__ __forceinline__ uint32_t pack2(float lo, float hi) {
    union { bf16pair_t b; uint32_t u; } r; r.b = __builtin_convertvector((f32pair_t){lo, hi}, bf16pair_t); return r.u;
}
__device__ __forceinline__ bf16_t f2bf(float f) { union { __bf16 b; bf16_t u; } r; r.b = (__bf16)f; return r.u; }
__device__ __forceinline__ float bf2f(bf16_t h) { return __uint_as_float(((uint32_t)h) << 16); }
__device__ __forceinline__ float sigmoidf_(float v) { return 1.f / (1.f + __expf(-v)); }

__device__ __forceinline__ float wave_sum(float v) {
#pragma unroll
    for (int o = 32; o > 0; o >>= 1) v += __shfl_xor(v, o);
    return v;
}

typedef __bf16 bf16v2 __attribute__((ext_vector_type(2)));
__device__ __forceinline__ float dot2bf(uint32_t a, uint32_t b, float c) {
    union { uint32_t u; bf16v2 v; } x, y; x.u = a; y.u = b;
    return __builtin_amdgcn_fdot2_f32_bf16(x.v, y.v, c, false);
}
__device__ __forceinline__ float row_sum16(float v) {
    v += __builtin_amdgcn_update_dpp(0.f, v, 0xB1, 0xF, 0xF, false);
    v += __builtin_amdgcn_update_dpp(0.f, v, 0x4E, 0xF, 0xF, false);
    v += __builtin_amdgcn_update_dpp(0.f, v, 0x141, 0xF, 0xF, false);
    v += __builtin_amdgcn_update_dpp(0.f, v, 0x140, 0xF, 0xF, false);
    return v;
}
__device__ __forceinline__ void d_transpose(const float* __restrict__ W, bf16_t* __restrict__ Wt, int K, int N, const float* __restrict__ rs, int unit, char* shm) {
    float (*tile)[33] = (float (*)[33])shm;
    const int ntn = N / 32;
    const int k0 = (unit / ntn) * 32, n0 = (unit % ntn) * 32, tx = ltid() & 31, ty = ltid() >> 5;
#pragma unroll
    for (int i = 0; i < 4; ++i) {
        const int k = k0 + ty + i * 8;
        tile[ty + i * 8][tx] = W[(size_t)k * N + n0 + tx] * (rs ? rs[k] : 1.f);
    }
    __syncthreads();
#pragma unroll
    for (int i = 0; i < 4; ++i) {
        const int n = n0 + ty + i * 8;
        Wt[(size_t)n * K + k0 + tx] = f2bf(tile[tx][ty + i * 8]);
    }
    __syncthreads();
}

__device__ __forceinline__ void d_cvt(const float* __restrict__ src, bf16_t* __restrict__ dst, size_t n4, int vblk, int nvblk) {
    for (size_t i = (size_t)vblk * 256 + ltid(); i < n4; i += (size_t)nvblk * 256) {
        const float4 v = ((const float4*)src)[i];
        ushort4 o; o.x = f2bf(v.x); o.y = f2bf(v.y); o.z = f2bf(v.z); o.w = f2bf(v.w);
        ((ushort4*)dst)[i] = o;
    }
}

__device__ __forceinline__ void d_cvt8(const float* __restrict__ src, unsigned char* __restrict__ dst, size_t n16, float scale, int vblk, int nvblk) {
    for (size_t i = (size_t)vblk * 256 + ltid(); i < n16; i += (size_t)nvblk * 256) {
        const float4* s = (const float4*)src + i * 4;
        uint32_t w[4];
#pragma unroll
        for (int q = 0; q < 4; ++q) {
            const float4 v = s[q];
            int pk = 0;
            pk = __builtin_amdgcn_cvt_pk_fp8_f32(v.x * scale, v.y * scale, pk, false);
            pk = __builtin_amdgcn_cvt_pk_fp8_f32(v.z * scale, v.w * scale, pk, true);
            w[q] = (uint32_t)pk;
        }
        ((uint4*)dst)[i] = make_uint4(w[0], w[1], w[2], w[3]);
    }
}

__device__ __forceinline__ void d_misc(const P& p, int unit) {
    const int gid = unit * 256 + ltid();
    if (gid < LP * 8) {
        const int pp = gid >> 3, i = gid & 7;
        const double inv = pow(500000.0, -(double)i / 8.0);
        const double ang = (double)(pp - PADF) * inv;
        float2 cs; cs.x = (float)cos(ang); cs.y = (float)sin(ang);
        WS(float2, OFF_ROPE)[gid] = cs;
    }
    if (gid < 512) {
        const float l0 = p.lb_logits[gid], l1 = p.lb_logits[512 + gid];
        WS(float, OFF_LB)[gid] = 1.f / (1.f + expf(l1 - l0));
    }
}

__device__ __forceinline__ void d_rmsnorm_in(const P& p, int unit) {
    const int lane = ltid() & 63, r = unit * 4 + (ltid() >> 6), b = r / LP, pp = r % LP;
    bf16_t* dst = WS(bf16_t, OFF_XN) + (size_t)r * DM;
    if (pp < PADF) {
#pragma unroll
        for (int i = 0; i < 2; ++i) ((uint4*)dst)[lane + 64 * i] = make_uint4(0, 0, 0, 0);
        return;
    }
    const float* src = (pp < 128) ? (p.meta + (size_t)(pp - PADF) * DM) : (p.x + ((size_t)b * SEQ + (pp - 128)) * DM);
    float4 v[4];
#pragma unroll
    for (int i = 0; i < 4; ++i) v[i] = ((const float4*)src)[lane * 2 + (i & 1) + 128 * (i >> 1)];
    float ss = 0.f;
#pragma unroll
    for (int i = 0; i < 4; ++i) ss += (v[i].x * v[i].x + v[i].y * v[i].y) + (v[i].z * v[i].z + v[i].w * v[i].w);
    ss = wave_sum(ss);
    const float rstd = rsqrtf(ss * (1.f / DM) + EPS);
#pragma unroll
    for (int hh = 0; hh < 2; ++hh) {
        const float4 g0 = ((const float4*)p.g_mix)[lane * 2 + 128 * hh], g1 = ((const float4*)p.g_mix)[lane * 2 + 1 + 128 * hh];
        const float4 a = v[2 * hh], c = v[2 * hh + 1];
        ((uint4*)dst)[lane + 64 * hh] = make_uint4(pack2(a.x * rstd * g0.x, a.y * rstd * g0.y), pack2(a.z * rstd * g0.z, a.w * rstd * g0.w),
                                                   pack2(c.x * rstd * g1.x, c.y * rstd * g1.y), pack2(c.z * rstd * g1.z, c.w * rstd * g1.w));
    }
}

__device__ __forceinline__ void glds16(const void* src, void* lds) { __builtin_amdgcn_global_load_lds((const unsigned*)src, (unsigned*)lds, 16, 0, 0); }

__device__ __forceinline__ void gemm_kloop(const bf16_t* __restrict__ A, int lda, const bf16_t* __restrict__ Bt, int ldb, int K, int brow, int bcol,
                                           f32x4 (&acc)[4][4], char* shm) {
    const int tid = ltid(), wid = tid >> 6, lane = tid & 63, wr = wid >> 1, wc = wid & 1, fr = lane & 15, fq = lane >> 4;
    const int sr = tid >> 3, sc = ((tid & 7) ^ ((sr >> 1) & 7)) * 8;
    const bf16_t* ag = A + (size_t)(brow + sr) * lda + sc;
    const bf16_t* bg = Bt + (size_t)(bcol + sr) * ldb + sc;
    const int nt = K >> 6;
#pragma unroll
    for (int i = 0; i < 4; ++i) {
        glds16(ag + (size_t)(32 * i) * lda, shm + tid * 16 + i * 4096);
        glds16(bg + (size_t)(32 * i) * ldb, shm + 16384 + tid * 16 + i * 4096);
    }
    asm volatile("s_waitcnt vmcnt(0)" ::: "memory");
    __syncthreads();
    const int arow = wr * 64 + fr, brw = wc * 64 + fr;
    const int swz = (fr >> 1) & 7;
    for (int kt = 0; kt < nt; ++kt) {
        char* SA = shm + (kt & 1) * 32768;
        char* SB = SA + 16384;
        if (kt + 1 < nt) {
            char* NA = shm + ((kt + 1) & 1) * 32768;
#pragma unroll
            for (int i = 0; i < 4; ++i) {
                glds16(ag + (size_t)(32 * i) * lda + (kt + 1) * 64, NA + tid * 16 + i * 4096);
                glds16(bg + (size_t)(32 * i) * ldb + (kt + 1) * 64, NA + 16384 + tid * 16 + i * 4096);
            }
        }
        bf16x8 a[2][4], b[2][4];
#pragma unroll
        for (int ks = 0; ks < 2; ++ks) {
            const int coff = (((ks * 4 + fq) ^ swz) << 4);
#pragma unroll
            for (int m = 0; m < 4; ++m) a[ks][m] = *(const bf16x8*)(SA + (arow + m * 16) * 128 + coff);
#pragma unroll
            for (int n = 0; n < 4; ++n) b[ks][n] = *(const bf16x8*)(SB + (brw + n * 16) * 128 + coff);
        }
        __builtin_amdgcn_s_setprio(1);
#pragma unroll
        for (int ks = 0; ks < 2; ++ks)
#pragma unroll
            for (int m = 0; m < 4; ++m)
#pragma unroll
                for (int n = 0; n < 4; ++n) acc[m][n] = __builtin_amdgcn_mfma_f32_16x16x32_bf16(a[ks][m], b[ks][n], acc[m][n], 0, 0, 0);
        __builtin_amdgcn_s_setprio(0);
        asm volatile("s_waitcnt vmcnt(0)" ::: "memory");
        __syncthreads();
    }
}

__device__ __forceinline__ void zero_acc(f32x4 (&acc)[4][4]) {
#pragma unroll
    for (int m = 0; m < 4; ++m)
#pragma unroll
        for (int n = 0; n < 4; ++n) acc[m][n] = (f32x4){0.f, 0.f, 0.f, 0.f};
}

constexpr int EPI_LD = 136;
__device__ __forceinline__ void tile_store_bf16(const char* shm, bf16_t* dst, int ld) {
    __syncthreads();
    const int t_ = ltid();
#pragma unroll
    for (int i = 0; i < 8; ++i) {
        const int q = t_ + 256 * i, r = q >> 4, c = q & 15;
        *(uint4*)(dst + (size_t)r * ld + c * 8) = *(const uint4*)(shm + (r * EPI_LD + c * 8) * 2);
    }
    __syncthreads();
}

__device__ __forceinline__ void tile_load_bf16(char* shm, const bf16_t* srcp, int ld) {
    const int t_ = ltid();
#pragma unroll
    for (int i = 0; i < 8; ++i) {
        const int q = t_ + 256 * i, r = q >> 4, c = q & 15;
        *(uint4*)(shm + (r * EPI_LD + c * 8) * 2) = *(const uint4*)(srcp + (size_t)r * ld + c * 8);
    }
}

__device__ __forceinline__ void ph_gemm_inproj(const P& p, char* shm) {
    const int tid = ltid(), wid = tid >> 6, lane = tid & 63, wr = wid >> 1, wc = wid & 1, fr = lane & 15, fq = lane >> 4;
    constexpr int NT_N = 2816 / 128, NT_M = R / 128;
    const float2* rope = WS(float2, OFF_ROPE);
    const float* lbv = WS(float, OFF_LB);
    for (int tile = blockIdx.x; tile < NT_N * NT_M; tile += gridDim.x) {
        const int pm = tile / NT_N, pn = tile % NT_N, brow_ = pm * 128, bcol_ = pn * 128;
        f32x4 acc[4][4]; zero_acc(acc);
        int brow = brow_, bcol = bcol_;
        gemm_kloop(WS(bf16_t, OFF_XN), DM, WS(bf16_t, OFF_WIN), DM, DM, brow, bcol, acc, shm);
        asm volatile("" : "+s"(brow), "+s"(bcol));
        if (bcol >= 1280 && bcol < 1792) {
#pragma unroll
            for (int n = 0; n < 4; ++n) {
                const int col = bcol + wc * 64 + n * 16 + fr;
                const float bv = p.b_in[col], lb = lbv[col - 1280];
                float run = 0.f;
#pragma unroll
                for (int m = 0; m < 4; ++m) {
                    float c[4];
#pragma unroll
                    for (int j = 0; j < 4; ++j) {
                        const int row = brow + wr * 64 + m * 16 + fq * 4 + j;
                        const float v = acc[m][n][j] + bv;
                        const float f = lb + (1.f - lb) * sigmoidf_(v);
                        const float lf = ((row % LP) < PADF) ? 0.f : __logf(f);
                        c[j] = lf + (j ? c[j - 1] : 0.f);
                    }
                    const float x = c[3];
                    const float y = __shfl_up(x, 16);
                    float incl = x + (fq >= 1 ? y : 0.f);
                    const float z = __shfl_up(incl, 32);
                    incl += (fq >= 2 ? z : 0.f);
                    const float excl = incl - x;
                    const float tot = __shfl(incl, fr + 48);
#pragma unroll
                    for (int j = 0; j < 4; ++j) {
                        const int row = brow + wr * 64 + m * 16 + fq * 4 + j;
                        WS(float, OFF_LOGF)[(size_t)row * 512 + (col - 1280)] = run + excl + c[j];
                    }
                    run += tot;
                }
            }
        } else {
            bf16_t* st = (bf16_t*)shm;
            const int kind = (bcol < 512) ? 0 : (bcol < 640) ? 1 : (bcol < 2304) ? 2 : 3;
#pragma unroll
            for (int m = 0; m < 4; ++m)
#pragma unroll
                for (int n = 0; n < 4; ++n) {
                    const int cl = wc * 64 + n * 16 + fr;
                    const float bv = p.b_in[bcol + cl];
#pragma unroll
                    for (int j = 0; j < 4; ++j) {
                        const int rl = wr * 64 + m * 16 + fq * 4 + j;
                        float v = acc[m][n][j] + bv;
                        if (kind <= 1) {
                            if (n == 0) {
                                const float other = __shfl_xor(v, 8);
                                const float2 cs = rope[((brow + rl) % LP) * 8 + (fr & 7)];
                                v = (fr < 8) ? (v * cs.x - other * cs.y) : (v * cs.x + other * cs.y);
                            }
                            if (kind == 0) v *= 0.125f;
                        } else if (kind == 3) v = v * sigmoidf_(v);
                        st[rl * EPI_LD + cl] = f2bf(v);
                    }
                }
            bf16_t* dst; int ld;
            if (bcol < 512) { dst = WS(bf16_t, OFF_QB) + bcol; ld = 512; }
            else if (bcol < 640) { dst = WS(bf16_t, OFF_KB); ld = 128; }
            else if (bcol < 768) { dst = WS(bf16_t, OFF_VB); ld = 128; }
            else if (bcol < 1280) { dst = WS(bf16_t, OFF_RQ) + (bcol - 768); ld = 512; }
            else if (bcol < 2304) { dst = WS(bf16_t, OFF_RI) + (bcol - 1792); ld = 512; }
            else { dst = WS(bf16_t, OFF_RG) + (bcol - 2304); ld = 512; }
            tile_store_bf16(shm, dst + (size_t)brow * ld, ld);
        }
    }
}

__device__ __forceinline__ void ph_gemm_merge(const P& p, char* shm) {
    const int tid = ltid(), wid = tid >> 6, lane = tid & 63, wr = wid >> 1, wc = wid & 1, fr = lane & 15, fq = lane >> 4;
    constexpr int NT_N = 8, NT_M = T / 128;
    bf16_t* st = (bf16_t*)shm;
    for (int tile = blockIdx.x; tile < NT_N * NT_M; tile += gridDim.x) {
        const int pm = tile / NT_N, pn = tile % NT_N, brow = pm * 128, bcol = pn * 128;
        const int prow = brow + 128 * (brow / SEQ + 1);
        f32x4 acc[4][4];
        uint32_t sg[4][4];
#pragma unroll 1
        for (int pass = 0; pass < 2; ++pass) {
            zero_acc(acc);
            gemm_kloop(WS(bf16_t, OFF_XN), DM, WS(bf16_t, OFF_WIN), DM, DM, prow, 2816 + 1024 * pass + bcol, acc, shm);
            int ecol = bcol;
            asm volatile("" : "+s"(ecol));
#pragma unroll
            for (int m = 0; m < 4; ++m)
#pragma unroll
                for (int n = 0; n < 4; ++n) {
                    const float bv = p.b_in[2816 + 1024 * pass + ecol + wc * 64 + n * 16 + fr];
                    uint32_t g8 = 0;
#pragma unroll
                    for (int j = 0; j < 4; ++j) g8 |= (uint32_t)__builtin_rintf(sigmoidf_(acc[m][n][j] + bv) * 255.f) << (8 * j);
                    sg[m][n] = g8;
                }
            zero_acc(acc);
            gemm_kloop(WS(bf16_t, pass ? OFF_REC : OFF_ATT), 512, WS(bf16_t, pass ? OFF_WUR : OFF_WUA), 512, 512, brow, bcol, acc, shm);
            int erow = brow;
            asm volatile("" : "+s"(erow), "+s"(ecol));
            bf16_t* mrg = WS(bf16_t, OFF_MRG) + (size_t)erow * 1024 + ecol;
            if (pass == 1) { tile_load_bf16(shm, mrg, 1024); __syncthreads(); }
#pragma unroll
            for (int m = 0; m < 4; ++m)
#pragma unroll
                for (int n = 0; n < 4; ++n) {
                    float v[4];
#pragma unroll
                    for (int j = 0; j < 4; ++j) v[j] = acc[m][n][j] * ((float)((sg[m][n] >> (8 * j)) & 0xFFu) * (1.f / 255.f));
                    const int cl = wc * 64 + n * 16 + fr, rl = wr * 64 + m * 16 + fq * 4;
#pragma unroll
                    for (int j = 0; j < 4; ++j) {
                        bf16_t* e = st + (rl + j) * EPI_LD + cl;
                        *e = f2bf(pass ? (v[j] + bf2f(*e)) : v[j]);
                    }
                }
            tile_store_bf16(shm, mrg, 1024);
        }
    }
}

__device__ __forceinline__ void ph_gemm_out(const P& p, char* shm) {
    const int tid = ltid(), wid = tid >> 6, lane = tid & 63, wr = wid >> 1, wc = wid & 1, fr = lane & 15, fq = lane >> 4;
    constexpr int NT_N = 8, NT_M = T / 128;
    bf16_t* st = (bf16_t*)shm;
    for (int q = blockIdx.x >> 3; q < NT_N * NT_M / 8; q += gridDim.x >> 3) {
        const int pm = 8 * (q >> 3) + (blockIdx.x & 7), pn = q & 7, brow_ = pm * 128, bcol_ = pn * 128;
        f32x4 acc[4][4]; zero_acc(acc);
        int brow = brow_, bcol = bcol_;
        gemm_kloop(WS(bf16_t, OFF_MRG), 1024, WS(bf16_t, OFF_WOUT), 1024, 1024, brow, bcol, acc, shm);
        asm volatile("" : "+s"(brow), "+s"(bcol));
#pragma unroll
        for (int m = 0; m < 4; ++m)
#pragma unroll
            for (int n = 0; n < 4; ++n)
#pragma unroll
                for (int j = 0; j < 4; ++j) st[(wr * 64 + m * 16 + fq * 4 + j) * EPI_LD + wc * 64 + n * 16 + fr] = f2bf(acc[m][n][j]);
        __syncthreads();
#pragma unroll 2
        for (int i = 0; i < 8; ++i) {
            const int q = tid + 256 * i, r = q >> 4, c = q & 15;
            const uint4 a = *(const uint4*)(shm + (r * EPI_LD + c * 8) * 2);
            const float* xp = p.x + (size_t)(brow + r) * DM + bcol + c * 8;
            const float4 x0 = *(const float4*)xp, x1 = *(const float4*)(xp + 4);
            const float h0 = x0.x + __uint_as_float(a.x << 16), h1 = x0.y + __uint_as_float(a.x & 0xFFFF0000u);
            const float h2 = x0.z + __uint_as_float(a.y << 16), h3 = x0.w + __uint_as_float(a.y & 0xFFFF0000u);
            const float h4 = x1.x + __uint_as_float(a.z << 16), h5 = x1.y + __uint_as_float(a.z & 0xFFFF0000u);
            const float h6 = x1.z + __uint_as_float(a.w << 16), h7 = x1.w + __uint_as_float(a.w & 0xFFFF0000u);
            *(uint4*)(WS(bf16_t, OFF_H2B) + (size_t)(brow + r) * DM + bcol + c * 8) = make_uint4(pack2(h0, h1), pack2(h2, h3), pack2(h4, h5), pack2(h6, h7));
            float ss = (h0 * h0 + h1 * h1) + (h2 * h2 + h3 * h3) + (h4 * h4 + h5 * h5) + (h6 * h6 + h7 * h7);
            ss = row_sum16(ss);
            if (c == 0) WS(float, OFF_SSQ)[(size_t)pn * T + brow + r] = ss;
        }
        __syncthreads();
    }
}

__device__ __forceinline__ float row_rstd(const P& p, int row) {
    float s = 0.f;
#pragma unroll
    for (int i = 0; i < 8; ++i) s += WS(float, OFF_SSQ)[(size_t)i * T + row];
    return rsqrtf(s * (1.f / DM) + EPS);
}

__device__ __forceinline__ void ph_gemm_qry(const P& p, char* shm) {
    const int tid = ltid(), wid = tid >> 6, lane = tid & 63, wr = wid >> 1, wc = wid & 1, fr = lane & 15, fq = lane >> 4;
    constexpr int NT_N = 8, NT_M = T / 128;
    for (int tile = blockIdx.x; tile < NT_N * NT_M; tile += gridDim.x) {
        const int pm = tile / NT_N, pn = tile % NT_N, brow_ = pm * 128, bcol_ = pn * 128;
        f32x4 acc[4][4]; zero_acc(acc);
        int brow = brow_, bcol = bcol_;
        gemm_kloop(WS(bf16_t, OFF_H2B), 1024, WS(bf16_t, OFF_WQ), 1024, 1024, brow, bcol, acc, shm);
        asm volatile("" : "+s"(brow), "+s"(bcol));
#pragma unroll
        for (int m = 0; m < 4; ++m)
#pragma unroll
            for (int j = 0; j < 4; ++j) {
                const int row = brow + wr * 64 + m * 16 + fq * 4 + j;
                const float rstd = row_rstd(p, row);
                if (bcol == 0 && wc == 0 && fr == 0) WS(float, OFF_RSTD)[row] = rstd;
#pragma unroll
                for (int n = 0; n < 4; ++n) {
                    const int col = bcol + wc * 64 + n * 16 + fr;
                    WS(bf16_t, OFF_QRY)[(size_t)row * DM + col] = f2bf(acc[m][n][j] * rstd);
                }
            }
    }
}

#if ATTN_SIMPLE
__device__ __forceinline__ void d_attn_simple(const P& p, int unit) {
    const int gid = unit * 256 + ltid();
    const int hq = gid / T, t = gid % T, b = t / SEQ, s = t % SEQ, pq = 128 + s, kvh = hq >> 2;
    const bf16_t* qp = WS(bf16_t, OFF_QB) + ((size_t)b * LP + pq) * 512 + hq * 64;
    float q[64], o[64];
#pragma unroll
    for (int d = 0; d < 64; ++d) { q[d] = bf2f(qp[d]); o[d] = 0.f; }
    float m = p.sinks[hq], l = 1.f;
    const bf16_t* kbase = WS(bf16_t, OFF_KB) + (size_t)b * LP * 128 + kvh * 64;
    const bf16_t* vbase = WS(bf16_t, OFF_VB) + (size_t)b * LP * 128 + kvh * 64;
    const int lo = (pq - 127 > 128) ? (pq - 127) : 128;
    const int nkeys = 16 + (pq - lo + 1);
    for (int i = 0; i < nkeys; ++i) {
        const int pk = (i < 16) ? (PADF + i) : (lo + i - 16);
        const bf16_t* kp = kbase + (size_t)pk * 128;
        const bf16_t* vp = vbase + (size_t)pk * 128;
        float sc = 0.f;
#pragma unroll
        for (int d = 0; d < 64; ++d) sc += q[d] * bf2f(kp[d]);
        const float mn = fmaxf(m, sc), a = __expf(m - mn), e = __expf(sc - mn);
        l = l * a + e;
#pragma unroll
        for (int d = 0; d < 64; ++d) o[d] = o[d] * a + e * bf2f(vp[d]);
        m = mn;
    }
    const float inv = 1.f / l;
    bf16_t* op = WS(bf16_t, OFF_ATT) + (size_t)t * 512 + hq * 64;
#pragma unroll
    for (int d = 0; d < 64; ++d) op[d] = f2bf(o[d] * inv);
}

#endif
constexpr int LDV = 280;
__device__ __forceinline__ void d_attn(const P& p, int unit, char* shm) {
    bf16_t* VT = (bf16_t*)shm;
    const int tid = ltid(), lane = tid & 63, fr = lane & 15, fq = lane >> 4;
    const int w = __builtin_amdgcn_readfirstlane(tid >> 6);
    const int hq = unit & 7, n = ((unit >> 3) & 31) + 1, b = unit >> 8, kvh = hq >> 2;
    const size_t rb = (size_t)b * LP;
    const int kb0 = 128 * (n - 1);
    const bf16_t* kbp = WS(bf16_t, OFF_KB) + kvh * 64;
    const bf16_t* vbp = WS(bf16_t, OFF_VB) + kvh * 64;
#pragma unroll 1
    for (int i = 0; i < 9; ++i) {
        const int c = tid + 256 * i;
        if (c < 2176) {
            const int x = c >> 3, dc = c & 7;
            const int pos = (x < 256) ? (kb0 + x) : (PADF + x - 256);
            const uint4 v = *(const uint4*)(vbp + (rb + pos) * 128 + 8 * dc);
            bf16_t* dst = VT + (8 * dc) * LDV + x;
            dst[0 * LDV] = (bf16_t)(v.x & 0xFFFF); dst[1 * LDV] = (bf16_t)(v.x >> 16);
            dst[2 * LDV] = (bf16_t)(v.y & 0xFFFF); dst[3 * LDV] = (bf16_t)(v.y >> 16);
            dst[4 * LDV] = (bf16_t)(v.z & 0xFFFF); dst[5 * LDV] = (bf16_t)(v.z >> 16);
            dst[6 * LDV] = (bf16_t)(v.w & 0xFFFF); dst[7 * LDV] = (bf16_t)(v.w >> 16);
        }
    }
    __syncthreads();
    bf16x8 qf[2][2];
#pragma unroll
    for (int u = 0; u < 2; ++u)
#pragma unroll
        for (int ks = 0; ks < 2; ++ks)
            qf[u][ks] = *(const bf16x8*)(WS(bf16_t, OFF_QB) + (rb + 128 * n + 32 * w + 16 * u + fr) * 512 + hq * 64 + 32 * ks + 8 * fq);
    f32x4 s[11][2];
#pragma unroll
    for (int tt = 0; tt < 11; ++tt) {
        const int x0 = (tt < 10) ? (32 * w + 16 * tt) : 256;
        const int pos = ((tt < 10) ? (kb0 + x0) : PADF) + fr;
        const bf16x8 k0 = *(const bf16x8*)(kbp + (rb + pos) * 128 + 8 * fq);
        const bf16x8 k1 = *(const bf16x8*)(kbp + (rb + pos) * 128 + 32 + 8 * fq);
#pragma unroll
        for (int u = 0; u < 2; ++u) {
            f32x4 c = (f32x4){0.f, 0.f, 0.f, 0.f};
            c = __builtin_amdgcn_mfma_f32_16x16x32_bf16(k0, qf[u][0], c, 0, 0, 0);
            c = __builtin_amdgcn_mfma_f32_16x16x32_bf16(k1, qf[u][1], c, 0, 0, 0);
            if (tt < 10) {
                const int xq = 128 + 32 * w + 16 * u + fr;
#pragma unroll
                for (int j = 0; j < 4; ++j) {
                    const int x = x0 + 4 * fq + j, dq = xq - x;
                    const bool ok = (dq >= 0) && (dq < 128) && (kb0 + x >= 128);
                    c[j] = ok ? c[j] : -1.0e30f;
                }
            }
            s[tt][u] = c;
        }
    }
    const float sink = p.sinks[hq];
    float inv[2];
#pragma unroll
    for (int u = 0; u < 2; ++u) {
        float m = sink;
#pragma unroll
        for (int tt = 0; tt < 11; ++tt)
#pragma unroll
            for (int j = 0; j < 4; ++j) m = fmaxf(m, s[tt][u][j]);
        m = fmaxf(m, __shfl_xor(m, 16)); m = fmaxf(m, __shfl_xor(m, 32));
        float l = 0.f;
#pragma unroll
        for (int tt = 0; tt < 11; ++tt)
#pragma unroll
            for (int j = 0; j < 4; ++j) { const float e = __expf(s[tt][u][j] - m); s[tt][u][j] = e; l += e; }
        l += __shfl_xor(l, 16); l += __shfl_xor(l, 32);
        l += __expf(sink - m);
        inv[u] = 1.f / l;
    }
    f32x4 o[4][2];
#pragma unroll
    for (int dt = 0; dt < 4; ++dt)
#pragma unroll
        for (int u = 0; u < 2; ++u) o[dt][u] = (f32x4){0.f, 0.f, 0.f, 0.f};
#pragma unroll
    for (int g = 0; g < 6; ++g) {
        const int xa = (g < 5) ? (32 * w + 32 * g) : 256, xb = (g < 5) ? (xa + 16) : 256;
        bf16x8 pf[2];
#pragma unroll
        for (int u = 0; u < 2; ++u) {
#pragma unroll
            for (int j = 0; j < 4; ++j) {
                pf[u][j] = (short)f2bf(s[2 * g][u][j]);
                pf[u][4 + j] = (g < 5) ? (short)f2bf(s[(g < 5) ? (2 * g + 1) : 0][u][j]) : (short)0;
            }
        }
#pragma unroll
        for (int dt = 0; dt < 4; ++dt) {
            const uint2 a0 = *(const uint2*)(VT + (16 * dt + fr) * LDV + xa + 4 * fq);
            const uint2 a1 = *(const uint2*)(VT + (16 * dt + fr) * LDV + xb + 4 * fq);
            union { uint4 q; bf16x8 v; } av; av.q = make_uint4(a0.x, a0.y, a1.x, a1.y);
#pragma unroll
            for (int u = 0; u < 2; ++u) o[dt][u] = __builtin_amdgcn_mfma_f32_16x16x32_bf16(av.v, pf[u], o[dt][u], 0, 0, 0);
        }
    }
#pragma unroll
    for (int u = 0; u < 2; ++u) {
        const size_t t = (size_t)b * SEQ + 128 * (n - 1) + 32 * w + 16 * u + fr;
#pragma unroll
        for (int dt = 0; dt < 4; ++dt) {
            uint2 ov;
            ov.x = pack2(o[dt][u][0] * inv[u], o[dt][u][1] * inv[u]);
            ov.y = pack2(o[dt][u][2] * inv[u], o[dt][u][3] * inv[u]);
            *(uint2*)(WS(bf16_t, OFF_ATT) + t * 512 + hq * 64 + 16 * dt + 4 * fq) = ov;
        }
    }
    __syncthreads();
}

#if HGRN_SIMPLE
__device__ __forceinline__ void d_hgrn_simple(const P& p, int bh, char* shm) {
    float (*fs)[128] = (float (*)[128])shm;
    float (*ks)[128] = (float (*)[128])(shm + 4096);
    float (*qs)[128] = (float (*)[128])(shm + 8192);
    float (*os)[128] = (float (*)[128])(shm + 12288);
    float (*red)[2] = (float (*)[2])(shm + 16384);
    const int b = bh >> 2, h = bh & 3, e = ltid() & 127;
    const bool act = ltid() < 128;
    float S[128];
#pragma unroll
    for (int d = 0; d < 128; ++d) S[d] = 0.f;
    const float g = p.g_rec[h * 128 + e];
    for (int p0 = PADF; p0 < LP; p0 += 8) {
        float v[8];
        if (act) {
#pragma unroll
            for (int i = 0; i < 8; ++i) {
                const size_t r = (size_t)b * LP + p0 + i;
                const float lf = WS(float, OFF_LOGF)[r * 512 + h * 128 + e] - (((p0 + i) & 63) ? WS(float, OFF_LOGF)[(r - 1) * 512 + h * 128 + e] : 0.f);
                const float f = __expf(lf);
                fs[i][e] = f; ks[i][e] = 1.f - f;
                qs[i][e] = bf2f(WS(bf16_t, OFF_RQ)[r * 512 + h * 128 + e]);
                v[i] = bf2f(WS(bf16_t, OFF_RI)[r * 512 + h * 128 + e]);
            }
        }
        __syncthreads();
        if (act) {
#pragma unroll
            for (int i = 0; i < 8; ++i) {
                float o = 0.f;
#pragma unroll
                for (int d = 0; d < 128; ++d) { S[d] = fs[i][d] * S[d] + ks[i][d] * v[i]; o += qs[i][d] * S[d]; }
                os[i][e] = o;
                const float ss = wave_sum(o * o);
                if ((e & 63) == 0) red[i][e >> 6] = ss;
            }
        }
        __syncthreads();
        if (act && p0 >= 128) {
#pragma unroll
            for (int i = 0; i < 8; ++i) {
                const size_t r = (size_t)b * LP + p0 + i;
                const size_t t = (size_t)b * SEQ + (p0 + i - 128);
                const float rstd = rsqrtf((red[i][0] + red[i][1]) * (1.f / 128.f) + EPS);
                const float val = os[i][e] * rstd * g * bf2f(WS(bf16_t, OFF_RG)[r * 512 + h * 128 + e]);
                WS(bf16_t, OFF_REC)[t * 512 + h * 128 + e] = f2bf(val);
            }
        }
        __syncthreads();
    }
}

#endif

constexpr int LD64 = 72;
constexpr int LD128 = 136;

__device__ __forceinline__ void d_hgrn_A(const P& p, int unit, char* shm) {
    bf16_t* VT = (bf16_t*)shm;
    bf16_t* KT = (bf16_t*)(shm + 128 * LD64 * 2);
    const int tid = ltid(), wid = tid >> 6, lane = tid & 63, fr = lane & 15, fq = lane >> 4;
    const int bh = unit >> 6, n = (unit & 63) + 1, b = bh >> 2, h = bh & 3;
    const int c = tid & 127, half = tid >> 7;
    const size_t r0 = (size_t)b * LP + 64 * n;
    const float* bb = WS(float, OFF_LOGF) + r0 * 512 + h * 128 + c;
    const bf16_t* vv = WS(bf16_t, OFF_RI) + r0 * 512 + h * 128 + c;
    {
        const float blast = bb[63 * 512];
        float prev = half ? bb[31 * 512] : 0.f;
        const float* bp = bb + (size_t)(32 * half) * 512;
        const bf16_t* vp_ = vv + (size_t)(32 * half) * 512;
#pragma unroll 1
        for (int g = 0; g < 4; ++g) {
            float bs[8]; uint32_t vs[8];
#pragma unroll
            for (int i = 0; i < 8; ++i) { bs[i] = bp[i * 512]; vs[i] = vp_[i * 512]; }
            uint32_t kp[4], vp[4];
#pragma unroll
            for (int i = 0; i < 8; i += 2) {
                const float k0 = (1.f - __expf(bs[i] - prev)) * __expf(blast - bs[i]);
                const float k1 = (1.f - __expf(bs[i + 1] - bs[i])) * __expf(blast - bs[i + 1]);
                prev = bs[i + 1];
                kp[i >> 1] = pack2(k0, k1);
                vp[i >> 1] = vs[i] | (vs[i + 1] << 16);
            }
            *(uint4*)(KT + c * LD64 + 32 * half + 8 * g) = make_uint4(kp[0], kp[1], kp[2], kp[3]);
            *(uint4*)(VT + c * LD64 + 32 * half + 8 * g) = make_uint4(vp[0], vp[1], vp[2], vp[3]);
            bp += 8 * 512; vp_ += 8 * 512;
        }
    }
    __syncthreads();
    f32x4 acc[2][8];
#pragma unroll
    for (int mi = 0; mi < 2; ++mi)
#pragma unroll
        for (int n8 = 0; n8 < 8; ++n8) acc[mi][n8] = (f32x4){0.f, 0.f, 0.f, 0.f};
#pragma unroll
    for (int ks = 0; ks < 2; ++ks) {
        bf16x8 a[2];
#pragma unroll
        for (int mi = 0; mi < 2; ++mi) a[mi] = *(const bf16x8*)(VT + (32 * wid + 16 * mi + fr) * LD64 + 32 * ks + 8 * fq);
#pragma unroll
        for (int n8 = 0; n8 < 8; ++n8) {
            const bf16x8 bf = *(const bf16x8*)(KT + (16 * n8 + fr) * LD64 + 32 * ks + 8 * fq);
#pragma unroll
            for (int mi = 0; mi < 2; ++mi) acc[mi][n8] = __builtin_amdgcn_mfma_f32_16x16x32_bf16(a[mi], bf, acc[mi][n8], 0, 0, 0);
        }
    }
    bf16_t* dst = WS(bf16_t, OFF_DS) + (size_t)unit * 16384;
#pragma unroll
    for (int mi = 0; mi < 2; ++mi)
#pragma unroll
        for (int n8 = 0; n8 < 8; ++n8)
#pragma unroll
            for (int j = 0; j < 4; ++j) dst[(32 * wid + 16 * mi + 4 * fq + j) * 128 + 16 * n8 + fr] = f2bf(acc[mi][n8][j]);
    __syncthreads();
}

__device__ __forceinline__ void d_hgrn_scan(const P& p, int unit) {
    const int gid = unit * 256 + ltid();
    const int bh = gid >> 13, rem = gid & 8191, e = rem >> 6, d2 = (rem & 63) * 2;
    uint32_t* base = (uint32_t*)(WS(bf16_t, OFF_DS) + (size_t)bh * 64 * 16384 + e * 128 + d2);
    const float* bb = WS(float, OFF_LOGF) + ((size_t)(bh >> 2) * LP + 64 + 63) * 512 + (bh & 3) * 128 + d2;
    float s0 = 0.f, s1 = 0.f;
#pragma unroll 8
    for (int j = 0; j < 64; ++j) {
        const uint32_t x = base[(size_t)j * 8192];
        const float2 bl = *(const float2*)(bb + (size_t)j * 64 * 512);
        s0 = __expf(bl.x) * s0 + __uint_as_float(x << 16);
        s1 = __expf(bl.y) * s1 + __uint_as_float(x & 0xFFFF0000u);
        base[(size_t)j * 8192] = pack2(s0, s1);
    }
}

__device__ __forceinline__ void d_hgrn_C(const P& p, int unit, char* shm) {
    bf16_t* KS = (bf16_t*)shm;
    bf16_t* KD = KS + 64 * LD128;
    bf16_t* VT = KD + 64 * LD128;
    bf16_t* AM = VT + 128 * LD64;
    const int tid = ltid(), lane = tid & 63, fr = lane & 15, fq = lane >> 4;
    const int wi = __builtin_amdgcn_readfirstlane(tid >> 6);
    const int bh = unit >> 6, n = (unit & 63) + 2, b = bh >> 2, h = bh & 3;
    const size_t r0 = (size_t)b * LP + 64 * n;
    const size_t t0 = (size_t)b * SEQ + 64 * n - 128;
    {
        const int c = tid & 127, half = tid >> 7;
        const float* bb = WS(float, OFF_LOGF) + r0 * 512 + h * 128 + c;
        const bf16_t* vv = WS(bf16_t, OFF_RI) + r0 * 512 + h * 128 + c;
        float prev = half ? bb[31 * 512] : 0.f;
        const float* bp = bb + (size_t)(32 * half) * 512;
        const bf16_t* vp_ = vv + (size_t)(32 * half) * 512;
#pragma unroll 1
        for (int g = 0; g < 4; ++g) {
            const int s0 = 32 * half + 8 * g, sb = s0 & ~15;
            const float bend = bb[(size_t)(sb + 15) * 512];
            const float bref = (sb == 0) ? 0.f : bb[(size_t)(sb - 1) * 512];
            float bs[8]; uint32_t vs[8];
#pragma unroll
            for (int i = 0; i < 8; ++i) { bs[i] = bp[i * 512]; vs[i] = vp_[i * 512]; }
#pragma unroll
            for (int i = 0; i < 8; ++i) {
                const float k = 1.f - __expf(bs[i] - prev);
                prev = bs[i];
                KS[(s0 + i) * LD128 + c] = f2bf(k * __expf(bend - bs[i]));
                KD[(s0 + i) * LD128 + c] = f2bf(k * __expf(bref - bs[i]));
            }
            *(uint4*)(VT + c * LD64 + s0) = make_uint4(vs[0] | (vs[1] << 16), vs[2] | (vs[3] << 16), vs[4] | (vs[5] << 16), vs[6] | (vs[7] << 16));
            bp += 8 * 512; vp_ += 8 * 512;
        }
#pragma unroll
        for (int i = 0; i < 9; ++i) ((uint32_t*)AM)[tid + 256 * i] = 0u;
    }
    __syncthreads();
    const int tl = 16 * wi + fr;
    bf16x8 qf[4]; float bt[4][8];
    {
        const bf16_t* qrow = WS(bf16_t, OFF_RQ) + (r0 + tl) * 512 + h * 128 + 8 * fq;
        const float* brow = WS(float, OFF_LOGF) + (r0 + tl) * 512 + h * 128 + 8 * fq;
#pragma unroll
        for (int ks = 0; ks < 4; ++ks) {
            qf[ks] = *(const bf16x8*)(qrow + 32 * ks);
            const float4 x0 = *(const float4*)(brow + 32 * ks), x1 = *(const float4*)(brow + 32 * ks + 4);
            bt[ks][0] = x0.x; bt[ks][1] = x0.y; bt[ks][2] = x0.z; bt[ks][3] = x0.w; bt[ks][4] = x1.x; bt[ks][5] = x1.y; bt[ks][6] = x1.z; bt[ks][7] = x1.w;
        }
    }
    auto qfrag = [&](int ks, const float* refrow) -> bf16x8 {
        float rf[8];
        if (refrow) {
            const float4 x0 = *(const float4*)(refrow + 32 * ks), x1 = *(const float4*)(refrow + 32 * ks + 4);
            rf[0] = x0.x; rf[1] = x0.y; rf[2] = x0.z; rf[3] = x0.w; rf[4] = x1.x; rf[5] = x1.y; rf[6] = x1.z; rf[7] = x1.w;
        } else {
#pragma unroll
            for (int jj = 0; jj < 8; ++jj) rf[jj] = 0.f;
        }
        bf16x8 o;
#pragma unroll
        for (int jj = 0; jj < 8; ++jj) o[jj] = (short)f2bf(bf2f((bf16_t)qf[ks][jj]) * __expf(bt[ks][jj] - rf[jj]));
        return o;
    };
    const float* bchunk = WS(float, OFF_LOGF) + r0 * 512 + h * 128 + 8 * fq;
    f32x4 acc[8];
#pragma unroll
    for (int n8 = 0; n8 < 8; ++n8) acc[n8] = (f32x4){0.f, 0.f, 0.f, 0.f};
    {
        const bf16_t* sp = WS(bf16_t, OFF_DS) + (size_t)unit * 16384 + fr * 128 + 8 * fq;
#pragma unroll
        for (int ks = 0; ks < 4; ++ks) {
            const bf16x8 a = qfrag(ks, nullptr);
#pragma unroll
            for (int n8 = 0; n8 < 8; ++n8) {
                const bf16x8 bf = *(const bf16x8*)(sp + (size_t)n8 * 16 * 128 + 32 * ks);
                acc[n8] = __builtin_amdgcn_mfma_f32_16x16x32_bf16(a, bf, acc[n8], 0, 0, 0);
            }
        }
    }
    for (int j = 0; j < wi; ++j) {
        f32x4 c4 = (f32x4){0.f, 0.f, 0.f, 0.f};
        const float* refrow = bchunk + (size_t)(16 * j + 15) * 512;
#pragma unroll
        for (int ks = 0; ks < 4; ++ks) {
            const bf16x8 a = qfrag(ks, refrow);
            const bf16x8 bf = *(const bf16x8*)(KS + (16 * j + fr) * LD128 + 32 * ks + 8 * fq);
            c4 = __builtin_amdgcn_mfma_f32_16x16x32_bf16(a, bf, c4, 0, 0, 0);
        }
#pragma unroll
        for (int jj = 0; jj < 4; ++jj) AM[(16 * wi + 4 * fq + jj) * LD64 + 16 * j + fr] = f2bf(c4[jj]);
    }
    {
        f32x4 c4 = (f32x4){0.f, 0.f, 0.f, 0.f};
        const float* refrow = (wi > 0) ? (bchunk + (size_t)(16 * wi - 1) * 512) : nullptr;
#pragma unroll
        for (int ks = 0; ks < 4; ++ks) {
            const bf16x8 a = qfrag(ks, refrow);
            const bf16x8 bf = *(const bf16x8*)(KD + (16 * wi + fr) * LD128 + 32 * ks + 8 * fq);
            c4 = __builtin_amdgcn_mfma_f32_16x16x32_bf16(a, bf, c4, 0, 0, 0);
        }
#pragma unroll
        for (int jj = 0; jj < 4; ++jj) AM[(16 * wi + 4 * fq + jj) * LD64 + 16 * wi + fr] = f2bf((fr <= 4 * fq + jj) ? c4[jj] : 0.f);
    }
    __syncthreads();
#pragma unroll
    for (int ks = 0; ks < 2; ++ks) {
        const bf16x8 a = *(const bf16x8*)(AM + (16 * wi + fr) * LD64 + 32 * ks + 8 * fq);
#pragma unroll
        for (int n8 = 0; n8 < 8; ++n8) {
            const bf16x8 bf = *(const bf16x8*)(VT + (16 * n8 + fr) * LD64 + 32 * ks + 8 * fq);
            acc[n8] = __builtin_amdgcn_mfma_f32_16x16x32_bf16(a, bf, acc[n8], 0, 0, 0);
        }
    }
#pragma unroll
    for (int jj = 0; jj < 4; ++jj) {
        float ss = 0.f;
#pragma unroll
        for (int n8 = 0; n8 < 8; ++n8) ss += acc[n8][jj] * acc[n8][jj];
        ss += __shfl_xor(ss, 1); ss += __shfl_xor(ss, 2); ss += __shfl_xor(ss, 4); ss += __shfl_xor(ss, 8);
        const float rstd = rsqrtf(ss * (1.f / 128.f) + EPS);
        const int trow = 16 * wi + 4 * fq + jj;
#pragma unroll
        for (int n8 = 0; n8 < 8; ++n8) {
            const int e = 16 * n8 + fr;
            const float val = acc[n8][jj] * rstd * p.g_rec[h * 128 + e] * bf2f(WS(bf16_t, OFF_RG)[(r0 + trow) * 512 + h * 128 + e]);
            WS(bf16_t, OFF_REC)[(t0 + trow) * 512 + h * 128 + e] = f2bf(val);
        }
        asm volatile("" ::: "memory");
    }
    __syncthreads();
}

#if TOPK_SIMPLE
__device__ __forceinline__ void d_peer_topk_simple(const P& p, int unit) {
    const int t = (unit >> 3) * 256 + ltid(), h = unit & 7;
    const bf16_t* qp = WS(bf16_t, OFF_QRY) + (size_t)t * DM + h * 128;
    float tv[2][16]; int ti[2][16];
#pragma unroll
    for (int pp = 0; pp < 2; ++pp) {
        float q[64];
#pragma unroll
        for (int d = 0; d < 64; ++d) q[d] = bf2f(qp[pp * 64 + d]);
#pragma unroll
        for (int i = 0; i < 16; ++i) { tv[pp][i] = -3.0e38f; ti[pp][i] = 0; }
        const bf16_t* kp = WS(bf16_t, OFF_KEYS) + (size_t)(h * 2 + pp) * 128 * 64;
        for (int n = 0; n < 128; ++n) {
            float sc = 0.f;
#pragma unroll
            for (int d = 0; d < 64; ++d) sc += q[d] * bf2f(kp[n * 64 + d]);
            float xv = sc; int xi = n;
#pragma unroll
            for (int i = 0; i < 16; ++i) {
                if (xv > tv[pp][i]) { const float tf = tv[pp][i]; const int tn = ti[pp][i]; tv[pp][i] = xv; ti[pp][i] = xi; xv = tf; xi = tn; }
            }
        }
    }
    float bv[16]; int bi[16];
#pragma unroll
    for (int i = 0; i < 16; ++i) { bv[i] = -3.0e38f; bi[i] = 0; }
#pragma unroll
    for (int i = 0; i < 16; ++i)
#pragma unroll
        for (int j = 0; j < 16; ++j) {
            if ((i + 1) * (j + 1) <= 16) {
                float xv = tv[0][i] + tv[1][j]; int xi = ti[0][i] * 128 + ti[1][j];
#pragma unroll
                for (int k = 0; k < 16; ++k) {
                    if (xv > bv[k]) { const float tf = bv[k]; const int tn = bi[k]; bv[k] = xv; bi[k] = xi; xv = tf; xi = tn; }
                }
            }
        }
    float se = 0.f, ev[16];
#pragma unroll
    for (int k = 0; k < 16; ++k) { ev[k] = __expf(bv[k] - bv[0]); se += ev[k]; }
    const float inv = 1.f / se;
#pragma unroll
    for (int k = 0; k < 16; ++k) {
        WS(int, OFF_PIDX)[(size_t)t * 128 + h * 16 + k] = bi[k];
        WS(float, OFF_PGATE)[(size_t)t * 128 + h * 16 + k] = ev[k] * inv;
    }
}

#endif
template <int N> __device__ __forceinline__ void bitonic_sort_desc(float (&v)[N]) {
#pragma unroll
    for (int k = 2; k <= N; k <<= 1)
#pragma unroll
        for (int j = k >> 1; j > 0; j >>= 1)
#pragma unroll
            for (int i = 0; i < N; ++i) {
                const int l = i ^ j;
                if (l > i) {
                    const bool desc = ((i & k) == 0);
                    const float a = v[i], b = v[l];
                    const float hi = fmaxf(a, b), lo = fminf(a, b);
                    v[i] = desc ? hi : lo; v[l] = desc ? lo : hi;
                }
            }
}
template <int N> __device__ __forceinline__ void bitonic_merge_desc(float (&v)[N]) {
#pragma unroll
    for (int j = N >> 1; j > 0; j >>= 1)
#pragma unroll
        for (int i = 0; i < N; ++i) {
            const int l = i ^ j;
            if (l > i) { const float a = v[i], b = v[l]; v[i] = fmaxf(a, b); v[l] = fminf(a, b); }
        }
}
__device__ __forceinline__ void ph_peer_qry_topk(const P& p, char* shm) {
    const int tid = ltid(), wid = tid >> 6, lane = tid & 63, wr = wid >> 1, wc = wid & 1, fr = lane & 15, fq = lane >> 4;
    float* tops = (float*)shm;
    for (int q = blockIdx.x >> 3; q < T / 128; q += gridDim.x >> 3) {
        const int h = q & 7, t0 = (8 * (q >> 3) + (blockIdx.x & 7)) * 128;
        f32x4 acc[4][4]; zero_acc(acc);
        gemm_kloop(WS(bf16_t, OFF_WQ), 1024, WS(bf16_t, OFF_H2B), 1024, 1024, h * 128, t0, acc, shm);
        int tb = t0 + wc * 64 + fr;
        asm volatile("" : "+v"(tb));
        {
            const bf16_t* ksrc = WS(bf16_t, OFF_KEYS) + (size_t)h * 2 * 128 * 64;
#pragma unroll
            for (int i = 0; i < 8; ++i) {
                const int q = tid + 256 * i, r = q >> 3, c8 = q & 7;
                *(uint4*)(shm + 16384 + (r * 72 + c8 * 8) * 2) = *(const uint4*)(ksrc + (size_t)r * 64 + c8 * 8);
            }
        }
        __syncthreads();
        const bf16_t* kbase = (const bf16_t*)(shm + 16384) + (size_t)(wr * 128 + fr) * 72 + 4 * fq;
#pragma unroll
        for (int n = 0; n < 4; ++n) {
            const int t = tb + n * 16;
            const float rstd = row_rstd(p, t);
            if (wr == 0 && fq == 0 && h == 0) WS(float, OFF_RSTD)[t] = rstd;
            bf16x8 bq[2];
#pragma unroll
            for (int ks = 0; ks < 2; ++ks)
#pragma unroll
                for (int j = 0; j < 4; ++j) { bq[ks][j] = (short)f2bf(acc[2 * ks][n][j] * rstd); bq[ks][4 + j] = (short)f2bf(acc[2 * ks + 1][n][j] * rstd); }
            float v[32];
#pragma unroll
            for (int mk = 0; mk < 8; ++mk) {
                f32x4 c = (f32x4){0.f, 0.f, 0.f, 0.f};
#pragma unroll
                for (int ks = 0; ks < 2; ++ks) {
                    const uint2 a0 = *(const uint2*)(kbase + mk * 16 * 72 + 32 * ks);
                    const uint2 a1 = *(const uint2*)(kbase + mk * 16 * 72 + 32 * ks + 16);
                    union { uint4 q; bf16x8 v; } av; av.q = make_uint4(a0.x, a0.y, a1.x, a1.y);
                    c = __builtin_amdgcn_mfma_f32_16x16x32_bf16(av.v, bq[ks], c, 0, 0, 0);
                }
#pragma unroll
                for (int j = 0; j < 4; ++j) v[4 * mk + j] = __uint_as_float((__float_as_uint(c[j]) & ~0x7Fu) | (unsigned)(16 * mk + 4 * fq + j));
            }
            float m[16];
            {
                float h0[16], h1[16];
#pragma unroll
                for (int i = 0; i < 16; ++i) { h0[i] = v[i]; h1[i] = v[16 + i]; }
                bitonic_sort_desc<16>(h0); bitonic_sort_desc<16>(h1);
#pragma unroll
                for (int i = 0; i < 16; ++i) m[i] = fmaxf(h0[i], h1[15 - i]);
                bitonic_merge_desc<16>(m);
            }
#pragma unroll
            for (int off = 16; off <= 32; off <<= 1) {
                float o[16];
#pragma unroll
                for (int i = 0; i < 16; ++i) o[i] = __shfl_xor(m[i], off);
#pragma unroll
                for (int i = 0; i < 16; ++i) m[i] = fmaxf(m[i], o[15 - i]);
                bitonic_merge_desc<16>(m);
            }
            if (fq == 0) {
                float4* dst = (float4*)(tops + ((size_t)wr * 128 + wc * 64 + n * 16 + fr) * 16);
                dst[0] = make_float4(m[0], m[1], m[2], m[3]); dst[1] = make_float4(m[4], m[5], m[6], m[7]);
                dst[2] = make_float4(m[8], m[9], m[10], m[11]); dst[3] = make_float4(m[12], m[13], m[14], m[15]);
            }
        }
        __syncthreads();
        if (tid < 128) {
            const float* ta = tops + (size_t)tid * 16;
            const float* tbp = tops + (size_t)(128 + tid) * 16;
            float a[16], b[16];
#pragma unroll
            for (int i = 0; i < 16; ++i) { a[i] = __uint_as_float(__float_as_uint(ta[i]) & ~0x7Fu); b[i] = __uint_as_float(__float_as_uint(tbp[i]) & ~0x7Fu); }
            float cand[64];
            int k = 0;
#pragma unroll
            for (int i = 0; i < 16; ++i)
#pragma unroll
                for (int j = 0; j < 16; ++j)
                    if ((i + 1) * (j + 1) <= 16) { cand[k] = __uint_as_float((__float_as_uint(a[i] + b[j]) & ~0xFFu) | (unsigned)(i * 16 + j)); ++k; }
#pragma unroll
            for (int kk = 50; kk < 64; ++kk) cand[kk] = -3.0e38f;
            bitonic_sort_desc<64>(cand);
            float ev[16], se = 0.f; int ex[16];
            const float best = __uint_as_float(__float_as_uint(cand[0]) & ~0xFFu);
#pragma unroll
            for (int q = 0; q < 16; ++q) {
                const unsigned bits = __float_as_uint(cand[q]);
                const int ci = (bits >> 4) & 15, cj = bits & 15;
                const int ia = (int)(__float_as_uint(ta[ci]) & 0x7Fu), ib = (int)(__float_as_uint(tbp[cj]) & 0x7Fu);
                ex[q] = ia * 128 + ib;
                ev[q] = __expf(__uint_as_float(bits & ~0xFFu) - best); se += ev[q];
            }
            const float inv = 1.f / se;
            int4* pi = (int4*)(WS(int, OFF_PIDX) + (size_t)(t0 + tid) * 128 + h * 16);
            float4* pg = (float4*)(WS(float, OFF_PGATE) + (size_t)(t0 + tid) * 128 + h * 16);
#pragma unroll
            for (int q = 0; q < 4; ++q) {
                pi[q] = make_int4(ex[4 * q], ex[4 * q + 1], ex[4 * q + 2], ex[4 * q + 3]);
                pg[q] = make_float4(ev[4 * q] * inv, ev[4 * q + 1] * inv, ev[4 * q + 2] * inv, ev[4 * q + 3] * inv);
            }
        }
        __syncthreads();
    }
}

#if PEER_SIMPLE
__device__ __forceinline__ void d_peer_expert(const P& p, int t, char* shm) {
    float* act = (float*)shm;
    float* red = (float*)(shm + 512);
    const int tid = ltid(), wid = tid >> 6, lane = tid & 63;
    const float rstd = row_rstd(p, t);
    const float* h2 = WS(float, OFF_H2) + (size_t)t * DM;
    float xn[16];
#pragma unroll
    for (int i = 0; i < 4; ++i) {
        const float4 v = ((const float4*)h2)[lane * 4 + i];
        const float4 g = ((const float4*)p.g_ffn)[lane * 4 + i];
        xn[4 * i + 0] = v.x * rstd * g.x; xn[4 * i + 1] = v.y * rstd * g.y; xn[4 * i + 2] = v.z * rstd * g.z; xn[4 * i + 3] = v.w * rstd * g.w;
    }
    const int* idx = WS(int, OFF_PIDX) + (size_t)t * 128;
    const float* gate = WS(float, OFF_PGATE) + (size_t)t * 128;
    const bf16_t* edn = WS(bf16_t, OFF_EDN);
    const bf16_t* eup = WS(bf16_t, OFF_EUP);
    for (int e = wid; e < 128; e += 4) {
        const bf16_t* row = edn + (size_t)idx[e] * DM + lane * 16;
        const uint4 a = ((const uint4*)row)[0], c = ((const uint4*)row)[1];
        const uint32_t w[8] = {a.x, a.y, a.z, a.w, c.x, c.y, c.z, c.w};
        float s = 0.f;
#pragma unroll
        for (int i = 0; i < 8; ++i) s += xn[2 * i] * __uint_as_float(w[i] << 16) + xn[2 * i + 1] * __uint_as_float(w[i] & 0xFFFF0000u);
        s = wave_sum(s);
        if (lane == 0) act[e] = 0.5f * s * (1.f + erff(s * 0.70710678118654752f)) * gate[e];
    }
    __syncthreads();
    float y0 = 0.f, y1 = 0.f, y2 = 0.f, y3 = 0.f;
    for (int e = 0; e < 128; ++e) {
        const float a = act[e];
        const uint2 w = *(const uint2*)(eup + (size_t)idx[e] * DM + tid * 4);
        y0 += a * __uint_as_float(w.x << 16); y1 += a * __uint_as_float(w.x & 0xFFFF0000u);
        y2 += a * __uint_as_float(w.y << 16); y3 += a * __uint_as_float(w.y & 0xFFFF0000u);
    }
    const float4 hv = ((const float4*)h2)[tid];
    const float o0 = hv.x + y0, o1 = hv.y + y1, o2 = hv.z + y2, o3 = hv.w + y3;
    float ss = wave_sum(o0 * o0 + o1 * o1 + o2 * o2 + o3 * o3);
    if (lane == 0) red[wid] = ss;
    __syncthreads();
    ss = red[0] + red[1] + red[2] + red[3];
    const float rs = rsqrtf(ss * (1.f / DM) + EPS);
    const float4 g = ((const float4*)p.g_fin)[tid];
    float4 ov; ov.x = o0 * rs * g.x; ov.y = o1 * rs * g.y; ov.z = o2 * rs * g.z; ov.w = o3 * rs * g.w;
    ((float4*)(p.out + (size_t)t * DM))[tid] = ov;
    __syncthreads();
}

#endif
__device__ __forceinline__ float* part_ptr(const P& p, int c) {
    return WS(float, OFF_PART) + (size_t)c * T * 128;
}
__device__ __forceinline__ unsigned xcc_id() { return (unsigned)__builtin_amdgcn_s_getreg((3 << 11) | 20) & 7u; }

#define MEMFENCE() asm volatile("" ::: "memory")
typedef float f32x2_t __attribute__((ext_vector_type(2)));
__device__ __forceinline__ float dpp_xor1(float v) { return __builtin_amdgcn_update_dpp(0.f, v, 0xB1, 0xF, 0xF, false); }
__device__ __forceinline__ float dpp_xor2(float v) { return __builtin_amdgcn_update_dpp(0.f, v, 0x4E, 0xF, 0xF, false); }
__device__ __forceinline__ float swz_xor4(float v) { return __int_as_float(__builtin_amdgcn_ds_swizzle(__float_as_int(v), 0x101F)); }
__device__ __forceinline__ float gelu_as(float v) {
    const float av = fabsf(v), t = __builtin_amdgcn_rcpf(av * 0.2316418882f + 1.0f);
    float q = t * 0.5307027145f + (-0.7265760135f); q = q * t + 0.7107068705f; q = q * t + (-0.142248368f); q = q * t + 0.127414796f; q = q * t;
    const float m = v * (q * __builtin_amdgcn_exp2f((v * v) * (-0.72134752044f)));
    return v < 0.f ? m : v - m;
}
__device__ __forceinline__ float group8_transpose_sum(const float (&s)[8], int ch) {
    const bool b0 = ch & 1, b1 = (ch >> 1) & 1, b2 = (ch >> 2) & 1;
    float r4[4], r2[2];
#pragma unroll
    for (int j = 0; j < 4; ++j) { const float keep = b0 ? s[2 * j + 1] : s[2 * j], send = b0 ? s[2 * j] : s[2 * j + 1]; r4[j] = keep + dpp_xor1(send); }
#pragma unroll
    for (int j = 0; j < 2; ++j) { const float keep = b1 ? r4[2 * j + 1] : r4[2 * j], send = b1 ? r4[2 * j] : r4[2 * j + 1]; r2[j] = keep + dpp_xor2(send); }
    const float keep = b2 ? r2[1] : r2[0], send = b2 ? r2[0] : r2[1];
    return keep + swz_xor4(send);
}
constexpr int PEER_TILE = 128;
constexpr int PEER_WTOK = PEER_TILE / 4;
__device__ __forceinline__ void d_peer_e1_run(const P& p, int t0, int c, int lane) {
    const int g8 = lane >> 3, ch = lane & 7;
    const unsigned char* tab = WS(unsigned char, OFF_EDN);
    const unsigned loff = 128u * (unsigned)c + 16u * (unsigned)ch;
    float4 gf[4];
#pragma unroll
    for (int q = 0; q < 4; ++q) gf[q] = *(const float4*)(p.g_ffn + 128 * c + 16 * ch + 4 * q);
    const int4* ip = (const int4*)(WS(int, OFF_PIDX) + (size_t)t0 * 128 + 16 * g8);
    int4 nidx[4];
#pragma unroll
    for (int k = 0; k < 4; ++k) nidx[k] = ip[k];
#pragma unroll 1
    for (int tk = 0; tk < PEER_WTOK; ++tk) {
        const int t = t0 + tk;
        const unsigned idx[16] = {(unsigned)nidx[0].x, (unsigned)nidx[0].y, (unsigned)nidx[0].z, (unsigned)nidx[0].w, (unsigned)nidx[1].x, (unsigned)nidx[1].y, (unsigned)nidx[1].z, (unsigned)nidx[1].w,
                                  (unsigned)nidx[2].x, (unsigned)nidx[2].y, (unsigned)nidx[2].z, (unsigned)nidx[2].w, (unsigned)nidx[3].x, (unsigned)nidx[3].y, (unsigned)nidx[3].z, (unsigned)nidx[3].w};
        uint4 w[16];
#pragma unroll
        for (int k = 0; k < 16; ++k) w[k] = *(const uint4*)(tab + (idx[k] * 1024u + loff));
        const bf16_t* hp = WS(bf16_t, OFF_H2B) + (size_t)t * DM + 128 * c + 16 * ch;
        const uint4 h0 = *(const uint4*)hp, h1 = *(const uint4*)(hp + 8);
        const float rstd = WS(float, OFF_RSTD)[t];
        if (tk + 1 < PEER_WTOK) {
#pragma unroll
            for (int k = 0; k < 4; ++k) nidx[k] = ip[(tk + 1) * 32 + k];
        }
        MEMFENCE();
        f32x2_t x[8];
        {
            const uint32_t hw[8] = {h0.x, h0.y, h0.z, h0.w, h1.x, h1.y, h1.z, h1.w};
#pragma unroll
            for (int q = 0; q < 4; ++q) {
                x[2 * q] = (f32x2_t){__uint_as_float(hw[2 * q] << 16) * rstd * gf[q].x, __uint_as_float(hw[2 * q] & 0xFFFF0000u) * rstd * gf[q].y};
                x[2 * q + 1] = (f32x2_t){__uint_as_float(hw[2 * q + 1] << 16) * rstd * gf[q].z, __uint_as_float(hw[2 * q + 1] & 0xFFFF0000u) * rstd * gf[q].w};
            }
        }
        float res[2];
#pragma unroll
        for (int hh = 0; hh < 2; ++hh) {
            float s[8];
#pragma unroll
            for (int k = 0; k < 8; ++k) {
                const uint4 wk = w[8 * hh + k];
                f32x2_t a2 = __builtin_amdgcn_cvt_pk_f32_fp8((int)wk.x, false) * x[0];
                a2 = __builtin_elementwise_fma(__builtin_amdgcn_cvt_pk_f32_fp8((int)wk.x, true), x[1], a2);
                a2 = __builtin_elementwise_fma(__builtin_amdgcn_cvt_pk_f32_fp8((int)wk.y, false), x[2], a2);
                a2 = __builtin_elementwise_fma(__builtin_amdgcn_cvt_pk_f32_fp8((int)wk.y, true), x[3], a2);
                a2 = __builtin_elementwise_fma(__builtin_amdgcn_cvt_pk_f32_fp8((int)wk.z, false), x[4], a2);
                a2 = __builtin_elementwise_fma(__builtin_amdgcn_cvt_pk_f32_fp8((int)wk.z, true), x[5], a2);
                a2 = __builtin_elementwise_fma(__builtin_amdgcn_cvt_pk_f32_fp8((int)wk.w, false), x[6], a2);
                a2 = __builtin_elementwise_fma(__builtin_amdgcn_cvt_pk_f32_fp8((int)wk.w, true), x[7], a2);
                s[k] = a2[0] + a2[1];
            }
            res[hh] = group8_transpose_sum(s, ch);
        }
        float* pp = part_ptr(p, c) + (size_t)t * 128 + 16 * g8 + ch;
        pp[0] = res[0]; pp[8] = res[1];
    }
}

__device__ __forceinline__ void d_peer_act(const P& p, int vblk, int nvblk) {
    const int lane = ltid() & 63, wv = ltid() >> 6;
    for (int t = vblk * 4 + wv; t < T; t += nvblk * 4) {
        float pu[2][8], gt[2];
#pragma unroll
        for (int k = 0; k < 2; ++k) {
#pragma unroll
            for (int cc = 0; cc < 8; ++cc) pu[k][cc] = part_ptr(p, cc)[(size_t)t * 128 + lane + 64 * k];
            gt[k] = WS(float, OFF_PGATE)[(size_t)t * 128 + lane + 64 * k];
        }
#pragma unroll
        for (int k = 0; k < 2; ++k) {
            const float u = (((pu[k][0] + pu[k][1]) + (pu[k][2] + pu[k][3])) + ((pu[k][4] + pu[k][5]) + (pu[k][6] + pu[k][7]))) * (1.f / 64.f);
            WS(float, OFF_ACT)[(size_t)t * 128 + lane + 64 * k] = gelu_as(u) * gt[k] * 0.125f;
        }
    }
}

__device__ __forceinline__ void d_peer_e2_run(const P& p, int t0, int c, int lane, float* sact) {
    const int g8 = lane >> 3, ch = lane & 7;
    const unsigned char* tab = WS(unsigned char, OFF_EUP);
    const unsigned loff = 128u * (unsigned)c + 16u * (unsigned)ch;
    const bool b3 = (lane >> 3) & 1, b4 = (lane >> 4) & 1, b5 = (lane >> 5) & 1;
    const int col = 128 * c + 16 * ch + 8 * (int)b3 + 4 * (int)b4 + 2 * (int)b5;
    const int4* ip = (const int4*)(WS(int, OFF_PIDX) + (size_t)t0 * 128 + 16 * g8);
    const float4* ap = (const float4*)(WS(float, OFF_ACT) + (size_t)t0 * 128 + 16 * g8);
    int4 nidx[4]; float4 nact[4];
#pragma unroll
    for (int k = 0; k < 4; ++k) { nidx[k] = ip[k]; nact[k] = ap[k]; }
#pragma unroll 1
    for (int tk = 0; tk < PEER_WTOK; ++tk) {
        const int t = t0 + tk;
        const unsigned idx[16] = {(unsigned)nidx[0].x, (unsigned)nidx[0].y, (unsigned)nidx[0].z, (unsigned)nidx[0].w, (unsigned)nidx[1].x, (unsigned)nidx[1].y, (unsigned)nidx[1].z, (unsigned)nidx[1].w,
                                  (unsigned)nidx[2].x, (unsigned)nidx[2].y, (unsigned)nidx[2].z, (unsigned)nidx[2].w, (unsigned)nidx[3].x, (unsigned)nidx[3].y, (unsigned)nidx[3].z, (unsigned)nidx[3].w};
        const float a[16] = {nact[0].x, nact[0].y, nact[0].z, nact[0].w, nact[1].x, nact[1].y, nact[1].z, nact[1].w, nact[2].x, nact[2].y, nact[2].z, nact[2].w, nact[3].x, nact[3].y, nact[3].z, nact[3].w};
        uint4 w[16];
#pragma unroll
        for (int k = 0; k < 16; ++k) w[k] = *(const uint4*)(tab + (idx[k] * 1024u + loff));
        const uint32_t hb = *(const uint32_t*)(WS(bf16_t, OFF_H2B) + (size_t)t * DM + col);
        if (tk + 1 < PEER_WTOK) {
#pragma unroll
            for (int k = 0; k < 4; ++k) { nidx[k] = ip[(tk + 1) * 32 + k]; nact[k] = ap[(tk + 1) * 32 + k]; }
        }
        MEMFENCE();
        f32x2_t y[8];
#pragma unroll
        for (int k = 0; k < 8; ++k) y[k] = (f32x2_t){0.f, 0.f};
#pragma unroll
        for (int k = 0; k < 16; ++k) {
            const f32x2_t av = (f32x2_t){a[k], a[k]};
            const uint4 wk = w[k];
            y[0] = __builtin_elementwise_fma(__builtin_amdgcn_cvt_pk_f32_fp8((int)wk.x, false), av, y[0]);
            y[1] = __builtin_elementwise_fma(__builtin_amdgcn_cvt_pk_f32_fp8((int)wk.x, true), av, y[1]);
            y[2] = __builtin_elementwise_fma(__builtin_amdgcn_cvt_pk_f32_fp8((int)wk.y, false), av, y[2]);
            y[3] = __builtin_elementwise_fma(__builtin_amdgcn_cvt_pk_f32_fp8((int)wk.y, true), av, y[3]);
            y[4] = __builtin_elementwise_fma(__builtin_amdgcn_cvt_pk_f32_fp8((int)wk.z, false), av, y[4]);
            y[5] = __builtin_elementwise_fma(__builtin_amdgcn_cvt_pk_f32_fp8((int)wk.z, true), av, y[5]);
            y[6] = __builtin_elementwise_fma(__builtin_amdgcn_cvt_pk_f32_fp8((int)wk.w, false), av, y[6]);
            y[7] = __builtin_elementwise_fma(__builtin_amdgcn_cvt_pk_f32_fp8((int)wk.w, true), av, y[7]);
        }
        f32x2_t k4[4], k2[2], k1;
#pragma unroll
        for (int k = 0; k < 4; ++k) {
            const f32x2_t keep = b3 ? y[4 + k] : y[k], send = b3 ? y[k] : y[4 + k];
            k4[k] = keep + (f32x2_t){__shfl_xor(send[0], 8), __shfl_xor(send[1], 8)};
        }
#pragma unroll
        for (int k = 0; k < 2; ++k) {
            const f32x2_t keep = b4 ? k4[2 + k] : k4[k], send = b4 ? k4[k] : k4[2 + k];
            k2[k] = keep + (f32x2_t){__shfl_xor(send[0], 16), __shfl_xor(send[1], 16)};
        }
        {
            const f32x2_t keep = b5 ? k2[1] : k2[0], send = b5 ? k2[0] : k2[1];
            k1 = keep + (f32x2_t){__shfl_xor(send[0], 32), __shfl_xor(send[1], 32)};
        }
        float2 o;
        o.x = __uint_as_float(hb << 16) + k1[0]; o.y = __uint_as_float(hb & 0xFFFF0000u) + k1[1];
        *(float2*)(p.out + (size_t)t * DM + col) = o;
        float ss = row_sum16(o.x * o.x + o.y * o.y);
        ss += __shfl_xor(ss, 16); ss += __shfl_xor(ss, 32);
        if (lane == 0) WS(float, OFF_SSQ2)[(size_t)c * T + t] = ss;
    }
}

template <int PHASE> __device__ __forceinline__ void ph_peer_sliced(const P& p, char* shm, int rep) {
    int* s_tile = (int*)shm;
    float* sact = (float*)(shm + 64) + (ltid() >> 6) * 128;
    const int tid = ltid(), lane = tid & 63, wid = tid >> 6;
    unsigned* qc = WS(unsigned, OFF_QCNT) + (PHASE == 2 ? 8 : 0) + 16 * rep;
    const unsigned x0 = xcc_id();
    for (int dc = 0; dc < 8; ++dc) {
        const int c = (int)((x0 + dc) & 7u);
        __syncthreads();
        if (tid == 0) *s_tile = (int)atomicAdd(&qc[c], 1u);
        __syncthreads();
        int tile = *s_tile;
        while (tile < T / PEER_TILE) {
            __syncthreads();
            int nxt = 0;
            if (tid == 0) nxt = (int)atomicAdd(&qc[c], 1u);
            const int t0 = tile * PEER_TILE + wid * PEER_WTOK;
            if (PHASE == 1) d_peer_e1_run(p, t0, c, lane); else d_peer_e2_run(p, t0, c, lane, sact);
            if (tid == 0) *s_tile = nxt;
            __syncthreads();
            tile = *s_tile;
        }
    }
}

__device__ __forceinline__ void d_peer_e3(const P& p, int t) {
    const int tid = ltid();
    float s = 0.f;
#pragma unroll
    for (int c = 0; c < 8; ++c) s += WS(float, OFF_SSQ2)[(size_t)c * T + t];
    const float rs = rsqrtf(s * (1.f / DM) + EPS);
    float4* op = (float4*)(p.out + (size_t)t * DM) + tid;
    const float4 g = ((const float4*)p.g_fin)[tid];
    float4 v = *op;
    v.x *= rs * g.x; v.y *= rs * g.y; v.z *= rs * g.z; v.w *= rs * g.w;
    *op = v;
}

#define XB_TMO      128
#define XB_XCNT(j)  (256  + 64 * (j))
#define XB_XSUB(j)  (1280 + 64 * (j))
#define XB_XGEN(j)  (2304 + 64 * (j))
#define XB_TOP      3328
#define XB_TOPGEN   3392
#define XCD_BAR_WORDS 3456
#define XB_SPIN_CAP (1u << 22)
#define LAS __attribute__((address_space(3)))
__device__ __forceinline__ unsigned xb_ld(unsigned* p) { return __hip_atomic_load(p, __ATOMIC_RELAXED, __HIP_MEMORY_SCOPE_AGENT); }
__device__ __forceinline__ unsigned xb_add(unsigned* p, unsigned v) { return __hip_atomic_fetch_add(p, v, __ATOMIC_RELAXED, __HIP_MEMORY_SCOPE_AGENT); }
__device__ __forceinline__ unsigned xb_xcc_id() { return (unsigned)__builtin_amdgcn_s_getreg((3 << 11) | 20) & 0xFu; }
#define XB_SPIN(cond, bar) do { unsigned _sp = 0; while (cond) { __builtin_amdgcn_s_sleep(1); \
    if ((++_sp & 255u) == 0u) { if (xb_ld(&(bar)[XB_TMO])) break; if (_sp > XB_SPIN_CAP) { atomicAdd(&(bar)[XB_TMO], 1u); break; } } } } while (0)
struct XcdBarrier { unsigned* bar; unsigned x; volatile LAS unsigned* st; };
__device__ __forceinline__ XcdBarrier xcd_barrier_post(unsigned* bar, volatile LAS unsigned* st) {
    XcdBarrier b; b.bar = bar; b.x = xb_xcc_id(); b.st = st;
    if (threadIdx.x == 0) (void)xb_add(&bar[XB_XCNT(b.x)], 1u);
    return b;
}
__device__ __forceinline__ void xcd_barrier_complete(unsigned* bar, unsigned x, unsigned& nloc, unsigned& nx) {
    const unsigned G = gridDim.x * gridDim.y * gridDim.z;
    unsigned sum, cnt, mine, sp = 0u;
    for (;;) {
        sum = 0u; cnt = 0u; mine = 0u;
#pragma unroll
        for (unsigned j = 0; j < 16; ++j) { const unsigned c = xb_ld(&bar[XB_XCNT(j)]); sum += c; cnt += (c > 0u) ? 1u : 0u; mine = (j == x) ? c : mine; }
        if (sum == G) break;
        __builtin_amdgcn_s_sleep(1);
        if ((++sp & 255u) == 0u) { if (xb_ld(&bar[XB_TMO])) break; if (sp > XB_SPIN_CAP) { atomicAdd(&bar[XB_TMO], 1u); break; } }
    }
    nloc = mine > 0u ? mine : 1u; nx = cnt > 0u ? cnt : 1u;
}
__device__ __forceinline__ void xcd_barrier(const XcdBarrier& b) {
    asm volatile("s_waitcnt vmcnt(0)" ::: "memory");
    __syncthreads();
    if (threadIdx.x == 0) {
        unsigned* bar = b.bar;
        __builtin_amdgcn_s_waitcnt(0);
        unsigned nloc = b.st[0], nx = b.st[1];
        if (nloc == 0u) { xcd_barrier_complete(bar, b.x, nloc, nx); b.st[0] = nloc; b.st[1] = nx; }
        const unsigned old = xb_add(&bar[XB_XSUB(b.x)], 1u);
        const unsigned gen = old / nloc;
        if (old + 1u == (gen + 1u) * nloc) {
            __builtin_amdgcn_fence(__ATOMIC_RELEASE, "agent");
            asm volatile("s_waitcnt vmcnt(0)" ::: "memory");
            const unsigned og = xb_add(&bar[XB_TOP], 1u);
            const unsigned tg = og / nx;
            if (og + 1u == (tg + 1u) * nx) xb_add(&bar[XB_TOPGEN], 1u);
            else XB_SPIN(xb_ld(&bar[XB_TOPGEN]) == tg, bar);
            __builtin_amdgcn_fence(__ATOMIC_ACQUIRE, "agent");
            xb_add(&bar[XB_XGEN(b.x)], 1u);
            asm volatile("s_waitcnt vmcnt(0)" ::: "memory");
        } else {
            XB_SPIN(xb_ld(&bar[XB_XGEN(b.x)]) == gen, bar);
            __builtin_amdgcn_fence(__ATOMIC_ACQUIRE, "agent");
            asm volatile("s_waitcnt vmcnt(0)" ::: "memory");
        }
    }
    __syncthreads();
}

#define REP_P0 1
#define REP_P1 1
#define REP_P2 1
#define REP_P2C 1
#define REP_P3 1
#define REP_P4G 1
#define REP_P4C 1
#define REP_P5 1
#define REP_P6 1
#define REP_P9 1
#define REP_E1 1
#define REP_E2 1
#define REPEAT(N) for (int rep_ = 0; rep_ < (N); ++rep_)
constexpr int SHM_BYTES = 65536;
__global__ void __launch_bounds__(256, 2) mega(P p) {
    __shared__ __attribute__((aligned(16))) char shm[SHM_BYTES + 16];
    const int G = gridDim.x, bid = blockIdx.x;
    volatile LAS unsigned* xst = (volatile LAS unsigned*)(shm + SHM_BYTES);
    if (threadIdx.x == 0) { xst[0] = 0u; xst[1] = 0u; }
    __syncthreads();
    const XcdBarrier xb = xcd_barrier_post(WS(unsigned, OFF_BAR), xst);

    {
        constexpr int U_WIN = (NIN / 32) * 32, U_WUA = 32 * 16, U_WUR = 32 * 16, U_WOUT = 32 * 32, U_WQ = 32 * 32, U_KEYS = 32, U_MISC = (LP * 8 + 255) / 256;
        constexpr int E0 = U_WIN, E1 = E0 + U_WUA, E2 = E1 + U_WUR, E3 = E2 + U_WOUT, E4 = E3 + U_WQ, E5 = E4 + U_KEYS, E6 = E5 + U_MISC, E7 = E6 + R / 4;
        if (bid == 0 && threadIdx.x < 64) WS(unsigned, OFF_QCNT)[threadIdx.x] = 0u;
        REPEAT(REP_P0)
        for (int u = bid; u < E7; u += G) {
            if (u < E0) d_transpose(p.w_in, WS(bf16_t, OFF_WIN), 1024, NIN, nullptr, u, shm);
            else if (u < E1) d_transpose(p.w_ua, WS(bf16_t, OFF_WUA), 512, 1024, nullptr, u - E0, shm);
            else if (u < E2) d_transpose(p.w_ur, WS(bf16_t, OFF_WUR), 512, 1024, nullptr, u - E1, shm);
            else if (u < E3) d_transpose(p.w_out, WS(bf16_t, OFF_WOUT), 1024, 1024, nullptr, u - E2, shm);
            else if (u < E4) d_transpose(p.w_q, WS(bf16_t, OFF_WQ), 1024, 1024, p.g_ffn, u - E3, shm);
            else if (u < E5) d_cvt(p.keys, WS(bf16_t, OFF_KEYS), (size_t)16 * 128 * 64 / 4, u - E4, U_KEYS);
            else if (u < E6) d_misc(p, u - E5);
            else d_rmsnorm_in(p, u - E6);
        }
    }
    xcd_barrier(xb);
    REPEAT(REP_P1) ph_gemm_inproj(p, shm);
    xcd_barrier(xb);
    REPEAT(REP_P2)
    for (int u = bid; u < 2048; u += G) { if (u < 1024) d_hgrn_A(p, u, shm); else d_attn(p, u - 1024, shm); }
    xcd_barrier(xb);
    for (int u = bid; u < 512; u += G) d_hgrn_scan(p, u);
    xcd_barrier(xb);
    REPEAT(REP_P2C)
    for (int u = bid; u < 1024; u += G) d_hgrn_C(p, u, shm);
    xcd_barrier(xb);
    REPEAT(REP_P3) ph_gemm_merge(p, shm);
    xcd_barrier(xb);
    REPEAT(REP_P4G) ph_gemm_out(p, shm);
    REPEAT(REP_P4C) {
    d_cvt8(p.edown, WS(unsigned char, OFF_EDN), (size_t)16384 * 1024 / 16, 64.f, bid, G);
    d_cvt8(p.eup, WS(unsigned char, OFF_EUP), (size_t)16384 * 1024 / 16, 8.f, bid, G); }
    xcd_barrier(xb);
    REPEAT(REP_P5) ph_peer_qry_topk(p, shm);
    xcd_barrier(xb);
    REPEAT(REP_E1) ph_peer_sliced<1>(p, shm, rep_);
    xcd_barrier(xb);
    d_peer_act(p, bid, G);
    xcd_barrier(xb);
    REPEAT(REP_E2) ph_peer_sliced<2>(p, shm, rep_);
    xcd_barrier(xb);
    REPEAT(REP_P9)
    for (int t = bid; t < T; t += G) d_peer_e3(p, t);
}

extern "C" void kernel_launch(void* const* d_in, const int* in_sizes, int n_in, void* d_out, int out_size, void* d_ws, size_t ws_size, hipStream_t stream) {
    P p{};
    p.x = (const float*)d_in[0]; p.meta = (const float*)d_in[1]; p.g_mix = (const float*)d_in[2]; p.w_in = (const float*)d_in[3];
    p.b_in = (const float*)d_in[4]; p.sinks = (const float*)d_in[5]; p.lb_logits = (const float*)d_in[6]; p.g_rec = (const float*)d_in[7];
    p.w_ua = (const float*)d_in[8]; p.w_ur = (const float*)d_in[9]; p.w_out = (const float*)d_in[10]; p.g_ffn = (const float*)d_in[11];
    p.w_q = (const float*)d_in[12]; p.keys = (const float*)d_in[13]; p.edown = (const float*)d_in[14]; p.eup = (const float*)d_in[15];
    p.g_fin = (const float*)d_in[16];
    p.out = (float*)d_out; p.ws = (char*)d_ws;
    static int grid_blocks = 0;
    if (!grid_blocks) {
        int dev = 0, cus = 0, per_cu = 0;
        (void)hipGetDevice(&dev);
        (void)hipDeviceGetAttribute(&cus, hipDeviceAttributeMultiprocessorCount, dev);
        (void)hipOccupancyMaxActiveBlocksPerMultiprocessor(&per_cu, mega, 256, 0);
        if (per_cu > 2) per_cu = 2;
        if (per_cu < 1) per_cu = 1;
        grid_blocks = cus * per_cu;
    }
    (void)hipMemsetAsync((char*)d_ws + OFF_BAR, 0, XCD_BAR_WORDS * 4, stream);
    void* args[] = {&p};
    hipError_t e = hipLaunchCooperativeKernel((void*)mega, dim3(grid_blocks), dim3(256), args, 0, stream);
    if (e != hipSuccess) fprintf(stderr, "cooperative launch failed: %s (grid %d)\n", hipGetErrorString(e), grid_blocks);
}
```

```cpp
#include <hip/hip_runtime.h>
#include <hip/hip_cooperative_groups.h>
#include <stdint.h>
#include <stdio.h>
namespace cg = cooperative_groups;

typedef unsigned short bf16_t;
typedef short bf16x8 __attribute__((ext_vector_type(8)));
typedef float f32x4 __attribute__((ext_vector_type(4)));

constexpr int NB = 4, SEQ = 4096, DM = 1024, LP = 4224, PADF = 112;
constexpr int R = NB * LP;
constexpr int T = NB * SEQ;
constexpr int NIN = 4864;
constexpr float EPS = 1e-6f;

constexpr size_t MiB = 1024 * 1024;
constexpr size_t OFF_WUA = 0;
constexpr size_t OFF_WUR = 1 * MiB;
constexpr size_t OFF_WOUT = 2 * MiB;
constexpr size_t OFF_WQ = 4 * MiB;
constexpr size_t OFF_KEYS = 6 * MiB;
constexpr size_t OFF_ROPE = 6 * MiB + 256 * 1024;
constexpr size_t OFF_LB = OFF_ROPE + 272 * 1024;
constexpr size_t OFF_SSQ = 7 * MiB;
constexpr size_t OFF_B = 8 * MiB;
constexpr size_t OFF_QB = OFF_B;
constexpr size_t OFF_KB = OFF_QB + (size_t)R * 512 * 2;
constexpr size_t OFF_VB = OFF_KB + (size_t)R * 128 * 2;
constexpr size_t OFF_RQ = OFF_VB + (size_t)R * 128 * 2;
constexpr size_t OFF_LOGF = OFF_RQ + (size_t)R * 512 * 2;
constexpr size_t OFF_RI = OFF_LOGF + (size_t)R * 512 * 4;
constexpr size_t OFF_RG = OFF_RI + (size_t)R * 512 * 2;
constexpr size_t OFF_GA = OFF_RG + (size_t)R * 512 * 2;
constexpr size_t OFF_GR = OFF_GA + (size_t)R * 1024 * 2;
constexpr size_t OFF_C = OFF_GR + (size_t)R * 1024 * 2;
constexpr size_t OFF_XN = OFF_C;
constexpr size_t OFF_WIN = OFF_XN + (size_t)R * 1024 * 2;
constexpr size_t OFF_TAIL = OFF_WIN + (size_t)NIN * 1024 * 2;
constexpr size_t OFF_DS = OFF_TAIL;
constexpr size_t OFF_ATT = OFF_GA;
constexpr size_t OFF_REC = OFF_ATT + (size_t)T * 512 * 2;
constexpr size_t OFF_MRG = OFF_LOGF;
constexpr size_t OFF_H2B = OFF_RI;
constexpr size_t OFF_EDN = OFF_C;
constexpr size_t OFF_EUP = OFF_EDN + (size_t)16384 * 1024;
constexpr size_t OFF_QRY = OFF_QB;
constexpr size_t OFF_PIDX = OFF_MRG;
constexpr size_t OFF_PGATE = OFF_PIDX + (size_t)T * 128 * 4;
constexpr size_t OFF_RSTD = OFF_LB + 4096;
constexpr size_t OFF_BAR = 6 * MiB + 640 * 1024;
constexpr size_t OFF_QCNT = OFF_LB + 2048;
constexpr size_t OFF_PART = OFF_GA;
constexpr size_t OFF_ACT = OFF_QB + 1 * MiB;
constexpr size_t OFF_SSQ2 = OFF_QB;
static_assert(OFF_SSQ2 + (size_t)8 * T * 4 <= OFF_ACT && OFF_ACT + (size_t)T * 128 * 4 <= OFF_LOGF, "ssq2/act overlay");
static_assert(OFF_PART + 8 * (size_t)T * 128 * 4 <= OFF_C, "part overlay");
static_assert(OFF_QCNT + 256 <= OFF_RSTD && OFF_RSTD + (size_t)T * 4 <= OFF_BAR && OFF_BAR + 3456 * 4 <= OFF_SSQ, "qcnt/rstd/bar");
static_assert(OFF_EUP + (size_t)16384 * 1024 * 2 <= 256 * MiB, "ws overflow");
static_assert(OFF_DS + (size_t)16 * 64 * 16384 * 2 <= 256 * MiB, "ws overflow");
static_assert(OFF_REC + (size_t)T * 512 * 2 <= OFF_C, "overlay");
static_assert(OFF_QRY + (size_t)T * 1024 * 2 <= OFF_LOGF, "qry overlay");
static_assert(OFF_PGATE + (size_t)T * 128 * 4 <= OFF_RI, "pidx overlay");

struct P {
    const float *x, *meta, *g_mix, *w_in, *b_in, *sinks, *lb_logits, *g_rec, *w_ua, *w_ur, *w_out, *g_ffn, *w_q, *keys, *edown, *eup, *g_fin;
    float* out;
    char* ws;
};
#define WS(type, off) ((type*)(p.ws + (off)))

__device__ __forceinline__ int ltid() { int t = threadIdx.x; asm volatile("" : "+v"(t)); return t; }
typedef __bf16 bf16pair_t __attribute__((ext_vector_type(2)));
typedef float f32pair_t __attribute__((ext_vector_type(2)));
__device__ __forceinline__ uint32_t pack2(float lo, float hi) {
    union { bf16pair_t b; uint32_t u; } r; r.b = __builtin_convertvector((f32pair_t){lo, hi}, bf16pair_t); return r.u;
}
__device__ __forceinline__ bf16_t f2bf(float f) { union { __bf16 b; bf16_t u; } r; r.b = (__bf16)f; return r.u; }
__device__ __forceinline__ float bf2f(bf16_t h) { return __uint_as_float(((uint32_t)h) << 16); }
__device__ __forceinline__ float sigmoidf_(float v) { return 1.f / (1.f + __expf(-v)); }

__device__ __forceinline__ float wave_sum(float v) {
#pragma unroll
    for (int o = 32; o > 0; o >>= 1) v += __shfl_xor(v, o);
    return v;
}

typedef __bf16 bf16v2 __attribute__((ext_vector_type(2)));
__device__ __forceinline__ float dot2bf(uint32_t a, uint32_t b, float c) {
    union { uint32_t u; bf16v2 v; } x, y; x.u = a; y.u = b;
    return __builtin_amdgcn_fdot2_f32_bf16(x.v, y.v, c, false);
}
__device__ __forceinline__ float row_sum16(float v) {
    v += __builtin_amdgcn_update_dpp(0.f, v, 0xB1, 0xF, 0xF, false);
    v += __builtin_amdgcn_update_dpp(0.f, v, 0x4E, 0xF, 0xF, false);
    v += __builtin_amdgcn_update_dpp(0.f, v, 0x141, 0xF, 0xF, false);
    v += __builtin_amdgcn_update_dpp(0.f, v, 0x140, 0xF, 0xF, false);
    return v;
}
__device__ __forceinline__ void d_transpose(const float* __restrict__ W, bf16_t* __restrict__ Wt, int K, int N, const float* __restrict__ rs, int unit, char* shm) {
    float (*tile)[65] = (float (*)[65])shm;
    const int tid = ltid(), ntn = N / 64;
    const int k0 = (unit / ntn) * 64, n0 = (unit % ntn) * 64, tx = tid & 15, ty = tid >> 4;
#pragma unroll
    for (int i = 0; i < 4; ++i) {
        const int k = k0 + ty + 16 * i;
        const float4 v = *(const float4*)(W + (size_t)k * N + n0 + 4 * tx);
        const float s = rs ? rs[k] : 1.f;
        tile[ty + 16 * i][4 * tx + 0] = v.x * s; tile[ty + 16 * i][4 * tx + 1] = v.y * s; tile[ty + 16 * i][4 * tx + 2] = v.z * s; tile[ty + 16 * i][4 * tx + 3] = v.w * s;
    }
    __syncthreads();
    {
        const int n = tid >> 2, kc = (tid & 3) * 16;
        uint32_t w[8];
#pragma unroll
        for (int j = 0; j < 8; ++j) w[j] = pack2(tile[kc + 2 * j][n], tile[kc + 2 * j + 1][n]);
        uint4* dst = (uint4*)(Wt + (size_t)(n0 + n) * K + k0 + kc);
        dst[0] = make_uint4(w[0], w[1], w[2], w[3]); dst[1] = make_uint4(w[4], w[5], w[6], w[7]);
    }
    __syncthreads();
}


__device__ __forceinline__ void d_cvt(const float* __restrict__ src, bf16_t* __restrict__ dst, size_t n4, int vblk, int nvblk) {
    for (size_t i = (size_t)vblk * 256 + ltid(); i < n4; i += (size_t)nvblk * 256) {
        const float4 v = ((const float4*)src)[i];
        ushort4 o; o.x = f2bf(v.x); o.y = f2bf(v.y); o.z = f2bf(v.z); o.w = f2bf(v.w);
        ((ushort4*)dst)[i] = o;
    }
}

__device__ __forceinline__ void d_cvt8(const float* __restrict__ src, unsigned char* __restrict__ dst, size_t n16, float scale, int vblk, int nvblk) {
    for (size_t i = (size_t)vblk * 256 + ltid(); i < n16; i += (size_t)nvblk * 256) {
        const float4* s = (const float4*)src + i * 4;
        uint32_t w[4];
#pragma unroll
        for (int q = 0; q < 4; ++q) {
            const float4 v = s[q];
            int pk = 0;
            pk = __builtin_amdgcn_cvt_pk_fp8_f32(v.x * scale, v.y * scale, pk, false);
            pk = __builtin_amdgcn_cvt_pk_fp8_f32(v.z * scale, v.w * scale, pk, true);
            w[q] = (uint32_t)pk;
        }
        ((uint4*)dst)[i] = make_uint4(w[0], w[1], w[2], w[3]);
    }
}

__device__ __forceinline__ void d_misc(const P& p, int unit) {
    const int gid = unit * 256 + ltid();
    if (gid < LP * 8) {
        const int pp = gid >> 3, i = gid & 7;
        const double inv = (i == 0) ? 1.0 : (i == 1) ? 0.19392274474868576 : (i == 2) ? 0.03760603093086393 : (i == 3) ? 0.007292664737217109 :
                           (i == 4) ? 0.001414213562373095 : (i == 5) ? 0.0002742481756762073 : (i == 6) ? 5.318295896944988e-05 : 1.031338537721246e-05;
        const double ang = (double)(pp - PADF) * inv;
        const double red = ang - 6.283185307179586476925 * __builtin_rint(ang * 0.15915494309189533577);
        float2 cs; __sincosf((float)red, &cs.y, &cs.x);
        WS(float2, OFF_ROPE)[gid] = cs;
    }
    if (gid < 512) {
        const float l0 = p.lb_logits[gid], l1 = p.lb_logits[512 + gid];
        WS(float, OFF_LB)[gid] = 1.f / (1.f + expf(l1 - l0));
    }
}

__device__ __forceinline__ void d_rmsnorm_in(const P& p, int unit) {
    const int lane = ltid() & 63, r = unit * 4 + (ltid() >> 6), b = r / LP, pp = r % LP;
    bf16_t* dst = WS(bf16_t, OFF_XN) + (size_t)r * DM;
    if (pp < PADF) {
#pragma unroll
        for (int i = 0; i < 2; ++i) ((uint4*)dst)[lane + 64 * i] = make_uint4(0, 0, 0, 0);
        return;
    }
    const float* src = (pp < 128) ? (p.meta + (size_t)(pp - PADF) * DM) : (p.x + ((size_t)b * SEQ + (pp - 128)) * DM);
    float4 v[4];
#pragma unroll
    for (int i = 0; i < 4; ++i) v[i] = ((const float4*)src)[lane * 2 + (i & 1) + 128 * (i >> 1)];
    float ss = 0.f;
#pragma unroll
    for (int i = 0; i < 4; ++i) ss += (v[i].x * v[i].x + v[i].y * v[i].y) + (v[i].z * v[i].z + v[i].w * v[i].w);
    ss = wave_sum(ss);
    const float rstd = rsqrtf(ss * (1.f / DM) + EPS);
#pragma unroll
    for (int hh = 0; hh < 2; ++hh) {
        const float4 g0 = ((const float4*)p.g_mix)[lane * 2 + 128 * hh], g1 = ((const float4*)p.g_mix)[lane * 2 + 1 + 128 * hh];
        const float4 a = v[2 * hh], c = v[2 * hh + 1];
        ((uint4*)dst)[lane + 64 * hh] = make_uint4(pack2(a.x * rstd * g0.x, a.y * rstd * g0.y), pack2(a.z * rstd * g0.z, a.w * rstd * g0.w),
                                                   pack2(c.x * rstd * g1.x, c.y * rstd * g1.y), pack2(c.z * rstd * g1.z, c.w * rstd * g1.w));
    }
}

__device__ __forceinline__ void glds16(const void* src, void* lds) { __builtin_amdgcn_global_load_lds((const unsigned*)src, (unsigned*)lds, 16, 0, 0); }

__device__ __forceinline__ void gemm_kloop(const bf16_t* __restrict__ A, int lda, const bf16_t* __restrict__ Bt, int ldb, int K, int brow, int bcol,
                                           f32x4 (&acc)[4][4], char* shm) {
    const int tid = ltid(), wid = tid >> 6, lane = tid & 63, wr = wid >> 1, wc = wid & 1, fr = lane & 15, fq = lane >> 4;
    const int sr = tid >> 3, sc = ((tid & 7) ^ ((sr >> 1) & 7)) * 8;
    const bf16_t* ag = A + (size_t)(brow + sr) * lda + sc;
    const bf16_t* bg = Bt + (size_t)(bcol + sr) * ldb + sc;
    const int nt = K >> 6;
#pragma unroll
    for (int i = 0; i < 4; ++i) {
        glds16(ag + (size_t)(32 * i) * lda, shm + tid * 16 + i * 4096);
        glds16(bg + (size_t)(32 * i) * ldb, shm + 16384 + tid * 16 + i * 4096);
    }
    asm volatile("s_waitcnt vmcnt(0)" ::: "memory");
    __syncthreads();
    const int arow = wr * 64 + fr, brw = wc * 64 + fr;
    const int swz = (fr >> 1) & 7;
    for (int kt = 0; kt < nt; ++kt) {
        char* SA = shm + (kt & 1) * 32768;
        char* SB = SA + 16384;
        if (kt + 1 < nt) {
            char* NA = shm + ((kt + 1) & 1) * 32768;
#pragma unroll
            for (int i = 0; i < 4; ++i) {
                glds16(ag + (size_t)(32 * i) * lda + (kt + 1) * 64, NA + tid * 16 + i * 4096);
                glds16(bg + (size_t)(32 * i) * ldb + (kt + 1) * 64, NA + 16384 + tid * 16 + i * 4096);
            }
        }
        bf16x8 a[2][4], b[2][4];
#pragma unroll
        for (int ks = 0; ks < 2; ++ks) {
            const int coff = (((ks * 4 + fq) ^ swz) << 4);
#pragma unroll
            for (int m = 0; m < 4; ++m) a[ks][m] = *(const bf16x8*)(SA + (arow + m * 16) * 128 + coff);
#pragma unroll
            for (int n = 0; n < 4; ++n) b[ks][n] = *(const bf16x8*)(SB + (brw + n * 16) * 128 + coff);
        }
        __builtin_amdgcn_s_setprio(1);
#pragma unroll
        for (int ks = 0; ks < 2; ++ks)
#pragma unroll
            for (int m = 0; m < 4; ++m)
#pragma unroll
                for (int n = 0; n < 4; ++n) acc[m][n] = __builtin_amdgcn_mfma_f32_16x16x32_bf16(a[ks][m], b[ks][n], acc[m][n], 0, 0, 0);
        __builtin_amdgcn_s_setprio(0);
        asm volatile("s_waitcnt vmcnt(0)" ::: "memory");
        __syncthreads();
    }
}

__device__ __forceinline__ void zero_acc(f32x4 (&acc)[4][4]) {
#pragma unroll
    for (int m = 0; m < 4; ++m)
#pragma unroll
        for (int n = 0; n < 4; ++n) acc[m][n] = (f32x4){0.f, 0.f, 0.f, 0.f};
}

constexpr int EPI_LD = 136;
__device__ __forceinline__ void tile_store_bf16(const char* shm, bf16_t* dst, int ld) {
    __syncthreads();
    const int t_ = ltid();
#pragma unroll
    for (int i = 0; i < 8; ++i) {
        const int q = t_ + 256 * i, r = q >> 4, c = q & 15;
        *(uint4*)(dst + (size_t)r * ld + c * 8) = *(const uint4*)(shm + (r * EPI_LD + c * 8) * 2);
    }
    __syncthreads();
}

__device__ __forceinline__ void tile_load_bf16(char* shm, const bf16_t* srcp, int ld) {
    const int t_ = ltid();
#pragma unroll
    for (int i = 0; i < 8; ++i) {
        const int q = t_ + 256 * i, r = q >> 4, c = q & 15;
        *(uint4*)(shm + (r * EPI_LD + c * 8) * 2) = *(const uint4*)(srcp + (size_t)r * ld + c * 8);
    }
}

__device__ __forceinline__ void ph_gemm_inproj(const P& p, char* shm) {
    const int tid = ltid(), wid = tid >> 6, lane = tid & 63, wr = wid >> 1, wc = wid & 1, fr = lane & 15, fq = lane >> 4;
    constexpr int NT_N = 2816 / 128, NT_M = R / 128;
    const float2* rope = WS(float2, OFF_ROPE);
    const float* lbv = WS(float, OFF_LB);
    for (int tile = blockIdx.x; tile < NT_N * NT_M; tile += gridDim.x) {
        const int pm = tile / NT_N, pn = tile % NT_N, brow_ = pm * 128, bcol_ = pn * 128;
        f32x4 acc[4][4]; zero_acc(acc);
        int brow = brow_, bcol = bcol_;
        gemm_kloop(WS(bf16_t, OFF_XN), DM, WS(bf16_t, OFF_WIN), DM, DM, brow, bcol, acc, shm);
        asm volatile("" : "+s"(brow), "+s"(bcol));
        if (bcol >= 1280 && bcol < 1792) {
#pragma unroll
            for (int n = 0; n < 4; ++n) {
                const int col = bcol + wc * 64 + n * 16 + fr;
                const float bv = p.b_in[col], lb = lbv[col - 1280];
                float run = 0.f;
#pragma unroll
                for (int m = 0; m < 4; ++m) {
                    float c[4];
#pragma unroll
                    for (int j = 0; j < 4; ++j) {
                        const int row = brow + wr * 64 + m * 16 + fq * 4 + j;
                        const float v = acc[m][n][j] + bv;
                        const float f = lb + (1.f - lb) * sigmoidf_(v);
                        const float lf = ((row % LP) < PADF) ? 0.f : __logf(f);
                        c[j] = lf + (j ? c[j - 1] : 0.f);
                    }
                    const float x = c[3];
                    const float y = __shfl_up(x, 16);
                    float incl = x + (fq >= 1 ? y : 0.f);
                    const float z = __shfl_up(incl, 32);
                    incl += (fq >= 2 ? z : 0.f);
                    const float excl = incl - x;
                    const float tot = __shfl(incl, fr + 48);
#pragma unroll
                    for (int j = 0; j < 4; ++j) {
                        const int row = brow + wr * 64 + m * 16 + fq * 4 + j;
                        WS(float, OFF_LOGF)[(size_t)row * 512 + (col - 1280)] = run + excl + c[j];
                    }
                    run += tot;
                }
            }
        } else {
            bf16_t* st = (bf16_t*)shm;
            const int kind = (bcol < 512) ? 0 : (bcol < 640) ? 1 : (bcol < 2304) ? 2 : 3;
#pragma unroll
            for (int m = 0; m < 4; ++m)
#pragma unroll
                for (int n = 0; n < 4; ++n) {
                    const int cl = wc * 64 + n * 16 + fr;
                    const float bv = p.b_in[bcol + cl];
#pragma unroll
                    for (int j = 0; j < 4; ++j) {
                        const int rl = wr * 64 + m * 16 + fq * 4 + j;
                        float v = acc[m][n][j] + bv;
                        if (kind <= 1) {
                            if (n == 0) {
                                const float other = __shfl_xor(v, 8);
                                const float2 cs = rope[((brow + rl) % LP) * 8 + (fr & 7)];
                                v = (fr < 8) ? (v * cs.x - other * cs.y) : (v * cs.x + other * cs.y);
                            }
                            if (kind == 0) v *= 0.125f;
                        } else if (kind == 3) v = v * sigmoidf_(v);
                        st[rl * EPI_LD + cl] = f2bf(v);
                    }
                }
            bf16_t* dst; int ld;
            if (bcol < 512) { dst = WS(bf16_t, OFF_QB) + bcol; ld = 512; }
            else if (bcol < 640) { dst = WS(bf16_t, OFF_KB); ld = 128; }
            else if (bcol < 768) { dst = WS(bf16_t, OFF_VB); ld = 128; }
            else if (bcol < 1280) { dst = WS(bf16_t, OFF_RQ) + (bcol - 768); ld = 512; }
            else if (bcol < 2304) { dst = WS(bf16_t, OFF_RI) + (bcol - 1792); ld = 512; }
            else { dst = WS(bf16_t, OFF_RG) + (bcol - 2304); ld = 512; }
            tile_store_bf16(shm, dst + (size_t)brow * ld, ld);
        }
    }
}

__device__ __forceinline__ void ph_gemm_merge(const P& p, char* shm) {
    const int tid = ltid(), wid = tid >> 6, lane = tid & 63, wr = wid >> 1, wc = wid & 1, fr = lane & 15, fq = lane >> 4;
    constexpr int NT_N = 8, NT_M = T / 128;
    bf16_t* st = (bf16_t*)shm;
    for (int tile = blockIdx.x; tile < NT_N * NT_M; tile += gridDim.x) {
        const int pm = tile / NT_N, pn = tile % NT_N, brow = pm * 128, bcol = pn * 128;
        const int prow = brow + 128 * (brow / SEQ + 1);
        f32x4 acc[4][4];
        uint32_t sg[4][4];
        uint32_t tt[4][4][2];
#pragma unroll 1
        for (int pass = 0; pass < 2; ++pass) {
            zero_acc(acc);
            gemm_kloop(WS(bf16_t, OFF_XN), DM, WS(bf16_t, OFF_WIN), DM, DM, prow, 2816 + 1024 * pass + bcol, acc, shm);
            int ecol = bcol;
            asm volatile("" : "+s"(ecol));
#pragma unroll
            for (int m = 0; m < 4; ++m)
#pragma unroll
                for (int n = 0; n < 4; ++n) {
                    const float bv = p.b_in[2816 + 1024 * pass + ecol + wc * 64 + n * 16 + fr];
                    uint32_t g8 = 0;
#pragma unroll
                    for (int j = 0; j < 4; ++j) g8 |= (uint32_t)__builtin_rintf(sigmoidf_(acc[m][n][j] + bv) * 255.f) << (8 * j);
                    sg[m][n] = g8;
                }
            zero_acc(acc);
            gemm_kloop(WS(bf16_t, pass ? OFF_REC : OFF_ATT), 512, WS(bf16_t, pass ? OFF_WUR : OFF_WUA), 512, 512, brow, bcol, acc, shm);
            int erow = brow;
            asm volatile("" : "+s"(erow), "+s"(ecol));
            bf16_t* mrg = WS(bf16_t, OFF_MRG) + (size_t)erow * 1024 + ecol;
#pragma unroll
            for (int m = 0; m < 4; ++m)
#pragma unroll
                for (int n = 0; n < 4; ++n) {
                    float v[4];
#pragma unroll
                    for (int j = 0; j < 4; ++j) v[j] = acc[m][n][j] * ((float)((sg[m][n] >> (8 * j)) & 0xFFu) * (1.f / 255.f));
                    if (pass == 0) { tt[m][n][0] = pack2(v[0], v[1]); tt[m][n][1] = pack2(v[2], v[3]); }
                    else {
                        const int cl = wc * 64 + n * 16 + fr, rl = wr * 64 + m * 16 + fq * 4;
                        st[(rl + 0) * EPI_LD + cl] = f2bf(v[0] + __uint_as_float(tt[m][n][0] << 16));
                        st[(rl + 1) * EPI_LD + cl] = f2bf(v[1] + __uint_as_float(tt[m][n][0] & 0xFFFF0000u));
                        st[(rl + 2) * EPI_LD + cl] = f2bf(v[2] + __uint_as_float(tt[m][n][1] << 16));
                        st[(rl + 3) * EPI_LD + cl] = f2bf(v[3] + __uint_as_float(tt[m][n][1] & 0xFFFF0000u));
                    }
                }
            if (pass == 1) tile_store_bf16(shm, mrg, 1024);
        }
    }
}

__device__ __forceinline__ void ph_gemm_out(const P& p, char* shm) {
    const int tid = ltid(), wid = tid >> 6, lane = tid & 63, wr = wid >> 1, wc = wid & 1, fr = lane & 15, fq = lane >> 4;
    constexpr int NT_N = 8, NT_M = T / 128;
    bf16_t* st = (bf16_t*)shm;
    for (int q = blockIdx.x >> 3; q < NT_N * NT_M / 8; q += gridDim.x >> 3) {
        const int pm = 8 * (q >> 3) + (blockIdx.x & 7), pn = q & 7, brow_ = pm * 128, bcol_ = pn * 128;
        f32x4 acc[4][4]; zero_acc(acc);
        int brow = brow_, bcol = bcol_;
        gemm_kloop(WS(bf16_t, OFF_MRG), 1024, WS(bf16_t, OFF_WOUT), 1024, 1024, brow, bcol, acc, shm);
        asm volatile("" : "+s"(brow), "+s"(bcol));
#pragma unroll
        for (int m = 0; m < 4; ++m)
#pragma unroll
            for (int n = 0; n < 4; ++n)
#pragma unroll
                for (int j = 0; j < 4; ++j) st[(wr * 64 + m * 16 + fq * 4 + j) * EPI_LD + wc * 64 + n * 16 + fr] = f2bf(acc[m][n][j]);
        __syncthreads();
#pragma unroll 2
        for (int i = 0; i < 8; ++i) {
            const int q = tid + 256 * i, r = q >> 4, c = q & 15;
            const uint4 a = *(const uint4*)(shm + (r * EPI_LD + c * 8) * 2);
            const float* xp = p.x + (size_t)(brow + r) * DM + bcol + c * 8;
            const float4 x0 = *(const float4*)xp, x1 = *(const float4*)(xp + 4);
            const float h0 = x0.x + __uint_as_float(a.x << 16), h1 = x0.y + __uint_as_float(a.x & 0xFFFF0000u);
            const float h2 = x0.z + __uint_as_float(a.y << 16), h3 = x0.w + __uint_as_float(a.y & 0xFFFF0000u);
            const float h4 = x1.x + __uint_as_float(a.z << 16), h5 = x1.y + __uint_as_float(a.z & 0xFFFF0000u);
            const float h6 = x1.z + __uint_as_float(a.w << 16), h7 = x1.w + __uint_as_float(a.w & 0xFFFF0000u);
            *(uint4*)(WS(bf16_t, OFF_H2B) + (size_t)(brow + r) * DM + bcol + c * 8) = make_uint4(pack2(h0, h1), pack2(h2, h3), pack2(h4, h5), pack2(h6, h7));
            float ss = (h0 * h0 + h1 * h1) + (h2 * h2 + h3 * h3) + (h4 * h4 + h5 * h5) + (h6 * h6 + h7 * h7);
            ss = row_sum16(ss);
            if (c == 0) WS(float, OFF_SSQ)[(size_t)pn * T + brow + r] = ss;
        }
        __syncthreads();
    }
}

__device__ __forceinline__ float row_rstd(const P& p, int row) {
    float s = 0.f;
#pragma unroll
    for (int i = 0; i < 8; ++i) s += WS(float, OFF_SSQ)[(size_t)i * T + row];
    return rsqrtf(s * (1.f / DM) + EPS);
}

__device__ __forceinline__ void ph_gemm_qry(const P& p, char* shm) {
    const int tid = ltid(), wid = tid >> 6, lane = tid & 63, wr = wid >> 1, wc = wid & 1, fr = lane & 15, fq = lane >> 4;
    constexpr int NT_N = 8, NT_M = T / 128;
    for (int tile = blockIdx.x; tile < NT_N * NT_M; tile += gridDim.x) {
        const int pm = tile / NT_N, pn = tile % NT_N, brow_ = pm * 128, bcol_ = pn * 128;
        f32x4 acc[4][4]; zero_acc(acc);
        int brow = brow_, bcol = bcol_;
        gemm_kloop(WS(bf16_t, OFF_H2B), 1024, WS(bf16_t, OFF_WQ), 1024, 1024, brow, bcol, acc, shm);
        asm volatile("" : "+s"(brow), "+s"(bcol));
#pragma unroll
        for (int m = 0; m < 4; ++m)
#pragma unroll
            for (int j = 0; j < 4; ++j) {
                const int row = brow + wr * 64 + m * 16 + fq * 4 + j;
                const float rstd = row_rstd(p, row);
                if (bcol == 0 && wc == 0 && fr == 0) WS(float, OFF_RSTD)[row] = rstd;
#pragma unroll
                for (int n = 0; n < 4; ++n) {
                    const int col = bcol + wc * 64 + n * 16 + fr;
                    WS(bf16_t, OFF_QRY)[(size_t)row * DM + col] = f2bf(acc[m][n][j] * rstd);
                }
            }
    }
}

#if ATTN_SIMPLE
__device__ __forceinline__ void d_attn_simple(const P& p, int unit) {
    const int gid = unit * 256 + ltid();
    const int hq = gid / T, t = gid % T, b = t / SEQ, s = t % SEQ, pq = 128 + s, kvh = hq >> 2;
    const bf16_t* qp = WS(bf16_t, OFF_QB) + ((size_t)b * LP + pq) * 512 + hq * 64;
    float q[64], o[64];
#pragma unroll
    for (int d = 0; d < 64; ++d) { q[d] = bf2f(qp[d]); o[d] = 0.f; }
    float m = p.sinks[hq], l = 1.f;
    const bf16_t* kbase = WS(bf16_t, OFF_KB) + (size_t)b * LP * 128 + kvh * 64;
    const bf16_t* vbase = WS(bf16_t, OFF_VB) + (size_t)b * LP * 128 + kvh * 64;
    const int lo = (pq - 127 > 128) ? (pq - 127) : 128;
    const int nkeys = 16 + (pq - lo + 1);
    for (int i = 0; i < nkeys; ++i) {
        const int pk = (i < 16) ? (PADF + i) : (lo + i - 16);
        const bf16_t* kp = kbase + (size_t)pk * 128;
        const bf16_t* vp = vbase + (size_t)pk * 128;
        float sc = 0.f;
#pragma unroll
        for (int d = 0; d < 64; ++d) sc += q[d] * bf2f(kp[d]);
        const float mn = fmaxf(m, sc), a = __expf(m - mn), e = __expf(sc - mn);
        l = l * a + e;
#pragma unroll
        for (int d = 0; d < 64; ++d) o[d] = o[d] * a + e * bf2f(vp[d]);
        m = mn;
    }
    const float inv = 1.f / l;
    bf16_t* op = WS(bf16_t, OFF_ATT) + (size_t)t * 512 + hq * 64;
#pragma unroll
    for (int d = 0; d < 64; ++d) op[d] = f2bf(o[d] * inv);
}

#endif
constexpr int LDV = 280;
__device__ __forceinline__ void d_attn(const P& p, int unit, char* shm) {
    bf16_t* VT = (bf16_t*)shm;
    const int tid = ltid(), lane = tid & 63, fr = lane & 15, fq = lane >> 4;
    const int w = __builtin_amdgcn_readfirstlane(tid >> 6);
    const int hq = unit & 7, n = ((unit >> 3) & 31) + 1, b = unit >> 8, kvh = hq >> 2;
    const size_t rb = (size_t)b * LP;
    const int kb0 = 128 * (n - 1);
    const bf16_t* kbp = WS(bf16_t, OFF_KB) + kvh * 64;
    const bf16_t* vbp = WS(bf16_t, OFF_VB) + kvh * 64;
#pragma unroll 1
    for (int i = 0; i < 9; ++i) {
        const int c = tid + 256 * i;
        if (c < 2176) {
            const int x = c >> 3, dc = c & 7;
            const int pos = (x < 256) ? (kb0 + x) : (PADF + x - 256);
            const uint4 v = *(const uint4*)(vbp + (rb + pos) * 128 + 8 * dc);
            bf16_t* dst = VT + (8 * dc) * LDV + x;
            dst[0 * LDV] = (bf16_t)(v.x & 0xFFFF); dst[1 * LDV] = (bf16_t)(v.x >> 16);
            dst[2 * LDV] = (bf16_t)(v.y & 0xFFFF); dst[3 * LDV] = (bf16_t)(v.y >> 16);
            dst[4 * LDV] = (bf16_t)(v.z & 0xFFFF); dst[5 * LDV] = (bf16_t)(v.z >> 16);
            dst[6 * LDV] = (bf16_t)(v.w & 0xFFFF); dst[7 * LDV] = (bf16_t)(v.w >> 16);
        }
    }
    __syncthreads();
    bf16x8 qf[2][2];
#pragma unroll
    for (int u = 0; u < 2; ++u)
#pragma unroll
        for (int ks = 0; ks < 2; ++ks)
            qf[u][ks] = *(const bf16x8*)(WS(bf16_t, OFF_QB) + (rb + 128 * n + 32 * w + 16 * u + fr) * 512 + hq * 64 + 32 * ks + 8 * fq);
    f32x4 s[11][2];
#pragma unroll
    for (int tt = 0; tt < 11; ++tt) {
        const int x0 = (tt < 10) ? (32 * w + 16 * tt) : 256;
        const int pos = ((tt < 10) ? (kb0 + x0) : PADF) + fr;
        const bf16x8 k0 = *(const bf16x8*)(kbp + (rb + pos) * 128 + 8 * fq);
        const bf16x8 k1 = *(const bf16x8*)(kbp + (rb + pos) * 128 + 32 + 8 * fq);
#pragma unroll
        for (int u = 0; u < 2; ++u) {
            f32x4 c = (f32x4){0.f, 0.f, 0.f, 0.f};
            c = __builtin_amdgcn_mfma_f32_16x16x32_bf16(k0, qf[u][0], c, 0, 0, 0);
            c = __builtin_amdgcn_mfma_f32_16x16x32_bf16(k1, qf[u][1], c, 0, 0, 0);
            if (tt < 10) {
                const int xq = 128 + 32 * w + 16 * u + fr;
#pragma unroll
                for (int j = 0; j < 4; ++j) {
                    const int x = x0 + 4 * fq + j, dq = xq - x;
                    const bool ok = (dq >= 0) && (dq < 128) && (kb0 + x >= 128);
                    c[j] = ok ? c[j] : -1.0e30f;
                }
            }
            s[tt][u] = c;
        }
    }
    const float sink = p.sinks[hq];
    float inv[2];
#pragma unroll
    for (int u = 0; u < 2; ++u) {
        float m = sink;
#pragma unroll
        for (int tt = 0; tt < 11; ++tt)
#pragma unroll
            for (int j = 0; j < 4; ++j) m = fmaxf(m, s[tt][u][j]);
        m = fmaxf(m, __shfl_xor(m, 16)); m = fmaxf(m, __shfl_xor(m, 32));
        float l = 0.f;
#pragma unroll
        for (int tt = 0; tt < 11; ++tt)
#pragma unroll
            for (int j = 0; j < 4; ++j) { const float e = __expf(s[tt][u][j] - m); s[tt][u][j] = e; l += e; }
        l += __shfl_xor(l, 16); l += __shfl_xor(l, 32);
        l += __expf(sink - m);
        inv[u] = 1.f / l;
    }
    f32x4 o[4][2];
#pragma unroll
    for (int dt = 0; dt < 4; ++dt)
#pragma unroll
        for (int u = 0; u < 2; ++u) o[dt][u] = (f32x4){0.f, 0.f, 0.f, 0.f};
#pragma unroll
    for (int g = 0; g < 6; ++g) {
        const int xa = (g < 5) ? (32 * w + 32 * g) : 256, xb = (g < 5) ? (xa + 16) : 256;
        bf16x8 pf[2];
#pragma unroll
        for (int u = 0; u < 2; ++u) {
#pragma unroll
            for (int j = 0; j < 4; ++j) {
                pf[u][j] = (short)f2bf(s[2 * g][u][j]);
                pf[u][4 + j] = (g < 5) ? (short)f2bf(s[(g < 5) ? (2 * g + 1) : 0][u][j]) : (short)0;
            }
        }
#pragma unroll
        for (int dt = 0; dt < 4; ++dt) {
            const uint2 a0 = *(const uint2*)(VT + (16 * dt + fr) * LDV + xa + 4 * fq);
            const uint2 a1 = *(const uint2*)(VT + (16 * dt + fr) * LDV + xb + 4 * fq);
            union { uint4 q; bf16x8 v; } av; av.q = make_uint4(a0.x, a0.y, a1.x, a1.y);
#pragma unroll
            for (int u = 0; u < 2; ++u) o[dt][u] = __builtin_amdgcn_mfma_f32_16x16x32_bf16(av.v, pf[u], o[dt][u], 0, 0, 0);
        }
    }
#pragma unroll
    for (int u = 0; u < 2; ++u) {
        const size_t t = (size_t)b * SEQ + 128 * (n - 1) + 32 * w + 16 * u + fr;
#pragma unroll
        for (int dt = 0; dt < 4; ++dt) {
            uint2 ov;
            ov.x = pack2(o[dt][u][0] * inv[u], o[dt][u][1] * inv[u]);
            ov.y = pack2(o[dt][u][2] * inv[u], o[dt][u][3] * inv[u]);
            *(uint2*)(WS(bf16_t, OFF_ATT) + t * 512 + hq * 64 + 16 * dt + 4 * fq) = ov;
        }
    }
    __syncthreads();
}

#if HGRN_SIMPLE
__device__ __forceinline__ void d_hgrn_simple(const P& p, int bh, char* shm) {
    float (*fs)[128] = (float (*)[128])shm;
    float (*ks)[128] = (float (*)[128])(shm + 4096);
    float (*qs)[128] = (float (*)[128])(shm + 8192);
    float (*os)[128] = (float (*)[128])(shm + 12288);
    float (*red)[2] = (float (*)[2])(shm + 16384);
    const int b = bh >> 2, h = bh & 3, e = ltid() & 127;
    const bool act = ltid() < 128;
    float S[128];
#pragma unroll
    for (int d = 0; d < 128; ++d) S[d] = 0.f;
    const float g = p.g_rec[h * 128 + e];
    for (int p0 = PADF; p0 < LP; p0 += 8) {
        float v[8];
        if (act) {
#pragma unroll
            for (int i = 0; i < 8; ++i) {
                const size_t r = (size_t)b * LP + p0 + i;
                const float lf = WS(float, OFF_LOGF)[r * 512 + h * 128 + e] - (((p0 + i) & 63) ? WS(float, OFF_LOGF)[(r - 1) * 512 + h * 128 + e] : 0.f);
                const float f = __expf(lf);
                fs[i][e] = f; ks[i][e] = 1.f - f;
                qs[i][e] = bf2f(WS(bf16_t, OFF_RQ)[r * 512 + h * 128 + e]);
                v[i] = bf2f(WS(bf16_t, OFF_RI)[r * 512 + h * 128 + e]);
            }
        }
        __syncthreads();
        if (act) {
#pragma unroll
            for (int i = 0; i < 8; ++i) {
                float o = 0.f;
#pragma unroll
                for (int d = 0; d < 128; ++d) { S[d] = fs[i][d] * S[d] + ks[i][d] * v[i]; o += qs[i][d] * S[d]; }
                os[i][e] = o;
                const float ss = wave_sum(o * o);
                if ((e & 63) == 0) red[i][e >> 6] = ss;
            }
        }
        __syncthreads();
        if (act && p0 >= 128) {
#pragma unroll
            for (int i = 0; i < 8; ++i) {
                const size_t r = (size_t)b * LP + p0 + i;
                const size_t t = (size_t)b * SEQ + (p0 + i - 128);
                const float rstd = rsqrtf((red[i][0] + red[i][1]) * (1.f / 128.f) + EPS);
                const float val = os[i][e] * rstd * g * bf2f(WS(bf16_t, OFF_RG)[r * 512 + h * 128 + e]);
                WS(bf16_t, OFF_REC)[t * 512 + h * 128 + e] = f2bf(val);
            }
        }
        __syncthreads();
    }
}

#endif

constexpr int LD64 = 72;
constexpr int LD128 = 136;

__device__ __forceinline__ void d_hgrn_A(const P& p, int unit, char* shm) {
    bf16_t* VT = (bf16_t*)shm;
    bf16_t* KT = (bf16_t*)(shm + 128 * LD64 * 2);
    const int tid = ltid(), wid = tid >> 6, lane = tid & 63, fr = lane & 15, fq = lane >> 4;
    const int bh = unit >> 6, n = (unit & 63) + 1, b = bh >> 2, h = bh & 3;
    const int c = tid & 127, half = tid >> 7;
    const size_t r0 = (size_t)b * LP + 64 * n;
    const float* bb = WS(float, OFF_LOGF) + r0 * 512 + h * 128 + c;
    const bf16_t* vv = WS(bf16_t, OFF_RI) + r0 * 512 + h * 128 + c;
    {
        const float blast = bb[63 * 512];
        float prev = half ? bb[31 * 512] : 0.f;
        const float* bp = bb + (size_t)(32 * half) * 512;
        const bf16_t* vp_ = vv + (size_t)(32 * half) * 512;
#pragma unroll 1
        for (int g = 0; g < 4; ++g) {
            float bs[8]; uint32_t vs[8];
#pragma unroll
            for (int i = 0; i < 8; ++i) { bs[i] = bp[i * 512]; vs[i] = vp_[i * 512]; }
            uint32_t kp[4], vp[4];
#pragma unroll
            for (int i = 0; i < 8; i += 2) {
                const float k0 = (1.f - __expf(bs[i] - prev)) * __expf(blast - bs[i]);
                const float k1 = (1.f - __expf(bs[i + 1] - bs[i])) * __expf(blast - bs[i + 1]);
                prev = bs[i + 1];
                kp[i >> 1] = pack2(k0, k1);
                vp[i >> 1] = vs[i] | (vs[i + 1] << 16);
            }
            *(uint4*)(KT + c * LD64 + 32 * half + 8 * g) = make_uint4(kp[0], kp[1], kp[2], kp[3]);
            *(uint4*)(VT + c * LD64 + 32 * half + 8 * g) = make_uint4(vp[0], vp[1], vp[2], vp[3]);
            bp += 8 * 512; vp_ += 8 * 512;
        }
    }
    __syncthreads();
    f32x4 acc[2][8];
#pragma unroll
    for (int mi = 0; mi < 2; ++mi)
#pragma unroll
        for (int n8 = 0; n8 < 8; ++n8) acc[mi][n8] = (f32x4){0.f, 0.f, 0.f, 0.f};
#pragma unroll
    for (int ks = 0; ks < 2; ++ks) {
        bf16x8 a[2];
#pragma unroll
        for (int mi = 0; mi < 2; ++mi) a[mi] = *(const bf16x8*)(VT + (32 * wid + 16 * mi + fr) * LD64 + 32 * ks + 8 * fq);
#pragma unroll
        for (int n8 = 0; n8 < 8; ++n8) {
            const bf16x8 bf = *(const bf16x8*)(KT + (16 * n8 + fr) * LD64 + 32 * ks + 8 * fq);
#pragma unroll
            for (int mi = 0; mi < 2; ++mi) acc[mi][n8] = __builtin_amdgcn_mfma_f32_16x16x32_bf16(a[mi], bf, acc[mi][n8], 0, 0, 0);
        }
    }
    bf16_t* dst = WS(bf16_t, OFF_DS) + (size_t)unit * 16384;
#pragma unroll
    for (int mi = 0; mi < 2; ++mi)
#pragma unroll
        for (int n8 = 0; n8 < 8; ++n8)
#pragma unroll
            for (int j = 0; j < 4; ++j) dst[(32 * wid + 16 * mi + 4 * fq + j) * 128 + 16 * n8 + fr] = f2bf(acc[mi][n8][j]);
    __syncthreads();
}

__device__ __forceinline__ void d_hgrn_scan(const P& p, int unit) {
    const int gid = unit * 256 + ltid();
    const int bh = gid >> 13, rem = gid & 8191, e = rem >> 6, d2 = (rem & 63) * 2;
    uint32_t* base = (uint32_t*)(WS(bf16_t, OFF_DS) + (size_t)bh * 64 * 16384 + e * 128 + d2);
    const float* bb = WS(float, OFF_LOGF) + ((size_t)(bh >> 2) * LP + 64 + 63) * 512 + (bh & 3) * 128 + d2;
    float s0 = 0.f, s1 = 0.f;
#pragma unroll 8
    for (int j = 0; j < 64; ++j) {
        const uint32_t x = base[(size_t)j * 8192];
        const float2 bl = *(const float2*)(bb + (size_t)j * 64 * 512);
        s0 = __expf(bl.x) * s0 + __uint_as_float(x << 16);
        s1 = __expf(bl.y) * s1 + __uint_as_float(x & 0xFFFF0000u);
        base[(size_t)j * 8192] = pack2(s0, s1);
    }
}

__device__ __forceinline__ void d_hgrn_C(const P& p, int unit, char* shm) {
    bf16_t* KS = (bf16_t*)shm;
    bf16_t* KD = KS + 64 * LD128;
    bf16_t* VT = KD + 64 * LD128;
    bf16_t* AM = VT + 128 * LD64;
    const int tid = ltid(), lane = tid & 63, fr = lane & 15, fq = lane >> 4;
    const int wi = __builtin_amdgcn_readfirstlane(tid >> 6);
    const int bh = unit >> 6, n = (unit & 63) + 2, b = bh >> 2, h = bh & 3;
    const size_t r0 = (size_t)b * LP + 64 * n;
    const size_t t0 = (size_t)b * SEQ + 64 * n - 128;
    {
        const int c = tid & 127, half = tid >> 7;
        const float* bb = WS(float, OFF_LOGF) + r0 * 512 + h * 128 + c;
        const bf16_t* vv = WS(bf16_t, OFF_RI) + r0 * 512 + h * 128 + c;
        float prev = half ? bb[31 * 512] : 0.f;
        const float* bp = bb + (size_t)(32 * half) * 512;
        const bf16_t* vp_ = vv + (size_t)(32 * half) * 512;
#pragma unroll 1
        for (int g = 0; g < 4; ++g) {
            const int s0 = 32 * half + 8 * g, sb = s0 & ~15;
            const float bend = bb[(size_t)(sb + 15) * 512];
            const float bref = (sb == 0) ? 0.f : bb[(size_t)(sb - 1) * 512];
            float bs[8]; uint32_t vs[8];
#pragma unroll
            for (int i = 0; i < 8; ++i) { bs[i] = bp[i * 512]; vs[i] = vp_[i * 512]; }
#pragma unroll
            for (int i = 0; i < 8; ++i) {
                const float k = 1.f - __expf(bs[i] - prev);
                prev = bs[i];
                KS[(s0 + i) * LD128 + c] = f2bf(k * __expf(bend - bs[i]));
                KD[(s0 + i) * LD128 + c] = f2bf(k * __expf(bref - bs[i]));
            }
            *(uint4*)(VT + c * LD64 + s0) = make_uint4(vs[0] | (vs[1] << 16), vs[2] | (vs[3] << 16), vs[4] | (vs[5] << 16), vs[6] | (vs[7] << 16));
            bp += 8 * 512; vp_ += 8 * 512;
        }
#pragma unroll
        for (int i = 0; i < 9; ++i) ((uint32_t*)AM)[tid + 256 * i] = 0u;
    }
    __syncthreads();
    const int tl = 16 * wi + fr;
    bf16x8 qf[4]; float bt[4][8];
    {
        const bf16_t* qrow = WS(bf16_t, OFF_RQ) + (r0 + tl) * 512 + h * 128 + 8 * fq;
        const float* brow = WS(float, OFF_LOGF) + (r0 + tl) * 512 + h * 128 + 8 * fq;
#pragma unroll
        for (int ks = 0; ks < 4; ++ks) {
            qf[ks] = *(const bf16x8*)(qrow + 32 * ks);
            const float4 x0 = *(const float4*)(brow + 32 * ks), x1 = *(const float4*)(brow + 32 * ks + 4);
            bt[ks][0] = x0.x; bt[ks][1] = x0.y; bt[ks][2] = x0.z; bt[ks][3] = x0.w; bt[ks][4] = x1.x; bt[ks][5] = x1.y; bt[ks][6] = x1.z; bt[ks][7] = x1.w;
        }
    }
    auto qfrag = [&](int ks, const float* refrow) -> bf16x8 {
        float rf[8];
        if (refrow) {
            const float4 x0 = *(const float4*)(refrow + 32 * ks), x1 = *(const float4*)(refrow + 32 * ks + 4);
            rf[0] = x0.x; rf[1] = x0.y; rf[2] = x0.z; rf[3] = x0.w; rf[4] = x1.x; rf[5] = x1.y; rf[6] = x1.z; rf[7] = x1.w;
        } else {
#pragma unroll
            for (int jj = 0; jj < 8; ++jj) rf[jj] = 0.f;
        }
        bf16x8 o;
#pragma unroll
        for (int jj = 0; jj < 8; ++jj) o[jj] = (short)f2bf(bf2f((bf16_t)qf[ks][jj]) * __expf(bt[ks][jj] - rf[jj]));
        return o;
    };
    const float* bchunk = WS(float, OFF_LOGF) + r0 * 512 + h * 128 + 8 * fq;
    f32x4 acc[8];
#pragma unroll
    for (int n8 = 0; n8 < 8; ++n8) acc[n8] = (f32x4){0.f, 0.f, 0.f, 0.f};
    {
        const bf16_t* sp = WS(bf16_t, OFF_DS) + (size_t)unit * 16384 + fr * 128 + 8 * fq;
#pragma unroll
        for (int ks = 0; ks < 4; ++ks) {
            const bf16x8 a = qfrag(ks, nullptr);
#pragma unroll
            for (int n8 = 0; n8 < 8; ++n8) {
                const bf16x8 bf = *(const bf16x8*)(sp + (size_t)n8 * 16 * 128 + 32 * ks);
                acc[n8] = __builtin_amdgcn_mfma_f32_16x16x32_bf16(a, bf, acc[n8], 0, 0, 0);
            }
        }
    }
    for (int j = 0; j < wi; ++j) {
        f32x4 c4 = (f32x4){0.f, 0.f, 0.f, 0.f};
        const float* refrow = bchunk + (size_t)(16 * j + 15) * 512;
#pragma unroll
        for (int ks = 0; ks < 4; ++ks) {
            const bf16x8 a = qfrag(ks, refrow);
            const bf16x8 bf = *(const bf16x8*)(KS + (16 * j + fr) * LD128 + 32 * ks + 8 * fq);
            c4 = __builtin_amdgcn_mfma_f32_16x16x32_bf16(a, bf, c4, 0, 0, 0);
        }
#pragma unroll
        for (int jj = 0; jj < 4; ++jj) AM[(16 * wi + 4 * fq + jj) * LD64 + 16 * j + fr] = f2bf(c4[jj]);
    }
    {
        f32x4 c4 = (f32x4){0.f, 0.f, 0.f, 0.f};
        const float* refrow = (wi > 0) ? (bchunk + (size_t)(16 * wi - 1) * 512) : nullptr;
#pragma unroll
        for (int ks = 0; ks < 4; ++ks) {
            const bf16x8 a = qfrag(ks, refrow);
            const bf16x8 bf = *(const bf16x8*)(KD + (16 * wi + fr) * LD128 + 32 * ks + 8 * fq);
            c4 = __builtin_amdgcn_mfma_f32_16x16x32_bf16(a, bf, c4, 0, 0, 0);
        }
#pragma unroll
        for (int jj = 0; jj < 4; ++jj) AM[(16 * wi + 4 * fq + jj) * LD64 + 16 * wi + fr] = f2bf((fr <= 4 * fq + jj) ? c4[jj] : 0.f);
    }
    __syncthreads();
#pragma unroll
    for (int ks = 0; ks < 2; ++ks) {
        const bf16x8 a = *(const bf16x8*)(AM + (16 * wi + fr) * LD64 + 32 * ks + 8 * fq);
#pragma unroll
        for (int n8 = 0; n8 < 8; ++n8) {
            const bf16x8 bf = *(const bf16x8*)(VT + (16 * n8 + fr) * LD64 + 32 * ks + 8 * fq);
            acc[n8] = __builtin_amdgcn_mfma_f32_16x16x32_bf16(a, bf, acc[n8], 0, 0, 0);
        }
    }
#pragma unroll
    for (int jj = 0; jj < 4; ++jj) {
        float ss = 0.f;
#pragma unroll
        for (int n8 = 0; n8 < 8; ++n8) ss += acc[n8][jj] * acc[n8][jj];
        ss += __shfl_xor(ss, 1); ss += __shfl_xor(ss, 2); ss += __shfl_xor(ss, 4); ss += __shfl_xor(ss, 8);
        const float rstd = rsqrtf(ss * (1.f / 128.f) + EPS);
        const int trow = 16 * wi + 4 * fq + jj;
#pragma unroll
        for (int n8 = 0; n8 < 8; ++n8) {
            const int e = 16 * n8 + fr;
            const float val = acc[n8][jj] * rstd * p.g_rec[h * 128 + e] * bf2f(WS(bf16_t, OFF_RG)[(r0 + trow) * 512 + h * 128 + e]);
            WS(bf16_t, OFF_REC)[(t0 + trow) * 512 + h * 128 + e] = f2bf(val);
        }
        asm volatile("" ::: "memory");
    }
    __syncthreads();
}

#if TOPK_SIMPLE
__device__ __forceinline__ void d_peer_topk_simple(const P& p, int unit) {
    const int t = (unit >> 3) * 256 + ltid(), h = unit & 7;
    const bf16_t* qp = WS(bf16_t, OFF_QRY) + (size_t)t * DM + h * 128;
    float tv[2][16]; int ti[2][16];
#pragma unroll
    for (int pp = 0; pp < 2; ++pp) {
        float q[64];
#pragma unroll
        for (int d = 0; d < 64; ++d) q[d] = bf2f(qp[pp * 64 + d]);
#pragma unroll
        for (int i = 0; i < 16; ++i) { tv[pp][i] = -3.0e38f; ti[pp][i] = 0; }
        const bf16_t* kp = WS(bf16_t, OFF_KEYS) + (size_t)(h * 2 + pp) * 128 * 64;
        for (int n = 0; n < 128; ++n) {
            float sc = 0.f;
#pragma unroll
            for (int d = 0; d < 64; ++d) sc += q[d] * bf2f(kp[n * 64 + d]);
            float xv = sc; int xi = n;
#pragma unroll
            for (int i = 0; i < 16; ++i) {
                if (xv > tv[pp][i]) { const float tf = tv[pp][i]; const int tn = ti[pp][i]; tv[pp][i] = xv; ti[pp][i] = xi; xv = tf; xi = tn; }
            }
        }
    }
    float bv[16]; int bi[16];
#pragma unroll
    for (int i = 0; i < 16; ++i) { bv[i] = -3.0e38f; bi[i] = 0; }
#pragma unroll
    for (int i = 0; i < 16; ++i)
#pragma unroll
        for (int j = 0; j < 16; ++j) {
            if ((i + 1) * (j + 1) <= 16) {
                float xv = tv[0][i] + tv[1][j]; int xi = ti[0][i] * 128 + ti[1][j];
#pragma unroll
                for (int k = 0; k < 16; ++k) {
                    if (xv > bv[k]) { const float tf = bv[k]; const int tn = bi[k]; bv[k] = xv; bi[k] = xi; xv = tf; xi = tn; }
                }
            }
        }
    float se = 0.f, ev[16];
#pragma unroll
    for (int k = 0; k < 16; ++k) { ev[k] = __expf(bv[k] - bv[0]); se += ev[k]; }
    const float inv = 1.f / se;
#pragma unroll
    for (int k = 0; k < 16; ++k) {
        WS(int, OFF_PIDX)[(size_t)t * 128 + h * 16 + k] = bi[k];
        WS(float, OFF_PGATE)[(size_t)t * 128 + h * 16 + k] = ev[k] * inv;
    }
}

#endif
template <int N> __device__ __forceinline__ void bitonic_sort_desc(float (&v)[N]) {
#pragma unroll
    for (int k = 2; k <= N; k <<= 1)
#pragma unroll
        for (int j = k >> 1; j > 0; j >>= 1)
#pragma unroll
            for (int i = 0; i < N; ++i) {
                const int l = i ^ j;
                if (l > i) {
                    const bool desc = ((i & k) == 0);
                    const float a = v[i], b = v[l];
                    const float hi = fmaxf(a, b), lo = fminf(a, b);
                    v[i] = desc ? hi : lo; v[l] = desc ? lo : hi;
                }
            }
}
template <int N> __device__ __forceinline__ void bitonic_merge_desc(float (&v)[N]) {
#pragma unroll
    for (int j = N >> 1; j > 0; j >>= 1)
#pragma unroll
        for (int i = 0; i < N; ++i) {
            const int l = i ^ j;
            if (l > i) { const float a = v[i], b = v[l]; v[i] = fmaxf(a, b); v[l] = fminf(a, b); }
        }
}
__device__ __forceinline__ void ph_peer_qry_topk(const P& p, char* shm) {
    const int tid = ltid(), wid = tid >> 6, lane = tid & 63, wr = wid >> 1, wc = wid & 1, fr = lane & 15, fq = lane >> 4;
    float* tops = (float*)shm;
    for (int q = blockIdx.x >> 3; q < T / 128; q += gridDim.x >> 3) {
        const int h = q & 7, t0 = (8 * (q >> 3) + (blockIdx.x & 7)) * 128;
        f32x4 acc[4][4]; zero_acc(acc);
        gemm_kloop(WS(bf16_t, OFF_WQ), 1024, WS(bf16_t, OFF_H2B), 1024, 1024, h * 128, t0, acc, shm);
        int tb = t0 + wc * 64 + fr;
        asm volatile("" : "+v"(tb));
        {
            const bf16_t* ksrc = WS(bf16_t, OFF_KEYS) + (size_t)h * 2 * 128 * 64;
#pragma unroll
            for (int i = 0; i < 8; ++i) {
                const int q = tid + 256 * i, r = q >> 3, c8 = q & 7;
                *(uint4*)(shm + 16384 + (r * 72 + c8 * 8) * 2) = *(const uint4*)(ksrc + (size_t)r * 64 + c8 * 8);
            }
        }
        __syncthreads();
        const bf16_t* kbase = (const bf16_t*)(shm + 16384) + (size_t)(wr * 128 + fr) * 72 + 4 * fq;
#pragma unroll
        for (int n = 0; n < 4; ++n) {
            const int t = tb + n * 16;
            const float rstd = row_rstd(p, t);
            if (wr == 0 && fq == 0 && h == 0) WS(float, OFF_RSTD)[t] = rstd;
            bf16x8 bq[2];
#pragma unroll
            for (int ks = 0; ks < 2; ++ks)
#pragma unroll
                for (int j = 0; j < 4; ++j) { bq[ks][j] = (short)f2bf(acc[2 * ks][n][j] * rstd); bq[ks][4 + j] = (short)f2bf(acc[2 * ks + 1][n][j] * rstd); }
            float v[32];
#pragma unroll
            for (int mk = 0; mk < 8; ++mk) {
                f32x4 c = (f32x4){0.f, 0.f, 0.f, 0.f};
#pragma unroll
                for (int ks = 0; ks < 2; ++ks) {
                    const uint2 a0 = *(const uint2*)(kbase + mk * 16 * 72 + 32 * ks);
                    const uint2 a1 = *(const uint2*)(kbase + mk * 16 * 72 + 32 * ks + 16);
                    union { uint4 q; bf16x8 v; } av; av.q = make_uint4(a0.x, a0.y, a1.x, a1.y);
                    c = __builtin_amdgcn_mfma_f32_16x16x32_bf16(av.v, bq[ks], c, 0, 0, 0);
                }
#pragma unroll
                for (int j = 0; j < 4; ++j) v[4 * mk + j] = __uint_as_float((__float_as_uint(c[j]) & ~0x7Fu) | (unsigned)(16 * mk + 4 * fq + j));
            }
            float m[16];
            {
                float h0[16], h1[16];
#pragma unroll
                for (int i = 0; i < 16; ++i) { h0[i] = v[i]; h1[i] = v[16 + i]; }
                bitonic_sort_desc<16>(h0); bitonic_sort_desc<16>(h1);
#pragma unroll
                for (int i = 0; i < 16; ++i) m[i] = fmaxf(h0[i], h1[15 - i]);
                bitonic_merge_desc<16>(m);
            }
#pragma unroll
            for (int off = 16; off <= 32; off <<= 1) {
                float o[16];
#pragma unroll
                for (int i = 0; i < 16; ++i) o[i] = __shfl_xor(m[i], off);
#pragma unroll
                for (int i = 0; i < 16; ++i) m[i] = fmaxf(m[i], o[15 - i]);
                bitonic_merge_desc<16>(m);
            }
            if (fq == 0) {
                float4* dst = (float4*)(tops + ((size_t)wr * 128 + wc * 64 + n * 16 + fr) * 16);
                dst[0] = make_float4(m[0], m[1], m[2], m[3]); dst[1] = make_float4(m[4], m[5], m[6], m[7]);
                dst[2] = make_float4(m[8], m[9], m[10], m[11]); dst[3] = make_float4(m[12], m[13], m[14], m[15]);
            }
        }
        __syncthreads();
        if (tid < 128) {
            const float* ta = tops + (size_t)tid * 16;
            const float* tbp = tops + (size_t)(128 + tid) * 16;
            float a[16], b[16];
#pragma unroll
            for (int i = 0; i < 16; ++i) { a[i] = __uint_as_float(__float_as_uint(ta[i]) & ~0x7Fu); b[i] = __uint_as_float(__float_as_uint(tbp[i]) & ~0x7Fu); }
            float cand[64];
            int k = 0;
#pragma unroll
            for (int i = 0; i < 16; ++i)
#pragma unroll
                for (int j = 0; j < 16; ++j)
                    if ((i + 1) * (j + 1) <= 16) { cand[k] = __uint_as_float((__float_as_uint(a[i] + b[j]) & ~0xFFu) | (unsigned)(i * 16 + j)); ++k; }
#pragma unroll
            for (int kk = 50; kk < 64; ++kk) cand[kk] = -3.0e38f;
            bitonic_sort_desc<64>(cand);
            float ev[16], se = 0.f; int ex[16];
            const float best = __uint_as_float(__float_as_uint(cand[0]) & ~0xFFu);
#pragma unroll
            for (int q = 0; q < 16; ++q) {
                const unsigned bits = __float_as_uint(cand[q]);
                const int ci = (bits >> 4) & 15, cj = bits & 15;
                const int ia = (int)(__float_as_uint(ta[ci]) & 0x7Fu), ib = (int)(__float_as_uint(tbp[cj]) & 0x7Fu);
                ex[q] = ia * 128 + ib;
                ev[q] = __expf(__uint_as_float(bits & ~0xFFu) - best); se += ev[q];
            }
            const float inv = 1.f / se;
            int4* pi = (int4*)(WS(int, OFF_PIDX) + (size_t)(t0 + tid) * 128 + h * 16);
            float4* pg = (float4*)(WS(float, OFF_PGATE) + (size_t)(t0 + tid) * 128 + h * 16);
#pragma unroll
            for (int q = 0; q < 4; ++q) {
                pi[q] = make_int4(ex[4 * q], ex[4 * q + 1], ex[4 * q + 2], ex[4 * q + 3]);
                pg[q] = make_float4(ev[4 * q] * inv, ev[4 * q + 1] * inv, ev[4 * q + 2] * inv, ev[4 * q + 3] * inv);
            }
        }
        __syncthreads();
    }
}

#if PEER_SIMPLE
__device__ __forceinline__ void d_peer_expert(const P& p, int t, char* shm) {
    float* act = (float*)shm;
    float* red = (float*)(shm + 512);
    const int tid = ltid(), wid = tid >> 6, lane = tid & 63;
    const float rstd = row_rstd(p, t);
    const float* h2 = WS(float, OFF_H2) + (size_t)t * DM;
    float xn[16];
#pragma unroll
    for (int i = 0; i < 4; ++i) {
        const float4 v = ((const float4*)h2)[lane * 4 + i];
        const float4 g = ((const float4*)p.g_ffn)[lane * 4 + i];
        xn[4 * i + 0] = v.x * rstd * g.x; xn[4 * i + 1] = v.y * rstd * g.y; xn[4 * i + 2] = v.z * rstd * g.z; xn[4 * i + 3] = v.w * rstd * g.w;
    }
    const int* idx = WS(int, OFF_PIDX) + (size_t)t * 128;
    const float* gate = WS(float, OFF_PGATE) + (size_t)t * 128;
    const bf16_t* edn = WS(bf16_t, OFF_EDN);
    const bf16_t* eup = WS(bf16_t, OFF_EUP);
    for (int e = wid; e < 128; e += 4) {
        const bf16_t* row = edn + (size_t)idx[e] * DM + lane * 16;
        const uint4 a = ((const uint4*)row)[0], c = ((const uint4*)row)[1];
        const uint32_t w[8] = {a.x, a.y, a.z, a.w, c.x, c.y, c.z, c.w};
        float s = 0.f;
#pragma unroll
        for (int i = 0; i < 8; ++i) s += xn[2 * i] * __uint_as_float(w[i] << 16) + xn[2 * i + 1] * __uint_as_float(w[i] & 0xFFFF0000u);
        s = wave_sum(s);
        if (lane == 0) act[e] = 0.5f * s * (1.f + erff(s * 0.70710678118654752f)) * gate[e];
    }
    __syncthreads();
    float y0 = 0.f, y1 = 0.f, y2 = 0.f, y3 = 0.f;
    for (int e = 0; e < 128; ++e) {
        const float a = act[e];
        const uint2 w = *(const uint2*)(eup + (size_t)idx[e] * DM + tid * 4);
        y0 += a * __uint_as_float(w.x << 16); y1 += a * __uint_as_float(w.x & 0xFFFF0000u);
        y2 += a * __uint_as_float(w.y << 16); y3 += a * __uint_as_float(w.y & 0xFFFF0000u);
    }
    const float4 hv = ((const float4*)h2)[tid];
    const float o0 = hv.x + y0, o1 = hv.y + y1, o2 = hv.z + y2, o3 = hv.w + y3;
    float ss = wave_sum(o0 * o0 + o1 * o1 + o2 * o2 + o3 * o3);
    if (lane == 0) red[wid] = ss;
    __syncthreads();
    ss = red[0] + red[1] + red[2] + red[3];
    const float rs = rsqrtf(ss * (1.f / DM) + EPS);
    const float4 g = ((const float4*)p.g_fin)[tid];
    float4 ov; ov.x = o0 * rs * g.x; ov.y = o1 * rs * g.y; ov.z = o2 * rs * g.z; ov.w = o3 * rs * g.w;
    ((float4*)(p.out + (size_t)t * DM))[tid] = ov;
    __syncthreads();
}

#endif
__device__ __forceinline__ float* part_ptr(const P& p, int c) {
    return WS(float, OFF_PART) + (size_t)c * T * 128;
}
__device__ __forceinline__ unsigned xcc_id() { return (unsigned)__builtin_amdgcn_s_getreg((3 << 11) | 20) & 7u; }

#define MEMFENCE() asm volatile("" ::: "memory")
typedef float f32x2_t __attribute__((ext_vector_type(2)));
__device__ __forceinline__ float dpp_xor1(float v) { return __builtin_amdgcn_update_dpp(0.f, v, 0xB1, 0xF, 0xF, false); }
__device__ __forceinline__ float dpp_xor2(float v) { return __builtin_amdgcn_update_dpp(0.f, v, 0x4E, 0xF, 0xF, false); }
__device__ __forceinline__ float swz_xor4(float v) { return __int_as_float(__builtin_amdgcn_ds_swizzle(__float_as_int(v), 0x101F)); }
__device__ __forceinline__ float gelu_as(float v) {
    const float av = fabsf(v), t = __builtin_amdgcn_rcpf(av * 0.2316418882f + 1.0f);
    float q = t * 0.5307027145f + (-0.7265760135f); q = q * t + 0.7107068705f; q = q * t + (-0.142248368f); q = q * t + 0.127414796f; q = q * t;
    const float m = v * (q * __builtin_amdgcn_exp2f((v * v) * (-0.72134752044f)));
    return v < 0.f ? m : v - m;
}
__device__ __forceinline__ float group8_transpose_sum(const float (&s)[8], int ch) {
    const bool b0 = ch & 1, b1 = (ch >> 1) & 1, b2 = (ch >> 2) & 1;
    float r4[4], r2[2];
#pragma unroll
    for (int j = 0; j < 4; ++j) { const float keep = b0 ? s[2 * j + 1] : s[2 * j], send = b0 ? s[2 * j] : s[2 * j + 1]; r4[j] = keep + dpp_xor1(send); }
#pragma unroll
    for (int j = 0; j < 2; ++j) { const float keep = b1 ? r4[2 * j + 1] : r4[2 * j], send = b1 ? r4[2 * j] : r4[2 * j + 1]; r2[j] = keep + dpp_xor2(send); }
    const float keep = b2 ? r2[1] : r2[0], send = b2 ? r2[0] : r2[1];
    return keep + swz_xor4(send);
}
constexpr int PEER_TILE = 128;
constexpr int PEER_WTOK = PEER_TILE / 4;
__device__ __forceinline__ void d_peer_e1_run(const P& p, int t0, int c, int lane) {
    const int g8 = lane >> 3, ch = lane & 7;
    const unsigned char* tab = WS(unsigned char, OFF_EDN);
    const unsigned loff = 128u * (unsigned)c + 16u * (unsigned)ch;
    float4 gf[4];
#pragma unroll
    for (int q = 0; q < 4; ++q) gf[q] = *(const float4*)(p.g_ffn + 128 * c + 16 * ch + 4 * q);
    const int4* ip = (const int4*)(WS(int, OFF_PIDX) + (size_t)t0 * 128 + 16 * g8);
    int4 nidx[4];
#pragma unroll
    for (int k = 0; k < 4; ++k) nidx[k] = ip[k];
#pragma unroll 1
    for (int tk = 0; tk < PEER_WTOK; ++tk) {
        const int t = t0 + tk;
        const unsigned idx[16] = {(unsigned)nidx[0].x, (unsigned)nidx[0].y, (unsigned)nidx[0].z, (unsigned)nidx[0].w, (unsigned)nidx[1].x, (unsigned)nidx[1].y, (unsigned)nidx[1].z, (unsigned)nidx[1].w,
                                  (unsigned)nidx[2].x, (unsigned)nidx[2].y, (unsigned)nidx[2].z, (unsigned)nidx[2].w, (unsigned)nidx[3].x, (unsigned)nidx[3].y, (unsigned)nidx[3].z, (unsigned)nidx[3].w};
        uint4 w[16];
#pragma unroll
        for (int k = 0; k < 16; ++k) w[k] = *(const uint4*)(tab + (idx[k] * 1024u + loff));
        const bf16_t* hp = WS(bf16_t, OFF_H2B) + (size_t)t * DM + 128 * c + 16 * ch;
        const uint4 h0 = *(const uint4*)hp, h1 = *(const uint4*)(hp + 8);
        const float rstd = WS(float, OFF_RSTD)[t];
        if (tk + 1 < PEER_WTOK) {
#pragma unroll
            for (int k = 0; k < 4; ++k) nidx[k] = ip[(tk + 1) * 32 + k];
        }
        MEMFENCE();
        f32x2_t x[8];
        {
            const uint32_t hw[8] = {h0.x, h0.y, h0.z, h0.w, h1.x, h1.y, h1.z, h1.w};
#pragma unroll
            for (int q = 0; q < 4; ++q) {
                x[2 * q] = (f32x2_t){__uint_as_float(hw[2 * q] << 16) * rstd * gf[q].x, __uint_as_float(hw[2 * q] & 0xFFFF0000u) * rstd * gf[q].y};
                x[2 * q + 1] = (f32x2_t){__uint_as_float(hw[2 * q + 1] << 16) * rstd * gf[q].z, __uint_as_float(hw[2 * q + 1] & 0xFFFF0000u) * rstd * gf[q].w};
            }
        }
        float res[2];
#pragma unroll
        for (int hh = 0; hh < 2; ++hh) {
            float s[8];
#pragma unroll
            for (int k = 0; k < 8; ++k) {
                const uint4 wk = w[8 * hh + k];
                f32x2_t a2 = __builtin_amdgcn_cvt_pk_f32_fp8((int)wk.x, false) * x[0];
                a2 = __builtin_elementwise_fma(__builtin_amdgcn_cvt_pk_f32_fp8((int)wk.x, true), x[1], a2);
                a2 = __builtin_elementwise_fma(__builtin_amdgcn_cvt_pk_f32_fp8((int)wk.y, false), x[2], a2);
                a2 = __builtin_elementwise_fma(__builtin_amdgcn_cvt_pk_f32_fp8((int)wk.y, true), x[3], a2);
                a2 = __builtin_elementwise_fma(__builtin_amdgcn_cvt_pk_f32_fp8((int)wk.z, false), x[4], a2);
                a2 = __builtin_elementwise_fma(__builtin_amdgcn_cvt_pk_f32_fp8((int)wk.z, true), x[5], a2);
                a2 = __builtin_elementwise_fma(__builtin_amdgcn_cvt_pk_f32_fp8((int)wk.w, false), x[6], a2);
                a2 = __builtin_elementwise_fma(__builtin_amdgcn_cvt_pk_f32_fp8((int)wk.w, true), x[7], a2);
                s[k] = a2[0] + a2[1];
            }
            res[hh] = group8_transpose_sum(s, ch);
        }
        float* pp = part_ptr(p, c) + (size_t)t * 128 + 16 * g8 + ch;
        pp[0] = res[0]; pp[8] = res[1];
    }
}

__device__ __forceinline__ void d_peer_act(const P& p, int vblk, int nvblk) {
    const int lane = ltid() & 63, wv = ltid() >> 6;
    for (int t = vblk * 4 + wv; t < T; t += nvblk * 4) {
        float pu[2][8], gt[2];
#pragma unroll
        for (int k = 0; k < 2; ++k) {
#pragma unroll
            for (int cc = 0; cc < 8; ++cc) pu[k][cc] = part_ptr(p, cc)[(size_t)t * 128 + lane + 64 * k];
            gt[k] = WS(float, OFF_PGATE)[(size_t)t * 128 + lane + 64 * k];
        }
#pragma unroll
        for (int k = 0; k < 2; ++k) {
            const float u = (((pu[k][0] + pu[k][1]) + (pu[k][2] + pu[k][3])) + ((pu[k][4] + pu[k][5]) + (pu[k][6] + pu[k][7]))) * (1.f / 64.f);
            WS(float, OFF_ACT)[(size_t)t * 128 + lane + 64 * k] = gelu_as(u) * gt[k] * 0.125f;
        }
    }
}

__device__ __forceinline__ void d_peer_e2_run(const P& p, int t0, int c, int lane, float* sact) {
    const int g8 = lane >> 3, ch = lane & 7;
    const unsigned char* tab = WS(unsigned char, OFF_EUP);
    const unsigned loff = 128u * (unsigned)c + 16u * (unsigned)ch;
    const bool b3 = (lane >> 3) & 1, b4 = (lane >> 4) & 1, b5 = (lane >> 5) & 1;
    const int col = 128 * c + 16 * ch + 8 * (int)b3 + 4 * (int)b4 + 2 * (int)b5;
    const int4* ip = (const int4*)(WS(int, OFF_PIDX) + (size_t)t0 * 128 + 16 * g8);
    const float4* ap = (const float4*)(WS(float, OFF_ACT) + (size_t)t0 * 128 + 16 * g8);
    int4 nidx[4]; float4 nact[4];
#pragma unroll
    for (int k = 0; k < 4; ++k) { nidx[k] = ip[k]; nact[k] = ap[k]; }
#pragma unroll 1
    for (int tk = 0; tk < PEER_WTOK; ++tk) {
        const int t = t0 + tk;
        const unsigned idx[16] = {(unsigned)nidx[0].x, (unsigned)nidx[0].y, (unsigned)nidx[0].z, (unsigned)nidx[0].w, (unsigned)nidx[1].x, (unsigned)nidx[1].y, (unsigned)nidx[1].z, (unsigned)nidx[1].w,
                                  (unsigned)nidx[2].x, (unsigned)nidx[2].y, (unsigned)nidx[2].z, (unsigned)nidx[2].w, (unsigned)nidx[3].x, (unsigned)nidx[3].y, (unsigned)nidx[3].z, (unsigned)nidx[3].w};
        const float a[16] = {nact[0].x, nact[0].y, nact[0].z, nact[0].w, nact[1].x, nact[1].y, nact[1].z, nact[1].w, nact[2].x, nact[2].y, nact[2].z, nact[2].w, nact[3].x, nact[3].y, nact[3].z, nact[3].w};
        uint4 w[16];
#pragma unroll
        for (int k = 0; k < 16; ++k) w[k] = *(const uint4*)(tab + (idx[k] * 1024u + loff));
        const uint32_t hb = *(const uint32_t*)(WS(bf16_t, OFF_H2B) + (size_t)t * DM + col);
        if (tk + 1 < PEER_WTOK) {
#pragma unroll
            for (int k = 0; k < 4; ++k) { nidx[k] = ip[(tk + 1) * 32 + k]; nact[k] = ap[(tk + 1) * 32 + k]; }
        }
        MEMFENCE();
        f32x2_t y[8];
#pragma unroll
        for (int k = 0; k < 8; ++k) y[k] = (f32x2_t){0.f, 0.f};
#pragma unroll
        for (int k = 0; k < 16; ++k) {
            const f32x2_t av = (f32x2_t){a[k], a[k]};
            const uint4 wk = w[k];
            y[0] = __builtin_elementwise_fma(__builtin_amdgcn_cvt_pk_f32_fp8((int)wk.x, false), av, y[0]);
            y[1] = __builtin_elementwise_fma(__builtin_amdgcn_cvt_pk_f32_fp8((int)wk.x, true), av, y[1]);
            y[2] = __builtin_elementwise_fma(__builtin_amdgcn_cvt_pk_f32_fp8((int)wk.y, false), av, y[2]);
            y[3] = __builtin_elementwise_fma(__builtin_amdgcn_cvt_pk_f32_fp8((int)wk.y, true), av, y[3]);
            y[4] = __builtin_elementwise_fma(__builtin_amdgcn_cvt_pk_f32_fp8((int)wk.z, false), av, y[4]);
            y[5] = __builtin_elementwise_fma(__builtin_amdgcn_cvt_pk_f32_fp8((int)wk.z, true), av, y[5]);
            y[6] = __builtin_elementwise_fma(__builtin_amdgcn_cvt_pk_f32_fp8((int)wk.w, false), av, y[6]);
            y[7] = __builtin_elementwise_fma(__builtin_amdgcn_cvt_pk_f32_fp8((int)wk.w, true), av, y[7]);
        }
        f32x2_t k4[4], k2[2], k1;
#pragma unroll
        for (int k = 0; k < 4; ++k) {
            const f32x2_t keep = b3 ? y[4 + k] : y[k], send = b3 ? y[k] : y[4 + k];
            k4[k] = keep + (f32x2_t){__shfl_xor(send[0], 8), __shfl_xor(send[1], 8)};
        }
#pragma unroll
        for (int k = 0; k < 2; ++k) {
            const f32x2_t keep = b4 ? k4[2 + k] : k4[k], send = b4 ? k4[k] : k4[2 + k];
            k2[k] = keep + (f32x2_t){__shfl_xor(send[0], 16), __shfl_xor(send[1], 16)};
        }
        {
            const f32x2_t keep = b5 ? k2[1] : k2[0], send = b5 ? k2[0] : k2[1];
            k1 = keep + (f32x2_t){__shfl_xor(send[0], 32), __shfl_xor(send[1], 32)};
        }
        float2 o;
        o.x = __uint_as_float(hb << 16) + k1[0]; o.y = __uint_as_float(hb & 0xFFFF0000u) + k1[1];
        *(float2*)(p.out + (size_t)t * DM + col) = o;
        float ss = row_sum16(o.x * o.x + o.y * o.y);
        ss += __shfl_xor(ss, 16); ss += __shfl_xor(ss, 32);
        if (lane == 0) WS(float, OFF_SSQ2)[(size_t)c * T + t] = ss;
    }
}

template <int PHASE> __device__ __forceinline__ void ph_peer_sliced(const P& p, char* shm, int rep) {
    int* s_tile = (int*)shm;
    float* sact = (float*)(shm + 64) + (ltid() >> 6) * 128;
    const int tid = ltid(), lane = tid & 63, wid = tid >> 6;
    unsigned* qc = WS(unsigned, OFF_QCNT) + (PHASE == 2 ? 8 : 0) + 16 * rep;
    const unsigned x0 = xcc_id();
    for (int dc = 0; dc < 8; ++dc) {
        const int c = (int)((x0 + dc) & 7u);
        __syncthreads();
        if (tid == 0) *s_tile = (int)atomicAdd(&qc[c], 1u);
        __syncthreads();
        int tile = *s_tile;
        while (tile < T / PEER_TILE) {
            __syncthreads();
            int nxt = 0;
            if (tid == 0) nxt = (int)atomicAdd(&qc[c], 1u);
            const int t0 = tile * PEER_TILE + wid * PEER_WTOK;
            if (PHASE == 1) d_peer_e1_run(p, t0, c, lane); else d_peer_e2_run(p, t0, c, lane, sact);
            if (tid == 0) *s_tile = nxt;
            __syncthreads();
            tile = *s_tile;
        }
    }
}

__device__ __forceinline__ void d_peer_e3(const P& p, int t) {
    const int tid = ltid();
    float s = 0.f;
#pragma unroll
    for (int c = 0; c < 8; ++c) s += WS(float, OFF_SSQ2)[(size_t)c * T + t];
    const float rs = rsqrtf(s * (1.f / DM) + EPS);
    float4* op = (float4*)(p.out + (size_t)t * DM) + tid;
    const float4 g = ((const float4*)p.g_fin)[tid];
    float4 v = *op;
    v.x *= rs * g.x; v.y *= rs * g.y; v.z *= rs * g.z; v.w *= rs * g.w;
    *op = v;
}

#define XB_TMO      128
#define XB_XCNT(j)  (256  + 64 * (j))
#define XB_XSUB(j)  (1280 + 64 * (j))
#define XB_XGEN(j)  (2304 + 64 * (j))
#define XB_TOP      3328
#define XB_TOPGEN   3392
#define XCD_BAR_WORDS 3456
#define XB_SPIN_CAP (1u << 22)
#define LAS __attribute__((address_space(3)))
__device__ __forceinline__ unsigned xb_ld(unsigned* p) { return __hip_atomic_load(p, __ATOMIC_RELAXED, __HIP_MEMORY_SCOPE_AGENT); }
__device__ __forceinline__ unsigned xb_add(unsigned* p, unsigned v) { return __hip_atomic_fetch_add(p, v, __ATOMIC_RELAXED, __HIP_MEMORY_SCOPE_AGENT); }
__device__ __forceinline__ unsigned xb_xcc_id() { return (unsigned)__builtin_amdgcn_s_getreg((3 << 11) | 20) & 0xFu; }
#define XB_SPIN(cond, bar) do { unsigned _sp = 0; while (cond) { __builtin_amdgcn_s_sleep(1); \
    if ((++_sp & 255u) == 0u) { if (xb_ld(&(bar)[XB_TMO])) break; if (_sp > XB_SPIN_CAP) { atomicAdd(&(bar)[XB_TMO], 1u); break; } } } } while (0)
struct XcdBarrier { unsigned* bar; unsigned x; volatile LAS unsigned* st; };
__device__ __forceinline__ XcdBarrier xcd_barrier_post(unsigned* bar, volatile LAS unsigned* st) {
    XcdBarrier b; b.bar = bar; b.x = xb_xcc_id(); b.st = st;
    if (threadIdx.x == 0) (void)xb_add(&bar[XB_XCNT(b.x)], 1u);
    return b;
}
__device__ __forceinline__ void xcd_barrier_complete(unsigned* bar, unsigned x, unsigned& nloc, unsigned& nx) {
    const unsigned G = gridDim.x * gridDim.y * gridDim.z;
    unsigned sum, cnt, mine, sp = 0u;
    for (;;) {
        sum = 0u; cnt = 0u; mine = 0u;
#pragma unroll
        for (unsigned j = 0; j < 16; ++j) { const unsigned c = xb_ld(&bar[XB_XCNT(j)]); sum += c; cnt += (c > 0u) ? 1u : 0u; mine = (j == x) ? c : mine; }
        if (sum == G) break;
        __builtin_amdgcn_s_sleep(1);
        if ((++sp & 255u) == 0u) { if (xb_ld(&bar[XB_TMO])) break; if (sp > XB_SPIN_CAP) { atomicAdd(&bar[XB_TMO], 1u); break; } }
    }
    nloc = mine > 0u ? mine : 1u; nx = cnt > 0u ? cnt : 1u;
}
__device__ __forceinline__ void xcd_barrier(const XcdBarrier& b) {
    asm volatile("s_waitcnt vmcnt(0)" ::: "memory");
    __syncthreads();
    if (threadIdx.x == 0) {
        unsigned* bar = b.bar;
        __builtin_amdgcn_s_waitcnt(0);
        unsigned nloc = b.st[0], nx = b.st[1];
        if (nloc == 0u) { xcd_barrier_complete(bar, b.x, nloc, nx); b.st[0] = nloc; b.st[1] = nx; }
        const unsigned old = xb_add(&bar[XB_XSUB(b.x)], 1u);
        const unsigned gen = old / nloc;
        if (old + 1u == (gen + 1u) * nloc) {
            __builtin_amdgcn_fence(__ATOMIC_RELEASE, "agent");
            asm volatile("s_waitcnt vmcnt(0)" ::: "memory");
            const unsigned og = xb_add(&bar[XB_TOP], 1u);
            const unsigned tg = og / nx;
            if (og + 1u == (tg + 1u) * nx) xb_add(&bar[XB_TOPGEN], 1u);
            else XB_SPIN(xb_ld(&bar[XB_TOPGEN]) == tg, bar);
            __builtin_amdgcn_fence(__ATOMIC_ACQUIRE, "agent");
            xb_add(&bar[XB_XGEN(b.x)], 1u);
            asm volatile("s_waitcnt vmcnt(0)" ::: "memory");
        } else {
            XB_SPIN(xb_ld(&bar[XB_XGEN(b.x)]) == gen, bar);
            __builtin_amdgcn_fence(__ATOMIC_ACQUIRE, "agent");
            asm volatile("s_waitcnt vmcnt(0)" ::: "memory");
        }
    }
    __syncthreads();
}

#define REP_P0 1
#define REP_P1 1
#define REP_P2 1
#define REP_P2C 1
#define REP_P3 1
#define REP_P4G 1
#define REP_P4C 1
#define REP_P5 1
#define REP_P6 1
#define REP_P9 1
#define REP_E1 1
#define REP_E2 1
#define REPEAT(N) for (int rep_ = 0; rep_ < (N); ++rep_)
constexpr int SHM_BYTES = 65536;
__global__ void __launch_bounds__(256, 2) mega(P p) {
    __shared__ __attribute__((aligned(16))) char shm[SHM_BYTES + 16];
    const int G = gridDim.x, bid = blockIdx.x;
    volatile LAS unsigned* xst = (volatile LAS unsigned*)(shm + SHM_BYTES);
    if (threadIdx.x == 0) { xst[0] = 0u; xst[1] = 0u; }
    __syncthreads();
    const XcdBarrier xb = xcd_barrier_post(WS(unsigned, OFF_BAR), xst);

    {
        constexpr int U_WIN = (NIN / 64) * 16, U_WUA = 16 * 8, U_WUR = 16 * 8, U_WOUT = 16 * 16, U_WQ = 16 * 16, U_KEYS = 32, U_MISC = (LP * 8 + 255) / 256;
        constexpr int E0 = U_WIN, E1 = E0 + U_WUA, E2 = E1 + U_WUR, E3 = E2 + U_WOUT, E4 = E3 + U_WQ, E5 = E4 + U_KEYS, E6 = E5 + U_MISC, E7 = E6 + R / 4;
        if (bid == 0 && threadIdx.x < 64) WS(unsigned, OFF_QCNT)[threadIdx.x] = 0u;
        REPEAT(REP_P0)
        for (int u = bid; u < E7; u += G) {
            if (u < E0) d_transpose(p.w_in, WS(bf16_t, OFF_WIN), 1024, NIN, nullptr, u, shm);
            else if (u < E1) d_transpose(p.w_ua, WS(bf16_t, OFF_WUA), 512, 1024, nullptr, u - E0, shm);
            else if (u < E2) d_transpose(p.w_ur, WS(bf16_t, OFF_WUR), 512, 1024, nullptr, u - E1, shm);
            else if (u < E3) d_transpose(p.w_out, WS(bf16_t, OFF_WOUT), 1024, 1024, nullptr, u - E2, shm);
            else if (u < E4) d_transpose(p.w_q, WS(bf16_t, OFF_WQ), 1024, 1024, p.g_ffn, u - E3, shm);
            else if (u < E5) d_cvt(p.keys, WS(bf16_t, OFF_KEYS), (size_t)16 * 128 * 64 / 4, u - E4, U_KEYS);
            else if (u < E6) d_misc(p, u - E5);
            else d_rmsnorm_in(p, u - E6);
        }
    }
    xcd_barrier(xb);
    REPEAT(REP_P1) ph_gemm_inproj(p, shm);
    xcd_barrier(xb);
    REPEAT(REP_P2)
    for (int u = bid; u < 2048; u += G) { if (u < 1024) d_hgrn_A(p, u, shm); else d_attn(p, u - 1024, shm); }
    xcd_barrier(xb);
    for (int u = bid; u < 512; u += G) d_hgrn_scan(p, u);
    xcd_barrier(xb);
    REPEAT(REP_P2C)
    for (int u = bid; u < 1024; u += G) d_hgrn_C(p, u, shm);
    xcd_barrier(xb);
    REPEAT(REP_P3) ph_gemm_merge(p, shm);
    xcd_barrier(xb);
    REPEAT(REP_P4G) ph_gemm_out(p, shm);
    REPEAT(REP_P4C) {
    d_cvt8(p.edown, WS(unsigned char, OFF_EDN), (size_t)16384 * 1024 / 16, 64.f, bid, G);
    d_cvt8(p.eup, WS(unsigned char, OFF_EUP), (size_t)16384 * 1024 / 16, 8.f, bid, G); }
    xcd_barrier(xb);
    REPEAT(REP_P5) ph_peer_qry_topk(p, shm);
    xcd_barrier(xb);
    REPEAT(REP_E1) ph_peer_sliced<1>(p, shm, rep_);
    xcd_barrier(xb);
    d_peer_act(p, bid, G);
    xcd_barrier(xb);
    REPEAT(REP_E2) ph_peer_sliced<2>(p, shm, rep_);
    xcd_barrier(xb);
    REPEAT(REP_P9)
    for (int t = bid; t < T; t += G) d_peer_e3(p, t);
}

extern "C" void kernel_launch(void* const* d_in, const int* in_sizes, int n_in, void* d_out, int out_size, void* d_ws, size_t ws_size, hipStream_t stream) {
    P p{};
    p.x = (const float*)d_in[0]; p.meta = (const float*)d_in[1]; p.g_mix = (const float*)d_in[2]; p.w_in = (const float*)d_in[3];
    p.b_in = (const float*)d_in[4]; p.sinks = (const float*)d_in[5]; p.lb_logits = (const float*)d_in[6]; p.g_rec = (const float*)d_in[7];
    p.w_ua = (const float*)d_in[8]; p.w_ur = (const float*)d_in[9]; p.w_out = (const float*)d_in[10]; p.g_ffn = (const float*)d_in[11];
    p.w_q = (const float*)d_in[12]; p.keys = (const float*)d_in[13]; p.edown = (const float*)d_in[14]; p.eup = (const float*)d_in[15];
    p.g_fin = (const float*)d_in[16];
    p.out = (float*)d_out; p.ws = (char*)d_ws;
    static int grid_blocks = 0;
    if (!grid_blocks) {
        int dev = 0, cus = 0, per_cu = 0;
        (void)hipGetDevice(&dev);
        (void)hipDeviceGetAttribute(&cus, hipDeviceAttributeMultiprocessorCount, dev);
        (void)hipOccupancyMaxActiveBlocksPerMultiprocessor(&per_cu, mega, 256, 0);
        if (per_cu > 2) per_cu = 2;
        if (per_cu < 1) per_cu = 1;
        grid_blocks = cus * per_cu;
    }
    (void)hipMemsetAsync((char*)d_ws + OFF_BAR, 0, XCD_BAR_WORDS * 4, stream);
    void* args[] = {&p};
    hipError_t e = hipLaunchCooperativeKernel((void*)mega, dim3(grid_blocks), dim3(256), args, 0, stream);
    if (e != hipSuccess) fprintf(stderr, "cooperative launch failed: %s (grid %d)\n", hipGetErrorString(e), grid_blocks);
}
```

```cpp
#include <hip/hip_runtime.h>
#include <hip/hip_cooperative_groups.h>
#include <stdint.h>
#include <stdio.h>
namespace cg = cooperative_groups;

typedef unsigned short bf16_t;
typedef short bf16x8 __attribute__((ext_vector_type(8)));
typedef float f32x4 __attribute__((ext_vector_type(4)));

constexpr int NB = 4, SEQ = 4096, DM = 1024, LP = 4224, PADF = 112;
constexpr int R = NB * LP;
constexpr int T = NB * SEQ;
constexpr int NIN = 4864;
constexpr float EPS = 1e-6f;

constexpr size_t MiB = 1024 * 1024;
constexpr size_t OFF_WUA = 0;
constexpr size_t OFF_WUR = 1 * MiB;
constexpr size_t OFF_WOUT = 2 * MiB;
constexpr size_t OFF_WQ = 4 * MiB;
constexpr size_t OFF_KEYS = 6 * MiB;
constexpr size_t OFF_ROPE = 6 * MiB + 256 * 1024;
constexpr size_t OFF_LB = OFF_ROPE + 272 * 1024;
constexpr size_t OFF_SSQ = 7 * MiB;
constexpr size_t OFF_B = 8 * MiB;
constexpr size_t OFF_QB = OFF_B;
constexpr size_t OFF_KB = OFF_QB + (size_t)R * 512 * 2;
constexpr size_t OFF_VB = OFF_KB + (size_t)R * 128 * 2;
constexpr size_t OFF_RQ = OFF_VB + (size_t)R * 128 * 2;
constexpr size_t OFF_LOGF = OFF_RQ + (size_t)R * 512 * 2;
constexpr size_t OFF_RI = OFF_LOGF + (size_t)R * 512 * 4;
constexpr size_t OFF_RG = OFF_RI + (size_t)R * 512 * 2;
constexpr size_t OFF_GA = OFF_RG + (size_t)R * 512 * 2;
constexpr size_t OFF_GR = OFF_GA + (size_t)R * 1024 * 2;
constexpr size_t OFF_C = OFF_GR + (size_t)R * 1024 * 2;
constexpr size_t OFF_XN = OFF_C;
constexpr size_t OFF_WIN = OFF_XN + (size_t)R * 1024 * 2;
constexpr size_t OFF_TAIL = OFF_WIN + (size_t)NIN * 1024 * 2;
constexpr size_t OFF_DS = OFF_TAIL;
constexpr size_t OFF_ATT = OFF_GA;
constexpr size_t OFF_REC = OFF_ATT + (size_t)T * 512 * 2;
constexpr size_t OFF_MRG = OFF_LOGF;
constexpr size_t OFF_H2B = OFF_RI;
constexpr size_t OFF_EDN = OFF_C;
constexpr size_t OFF_EUP = OFF_EDN + (size_t)16384 * 1024;
constexpr size_t OFF_QRY = OFF_QB;
constexpr size_t OFF_PIDX = OFF_MRG;
constexpr size_t OFF_PGATE = OFF_PIDX + (size_t)T * 128 * 4;
constexpr size_t OFF_RSTD = OFF_LB + 4096;
constexpr size_t OFF_BAR = 6 * MiB + 640 * 1024;
constexpr size_t OFF_QCNT = OFF_LB + 2048;
constexpr size_t OFF_PART = OFF_GA;
constexpr size_t OFF_ACT = OFF_QB + 1 * MiB;
constexpr size_t OFF_SSQ2 = OFF_QB;
static_assert(OFF_SSQ2 + (size_t)8 * T * 4 <= OFF_ACT && OFF_ACT + (size_t)T * 128 * 4 <= OFF_LOGF, "ssq2/act overlay");
static_assert(OFF_PART + 8 * (size_t)T * 128 * 4 <= OFF_C, "part overlay");
static_assert(OFF_QCNT + 256 <= OFF_RSTD && OFF_RSTD + (size_t)T * 4 <= OFF_BAR && OFF_BAR + 3456 * 4 <= OFF_SSQ, "qcnt/rstd/bar");
static_assert(OFF_EUP + (size_t)16384 * 1024 * 2 <= 256 * MiB, "ws overflow");
static_assert(OFF_DS + (size_t)16 * 64 * 16384 * 2 <= 256 * MiB, "ws overflow");
static_assert(OFF_REC + (size_t)T * 512 * 2 <= OFF_C, "overlay");
static_assert(OFF_QRY + (size_t)T * 1024 * 2 <= OFF_LOGF, "qry overlay");
static_assert(OFF_PGATE + (size_t)T * 128 * 4 <= OFF_RI, "pidx overlay");

struct P {
    const float *x, *meta, *g_mix, *w_in, *b_in, *sinks, *lb_logits, *g_rec, *w_ua, *w_ur, *w_out, *g_ffn, *w_q, *keys, *edown, *eup, *g_fin;
    float* out;
    char* ws;
};
#define WS(type, off) ((type*)(p.ws + (off)))

__device__ __forceinline__ int ltid() { int t = threadIdx.x; asm volatile("" : "+v"(t)); return t; }
typedef __bf16 bf16pair_t __attribute__((ext_vector_type(2)));
typedef float f32pair_t __attribute__((ext_vector_type(2)));
__device__ __forceinline__ uint32_t pack2(float lo, float hi) {
    union { bf16pair_t b; uint32_t u; } r; r.b = __builtin_convertvector((f32pair_t){lo, hi}, bf16pair_t); return r.u;
}
__device__ __forceinline__ bf16_t f2bf(float f) { union { __bf16 b; bf16_t u; } r; r.b = (__bf16)f; return r.u; }
__device__ __forceinline__ float bf2f(bf16_t h) { return __uint_as_float(((uint32_t)h) << 16); }
__device__ __forceinline__ float sigmoidf_(float v) { return 1.f / (1.f + __expf(-v)); }

__device__ __forceinline__ float wave_sum(float v) {
#pragma unroll
    for (int o = 32; o > 0; o >>= 1) v += __shfl_xor(v, o);
    return v;
}

typedef __bf16 bf16v2 __attribute__((ext_vector_type(2)));
__device__ __forceinline__ float dot2bf(uint32_t a, uint32_t b, float c) {
    union { uint32_t u; bf16v2 v; } x, y; x.u = a; y.u = b;
    return __builtin_amdgcn_fdot2_f32_bf16(x.v, y.v, c, false);
}
__device__ __forceinline__ float row_sum16(float v) {
    v += __builtin_amdgcn_update_dpp(0.f, v, 0xB1, 0xF, 0xF, false);
    v += __builtin_amdgcn_update_dpp(0.f, v, 0x4E, 0xF, 0xF, false);
    v += __builtin_amdgcn_update_dpp(0.f, v, 0x141, 0xF, 0xF, false);
    v += __builtin_amdgcn_update_dpp(0.f, v, 0x140, 0xF, 0xF, false);
    return v;
}
#define MEMFENCE() asm volatile("" ::: "memory")
__device__ __forceinline__ void d_transpose(const float* __restrict__ W, bf16_t* __restrict__ Wt, int K, int N, const float* __restrict__ rs, int unit, char* shm) {
    float (*tile)[65] = (float (*)[65])shm;
    const int tid = ltid(), ntn = N / 64;
    const int k0 = (unit / ntn) * 64, n0 = (unit % ntn) * 64, tx = tid & 15, ty = tid >> 4;
#pragma unroll
    for (int i = 0; i < 4; ++i) {
        const int k = k0 + ty + 16 * i;
        const float4 v = *(const float4*)(W + (size_t)k * N + n0 + 4 * tx);
        const float s = rs ? rs[k] : 1.f;
        tile[ty + 16 * i][4 * tx + 0] = v.x * s; tile[ty + 16 * i][4 * tx + 1] = v.y * s; tile[ty + 16 * i][4 * tx + 2] = v.z * s; tile[ty + 16 * i][4 * tx + 3] = v.w * s;
    }
    __syncthreads();
    {
        const int n = tid >> 2, kc = (tid & 3) * 16;
        uint32_t w[8];
#pragma unroll
        for (int j = 0; j < 8; ++j) w[j] = pack2(tile[kc + 2 * j][n], tile[kc + 2 * j + 1][n]);
        uint4* dst = (uint4*)(Wt + (size_t)(n0 + n) * K + k0 + kc);
        dst[0] = make_uint4(w[0], w[1], w[2], w[3]); dst[1] = make_uint4(w[4], w[5], w[6], w[7]);
    }
    __syncthreads();
}


__device__ __forceinline__ void d_cvt(const float* __restrict__ src, bf16_t* __restrict__ dst, size_t n4, int vblk, int nvblk) {
    for (size_t i = (size_t)vblk * 256 + ltid(); i < n4; i += (size_t)nvblk * 256) {
        const float4 v = ((const float4*)src)[i];
        ushort4 o; o.x = f2bf(v.x); o.y = f2bf(v.y); o.z = f2bf(v.z); o.w = f2bf(v.w);
        ((ushort4*)dst)[i] = o;
    }
}

__device__ __forceinline__ void d_cvt8(const float* __restrict__ src, unsigned char* __restrict__ dst, size_t n16, float scale, int vblk, int nvblk) {
    for (size_t i = (size_t)vblk * 256 + ltid(); i < n16; i += (size_t)nvblk * 256) {
        const float4* s = (const float4*)src + i * 4;
        uint32_t w[4];
#pragma unroll
        for (int q = 0; q < 4; ++q) {
            const float4 v = s[q];
            int pk = 0;
            pk = __builtin_amdgcn_cvt_pk_fp8_f32(v.x * scale, v.y * scale, pk, false);
            pk = __builtin_amdgcn_cvt_pk_fp8_f32(v.z * scale, v.w * scale, pk, true);
            w[q] = (uint32_t)pk;
        }
        ((uint4*)dst)[i] = make_uint4(w[0], w[1], w[2], w[3]);
    }
}

__device__ __forceinline__ void d_misc(const P& p, int unit) {
    const int gid = unit * 256 + ltid();
    if (gid < LP * 8) {
        const int pp = gid >> 3, i = gid & 7;
        const double inv = (i == 0) ? 1.0 : (i == 1) ? 0.19392274474868576 : (i == 2) ? 0.03760603093086393 : (i == 3) ? 0.007292664737217109 :
                           (i == 4) ? 0.001414213562373095 : (i == 5) ? 0.0002742481756762073 : (i == 6) ? 5.318295896944988e-05 : 1.031338537721246e-05;
        const double ang = (double)(pp - PADF) * inv;
        const double red = ang - 6.283185307179586476925 * __builtin_rint(ang * 0.15915494309189533577);
        float2 cs; __sincosf((float)red, &cs.y, &cs.x);
        WS(float2, OFF_ROPE)[gid] = cs;
    }
    if (gid < 512) {
        const float l0 = p.lb_logits[gid], l1 = p.lb_logits[512 + gid];
        WS(float, OFF_LB)[gid] = 1.f / (1.f + expf(l1 - l0));
    }
}

__device__ __forceinline__ void d_rmsnorm_in(const P& p, int unit) {
    const int lane = ltid() & 63, r = unit * 4 + (ltid() >> 6), b = r / LP, pp = r % LP;
    bf16_t* dst = WS(bf16_t, OFF_XN) + (size_t)r * DM;
    if (pp < PADF) {
#pragma unroll
        for (int i = 0; i < 2; ++i) ((uint4*)dst)[lane + 64 * i] = make_uint4(0, 0, 0, 0);
        return;
    }
    const float* src = (pp < 128) ? (p.meta + (size_t)(pp - PADF) * DM) : (p.x + ((size_t)b * SEQ + (pp - 128)) * DM);
    float4 v[4];
#pragma unroll
    for (int i = 0; i < 4; ++i) v[i] = ((const float4*)src)[lane * 2 + (i & 1) + 128 * (i >> 1)];
    float ss = 0.f;
#pragma unroll
    for (int i = 0; i < 4; ++i) ss += (v[i].x * v[i].x + v[i].y * v[i].y) + (v[i].z * v[i].z + v[i].w * v[i].w);
    ss = wave_sum(ss);
    const float rstd = rsqrtf(ss * (1.f / DM) + EPS);
#pragma unroll
    for (int hh = 0; hh < 2; ++hh) {
        const float4 g0 = ((const float4*)p.g_mix)[lane * 2 + 128 * hh], g1 = ((const float4*)p.g_mix)[lane * 2 + 1 + 128 * hh];
        const float4 a = v[2 * hh], c = v[2 * hh + 1];
        ((uint4*)dst)[lane + 64 * hh] = make_uint4(pack2(a.x * rstd * g0.x, a.y * rstd * g0.y), pack2(a.z * rstd * g0.z, a.w * rstd * g0.w),
                                                   pack2(c.x * rstd * g1.x, c.y * rstd * g1.y), pack2(c.z * rstd * g1.z, c.w * rstd * g1.w));
    }
}

__device__ __forceinline__ void glds16(const void* src, void* lds) { __builtin_amdgcn_global_load_lds((const unsigned*)src, (unsigned*)lds, 16, 0, 0); }

__device__ __forceinline__ void gemm_kloop(const bf16_t* __restrict__ A, int lda, const bf16_t* __restrict__ Bt, int ldb, int K, int brow, int bcol,
                                           f32x4 (&acc)[4][4], char* shm) {
    const int tid = ltid(), wid = tid >> 6, lane = tid & 63, wr = wid >> 1, wc = wid & 1, fr = lane & 15, fq = lane >> 4;
    const int sr = tid >> 3, sc = ((tid & 7) ^ ((sr >> 1) & 7)) * 8;
    const bf16_t* ag = A + (size_t)(brow + sr) * lda + sc;
    const bf16_t* bg = Bt + (size_t)(bcol + sr) * ldb + sc;
    const int nt = K >> 6;
#pragma unroll
    for (int i = 0; i < 4; ++i) {
        glds16(ag + (size_t)(32 * i) * lda, shm + tid * 16 + i * 4096);
        glds16(bg + (size_t)(32 * i) * ldb, shm + 16384 + tid * 16 + i * 4096);
    }
    asm volatile("s_waitcnt vmcnt(0)" ::: "memory");
    __syncthreads();
    const int arow = wr * 64 + fr, brw = wc * 64 + fr;
    const int swz = (fr >> 1) & 7;
    for (int kt = 0; kt < nt; ++kt) {
        char* SA = shm + (kt & 1) * 32768;
        char* SB = SA + 16384;
        if (kt + 1 < nt) {
            char* NA = shm + ((kt + 1) & 1) * 32768;
#pragma unroll
            for (int i = 0; i < 4; ++i) {
                glds16(ag + (size_t)(32 * i) * lda + (kt + 1) * 64, NA + tid * 16 + i * 4096);
                glds16(bg + (size_t)(32 * i) * ldb + (kt + 1) * 64, NA + 16384 + tid * 16 + i * 4096);
            }
        }
        bf16x8 a[2][4], b[2][4];
#pragma unroll
        for (int ks = 0; ks < 2; ++ks) {
            const int coff = (((ks * 4 + fq) ^ swz) << 4);
#pragma unroll
            for (int m = 0; m < 4; ++m) a[ks][m] = *(const bf16x8*)(SA + (arow + m * 16) * 128 + coff);
#pragma unroll
            for (int n = 0; n < 4; ++n) b[ks][n] = *(const bf16x8*)(SB + (brw + n * 16) * 128 + coff);
        }
        __builtin_amdgcn_s_setprio(1);
#pragma unroll
        for (int ks = 0; ks < 2; ++ks)
#pragma unroll
            for (int m = 0; m < 4; ++m)
#pragma unroll
                for (int n = 0; n < 4; ++n) acc[m][n] = __builtin_amdgcn_mfma_f32_16x16x32_bf16(a[ks][m], b[ks][n], acc[m][n], 0, 0, 0);
        __builtin_amdgcn_s_setprio(0);
        asm volatile("s_waitcnt vmcnt(0)" ::: "memory");
        __syncthreads();
    }
}

__device__ __forceinline__ void zero_acc(f32x4 (&acc)[4][4]) {
#pragma unroll
    for (int m = 0; m < 4; ++m)
#pragma unroll
        for (int n = 0; n < 4; ++n) acc[m][n] = (f32x4){0.f, 0.f, 0.f, 0.f};
}

constexpr int EPI_LD = 136;
__device__ __forceinline__ void tile_store_bf16(const char* shm, bf16_t* dst, int ld) {
    __syncthreads();
    const int t_ = ltid();
#pragma unroll
    for (int i = 0; i < 8; ++i) {
        const int q = t_ + 256 * i, r = q >> 4, c = q & 15;
        *(uint4*)(dst + (size_t)r * ld + c * 8) = *(const uint4*)(shm + (r * EPI_LD + c * 8) * 2);
    }
    __syncthreads();
}

__device__ __forceinline__ void tile_load_bf16(char* shm, const bf16_t* srcp, int ld) {
    const int t_ = ltid();
#pragma unroll
    for (int i = 0; i < 8; ++i) {
        const int q = t_ + 256 * i, r = q >> 4, c = q & 15;
        *(uint4*)(shm + (r * EPI_LD + c * 8) * 2) = *(const uint4*)(srcp + (size_t)r * ld + c * 8);
    }
}

__device__ __forceinline__ void ph_gemm_inproj(const P& p, char* shm) {
    const int tid = ltid(), wid = tid >> 6, lane = tid & 63, wr = wid >> 1, wc = wid & 1, fr = lane & 15, fq = lane >> 4;
    constexpr int NT_N = 2816 / 128, NT_M = R / 128;
    const float2* rope = WS(float2, OFF_ROPE);
    const float* lbv = WS(float, OFF_LB);
    for (int tile = blockIdx.x; tile < NT_N * NT_M; tile += gridDim.x) {
        const int pm = tile / NT_N, pn = tile % NT_N, brow_ = pm * 128, bcol_ = pn * 128;
        f32x4 acc[4][4]; zero_acc(acc);
        int brow = brow_, bcol = bcol_;
        gemm_kloop(WS(bf16_t, OFF_XN), DM, WS(bf16_t, OFF_WIN), DM, DM, brow, bcol, acc, shm);
        asm volatile("" : "+s"(brow), "+s"(bcol));
        if (bcol >= 1280 && bcol < 1792) {
#pragma unroll
            for (int n = 0; n < 4; ++n) {
                const int col = bcol + wc * 64 + n * 16 + fr;
                const float bv = p.b_in[col], lb = lbv[col - 1280];
                float run = 0.f;
#pragma unroll
                for (int m = 0; m < 4; ++m) {
                    float c[4];
#pragma unroll
                    for (int j = 0; j < 4; ++j) {
                        const int row = brow + wr * 64 + m * 16 + fq * 4 + j;
                        const float v = acc[m][n][j] + bv;
                        const float f = lb + (1.f - lb) * sigmoidf_(v);
                        const float lf = ((row % LP) < PADF) ? 0.f : __logf(f);
                        c[j] = lf + (j ? c[j - 1] : 0.f);
                    }
                    const float x = c[3];
                    const float y = __shfl_up(x, 16);
                    float incl = x + (fq >= 1 ? y : 0.f);
                    const float z = __shfl_up(incl, 32);
                    incl += (fq >= 2 ? z : 0.f);
                    const float excl = incl - x;
                    const float tot = __shfl(incl, fr + 48);
#pragma unroll
                    for (int j = 0; j < 4; ++j) {
                        const int row = brow + wr * 64 + m * 16 + fq * 4 + j;
                        WS(float, OFF_LOGF)[(size_t)row * 512 + (col - 1280)] = run + excl + c[j];
                    }
                    run += tot;
                }
            }
        } else {
            bf16_t* st = (bf16_t*)shm;
            const int kind = (bcol < 512) ? 0 : (bcol < 640) ? 1 : (bcol < 2304) ? 2 : 3;
#pragma unroll
            for (int m = 0; m < 4; ++m)
#pragma unroll
                for (int n = 0; n < 4; ++n) {
                    const int cl = wc * 64 + n * 16 + fr;
                    const float bv = p.b_in[bcol + cl];
#pragma unroll
                    for (int j = 0; j < 4; ++j) {
                        const int rl = wr * 64 + m * 16 + fq * 4 + j;
                        float v = acc[m][n][j] + bv;
                        if (kind <= 1) {
                            if (n == 0) {
                                const float other = __shfl_xor(v, 8);
                                const float2 cs = rope[((brow + rl) % LP) * 8 + (fr & 7)];
                                v = (fr < 8) ? (v * cs.x - other * cs.y) : (v * cs.x + other * cs.y);
                            }
                            if (kind == 0) v *= 0.125f;
                        } else if (kind == 3) v = v * sigmoidf_(v);
                        st[rl * EPI_LD + cl] = f2bf(v);
                    }
                }
            bf16_t* dst; int ld;
            if (bcol < 512) { dst = WS(bf16_t, OFF_QB) + bcol; ld = 512; }
            else if (bcol < 640) { dst = WS(bf16_t, OFF_KB); ld = 128; }
            else if (bcol < 768) { dst = WS(bf16_t, OFF_VB); ld = 128; }
            else if (bcol < 1280) { dst = WS(bf16_t, OFF_RQ) + (bcol - 768); ld = 512; }
            else if (bcol < 2304) { dst = WS(bf16_t, OFF_RI) + (bcol - 1792); ld = 512; }
            else { dst = WS(bf16_t, OFF_RG) + (bcol - 2304); ld = 512; }
            tile_store_bf16(shm, dst + (size_t)brow * ld, ld);
        }
    }
}

__device__ __forceinline__ void ph_gemm_merge(const P& p, char* shm) {
    const int tid = ltid(), wid = tid >> 6, lane = tid & 63, wr = wid >> 1, wc = wid & 1, fr = lane & 15, fq = lane >> 4;
    constexpr int NT_N = 8, NT_M = T / 128;
    bf16_t* st = (bf16_t*)shm;
    for (int tile = blockIdx.x; tile < NT_N * NT_M; tile += gridDim.x) {
        const int pm = tile / NT_N, pn = tile % NT_N, brow = pm * 128, bcol = pn * 128;
        const int prow = brow + 128 * (brow / SEQ + 1);
        f32x4 acc[4][4];
        uint32_t sg[4][4];
        uint32_t tt[4][4][2];
#pragma unroll 1
        for (int pass = 0; pass < 2; ++pass) {
            zero_acc(acc);
            gemm_kloop(WS(bf16_t, OFF_XN), DM, WS(bf16_t, OFF_WIN), DM, DM, prow, 2816 + 1024 * pass + bcol, acc, shm);
            int ecol = bcol;
            asm volatile("" : "+s"(ecol));
#pragma unroll
            for (int m = 0; m < 4; ++m)
#pragma unroll
                for (int n = 0; n < 4; ++n) {
                    const float bv = p.b_in[2816 + 1024 * pass + ecol + wc * 64 + n * 16 + fr];
                    uint32_t g8 = 0;
#pragma unroll
                    for (int j = 0; j < 4; ++j) g8 |= (uint32_t)__builtin_rintf(sigmoidf_(acc[m][n][j] + bv) * 255.f) << (8 * j);
                    sg[m][n] = g8;
                }
            zero_acc(acc);
            gemm_kloop(WS(bf16_t, pass ? OFF_REC : OFF_ATT), 512, WS(bf16_t, pass ? OFF_WUR : OFF_WUA), 512, 512, brow, bcol, acc, shm);
            int erow = brow;
            asm volatile("" : "+s"(erow), "+s"(ecol));
            bf16_t* mrg = WS(bf16_t, OFF_MRG) + (size_t)erow * 1024 + ecol;
#pragma unroll
            for (int m = 0; m < 4; ++m)
#pragma unroll
                for (int n = 0; n < 4; ++n) {
                    float v[4];
#pragma unroll
                    for (int j = 0; j < 4; ++j) v[j] = acc[m][n][j] * ((float)((sg[m][n] >> (8 * j)) & 0xFFu) * (1.f / 255.f));
                    if (pass == 0) { tt[m][n][0] = pack2(v[0], v[1]); tt[m][n][1] = pack2(v[2], v[3]); }
                    else {
                        const int cl = wc * 64 + n * 16 + fr, rl = wr * 64 + m * 16 + fq * 4;
                        st[(rl + 0) * EPI_LD + cl] = f2bf(v[0] + __uint_as_float(tt[m][n][0] << 16));
                        st[(rl + 1) * EPI_LD + cl] = f2bf(v[1] + __uint_as_float(tt[m][n][0] & 0xFFFF0000u));
                        st[(rl + 2) * EPI_LD + cl] = f2bf(v[2] + __uint_as_float(tt[m][n][1] << 16));
                        st[(rl + 3) * EPI_LD + cl] = f2bf(v[3] + __uint_as_float(tt[m][n][1] & 0xFFFF0000u));
                    }
                }
            if (pass == 1) tile_store_bf16(shm, mrg, 1024);
        }
    }
}

__device__ __forceinline__ void ph_gemm_out(const P& p, char* shm) {
    const int tid = ltid(), wid = tid >> 6, lane = tid & 63, wr = wid >> 1, wc = wid & 1, fr = lane & 15, fq = lane >> 4;
    constexpr int NT_N = 8, NT_M = T / 128;
    bf16_t* st = (bf16_t*)shm;
    for (int q = blockIdx.x >> 3; q < NT_N * NT_M / 8; q += gridDim.x >> 3) {
        const int pm = 8 * (q >> 3) + (blockIdx.x & 7), pn = q & 7, brow_ = pm * 128, bcol_ = pn * 128;
        f32x4 acc[4][4]; zero_acc(acc);
        int brow = brow_, bcol = bcol_;
        gemm_kloop(WS(bf16_t, OFF_MRG), 1024, WS(bf16_t, OFF_WOUT), 1024, 1024, brow, bcol, acc, shm);
        asm volatile("" : "+s"(brow), "+s"(bcol));
#pragma unroll
        for (int m = 0; m < 4; ++m)
#pragma unroll
            for (int n = 0; n < 4; ++n)
#pragma unroll
                for (int j = 0; j < 4; ++j) st[(wr * 64 + m * 16 + fq * 4 + j) * EPI_LD + wc * 64 + n * 16 + fr] = f2bf(acc[m][n][j]);
        __syncthreads();
#pragma unroll 2
        for (int i = 0; i < 8; ++i) {
            const int q = tid + 256 * i, r = q >> 4, c = q & 15;
            const uint4 a = *(const uint4*)(shm + (r * EPI_LD + c * 8) * 2);
            const float* xp = p.x + (size_t)(brow + r) * DM + bcol + c * 8;
            const float4 x0 = *(const float4*)xp, x1 = *(const float4*)(xp + 4);
            const float h0 = x0.x + __uint_as_float(a.x << 16), h1 = x0.y + __uint_as_float(a.x & 0xFFFF0000u);
            const float h2 = x0.z + __uint_as_float(a.y << 16), h3 = x0.w + __uint_as_float(a.y & 0xFFFF0000u);
            const float h4 = x1.x + __uint_as_float(a.z << 16), h5 = x1.y + __uint_as_float(a.z & 0xFFFF0000u);
            const float h6 = x1.z + __uint_as_float(a.w << 16), h7 = x1.w + __uint_as_float(a.w & 0xFFFF0000u);
            *(uint4*)(WS(bf16_t, OFF_H2B) + (size_t)(brow + r) * DM + bcol + c * 8) = make_uint4(pack2(h0, h1), pack2(h2, h3), pack2(h4, h5), pack2(h6, h7));
            float ss = (h0 * h0 + h1 * h1) + (h2 * h2 + h3 * h3) + (h4 * h4 + h5 * h5) + (h6 * h6 + h7 * h7);
            ss = row_sum16(ss);
            if (c == 0) WS(float, OFF_SSQ)[(size_t)pn * T + brow + r] = ss;
        }
        __syncthreads();
    }
}

__device__ __forceinline__ float row_rstd(const P& p, int row) {
    float s = 0.f;
#pragma unroll
    for (int i = 0; i < 8; ++i) s += WS(float, OFF_SSQ)[(size_t)i * T + row];
    return rsqrtf(s * (1.f / DM) + EPS);
}

__device__ __forceinline__ void ph_gemm_qry(const P& p, char* shm) {
    const int tid = ltid(), wid = tid >> 6, lane = tid & 63, wr = wid >> 1, wc = wid & 1, fr = lane & 15, fq = lane >> 4;
    constexpr int NT_N = 8, NT_M = T / 128;
    for (int tile = blockIdx.x; tile < NT_N * NT_M; tile += gridDim.x) {
        const int pm = tile / NT_N, pn = tile % NT_N, brow_ = pm * 128, bcol_ = pn * 128;
        f32x4 acc[4][4]; zero_acc(acc);
        int brow = brow_, bcol = bcol_;
        gemm_kloop(WS(bf16_t, OFF_H2B), 1024, WS(bf16_t, OFF_WQ), 1024, 1024, brow, bcol, acc, shm);
        asm volatile("" : "+s"(brow), "+s"(bcol));
#pragma unroll
        for (int m = 0; m < 4; ++m)
#pragma unroll
            for (int j = 0; j < 4; ++j) {
                const int row = brow + wr * 64 + m * 16 + fq * 4 + j;
                const float rstd = row_rstd(p, row);
                if (bcol == 0 && wc == 0 && fr == 0) WS(float, OFF_RSTD)[row] = rstd;
#pragma unroll
                for (int n = 0; n < 4; ++n) {
                    const int col = bcol + wc * 64 + n * 16 + fr;
                    WS(bf16_t, OFF_QRY)[(size_t)row * DM + col] = f2bf(acc[m][n][j] * rstd);
                }
            }
    }
}

#if ATTN_SIMPLE
__device__ __forceinline__ void d_attn_simple(const P& p, int unit) {
    const int gid = unit * 256 + ltid();
    const int hq = gid / T, t = gid % T, b = t / SEQ, s = t % SEQ, pq = 128 + s, kvh = hq >> 2;
    const bf16_t* qp = WS(bf16_t, OFF_QB) + ((size_t)b * LP + pq) * 512 + hq * 64;
    float q[64], o[64];
#pragma unroll
    for (int d = 0; d < 64; ++d) { q[d] = bf2f(qp[d]); o[d] = 0.f; }
    float m = p.sinks[hq], l = 1.f;
    const bf16_t* kbase = WS(bf16_t, OFF_KB) + (size_t)b * LP * 128 + kvh * 64;
    const bf16_t* vbase = WS(bf16_t, OFF_VB) + (size_t)b * LP * 128 + kvh * 64;
    const int lo = (pq - 127 > 128) ? (pq - 127) : 128;
    const int nkeys = 16 + (pq - lo + 1);
    for (int i = 0; i < nkeys; ++i) {
        const int pk = (i < 16) ? (PADF + i) : (lo + i - 16);
        const bf16_t* kp = kbase + (size_t)pk * 128;
        const bf16_t* vp = vbase + (size_t)pk * 128;
        float sc = 0.f;
#pragma unroll
        for (int d = 0; d < 64; ++d) sc += q[d] * bf2f(kp[d]);
        const float mn = fmaxf(m, sc), a = __expf(m - mn), e = __expf(sc - mn);
        l = l * a + e;
#pragma unroll
        for (int d = 0; d < 64; ++d) o[d] = o[d] * a + e * bf2f(vp[d]);
        m = mn;
    }
    const float inv = 1.f / l;
    bf16_t* op = WS(bf16_t, OFF_ATT) + (size_t)t * 512 + hq * 64;
#pragma unroll
    for (int d = 0; d < 64; ++d) op[d] = f2bf(o[d] * inv);
}

#endif
constexpr int LDV = 280;
__device__ __forceinline__ void d_attn(const P& p, int unit, char* shm) {
    bf16_t* VT = (bf16_t*)shm;
    const int tid = ltid(), lane = tid & 63, fr = lane & 15, fq = lane >> 4;
    const int w = __builtin_amdgcn_readfirstlane(tid >> 6);
    const int hq = unit & 7, n = ((unit >> 3) & 31) + 1, b = unit >> 8, kvh = hq >> 2;
    const size_t rb = (size_t)b * LP;
    const int kb0 = 128 * (n - 1);
    const bf16_t* kbp = WS(bf16_t, OFF_KB) + kvh * 64;
    const bf16_t* vbp = WS(bf16_t, OFF_VB) + kvh * 64;
#pragma unroll 1
    for (int i = 0; i < 9; ++i) {
        const int c = tid + 256 * i;
        if (c < 2176) {
            const int x = c >> 3, dc = c & 7;
            const int pos = (x < 256) ? (kb0 + x) : (PADF + x - 256);
            const uint4 v = *(const uint4*)(vbp + (rb + pos) * 128 + 8 * dc);
            bf16_t* dst = VT + (8 * dc) * LDV + x;
            dst[0 * LDV] = (bf16_t)(v.x & 0xFFFF); dst[1 * LDV] = (bf16_t)(v.x >> 16);
            dst[2 * LDV] = (bf16_t)(v.y & 0xFFFF); dst[3 * LDV] = (bf16_t)(v.y >> 16);
            dst[4 * LDV] = (bf16_t)(v.z & 0xFFFF); dst[5 * LDV] = (bf16_t)(v.z >> 16);
            dst[6 * LDV] = (bf16_t)(v.w & 0xFFFF); dst[7 * LDV] = (bf16_t)(v.w >> 16);
        }
    }
    __syncthreads();
    bf16x8 qf[2][2];
#pragma unroll
    for (int u = 0; u < 2; ++u)
#pragma unroll
        for (int ks = 0; ks < 2; ++ks)
            qf[u][ks] = *(const bf16x8*)(WS(bf16_t, OFF_QB) + (rb + 128 * n + 32 * w + 16 * u + fr) * 512 + hq * 64 + 32 * ks + 8 * fq);
    bf16x8 kf[11][2];
#pragma unroll
    for (int tt = 0; tt < 11; ++tt) {
        const int x0 = (tt < 10) ? (32 * w + 16 * tt) : 256;
        const int pos = ((tt < 10) ? (kb0 + x0) : PADF) + fr;
        kf[tt][0] = *(const bf16x8*)(kbp + (rb + pos) * 128 + 8 * fq);
        kf[tt][1] = *(const bf16x8*)(kbp + (rb + pos) * 128 + 32 + 8 * fq);
    }
    MEMFENCE();
    f32x4 s[11][2];
#pragma unroll
    for (int tt = 0; tt < 11; ++tt) {
        const int x0 = (tt < 10) ? (32 * w + 16 * tt) : 256;
#pragma unroll
        for (int u = 0; u < 2; ++u) {
            f32x4 c = (f32x4){0.f, 0.f, 0.f, 0.f};
            c = __builtin_amdgcn_mfma_f32_16x16x32_bf16(kf[tt][0], qf[u][0], c, 0, 0, 0);
            c = __builtin_amdgcn_mfma_f32_16x16x32_bf16(kf[tt][1], qf[u][1], c, 0, 0, 0);
            if (tt < 10) {
                const int xq = 128 + 32 * w + 16 * u + fr;
#pragma unroll
                for (int j = 0; j < 4; ++j) {
                    const int x = x0 + 4 * fq + j, dq = xq - x;
                    const bool ok = (dq >= 0) && (dq < 128) && (kb0 + x >= 128);
                    c[j] = ok ? c[j] : -1.0e30f;
                }
            }
            s[tt][u] = c;
        }
    }
    const float sink = p.sinks[hq];
    float inv[2];
#pragma unroll
    for (int u = 0; u < 2; ++u) {
        float m = sink;
#pragma unroll
        for (int tt = 0; tt < 11; ++tt)
#pragma unroll
            for (int j = 0; j < 4; ++j) m = fmaxf(m, s[tt][u][j]);
        m = fmaxf(m, __shfl_xor(m, 16)); m = fmaxf(m, __shfl_xor(m, 32));
        float l = 0.f;
#pragma unroll
        for (int tt = 0; tt < 11; ++tt)
#pragma unroll
            for (int j = 0; j < 4; ++j) { const float e = __expf(s[tt][u][j] - m); s[tt][u][j] = e; l += e; }
        l += __shfl_xor(l, 16); l += __shfl_xor(l, 32);
        l += __expf(sink - m);
        inv[u] = 1.f / l;
    }
    f32x4 o[4][2];
#pragma unroll
    for (int dt = 0; dt < 4; ++dt)
#pragma unroll
        for (int u = 0; u < 2; ++u) o[dt][u] = (f32x4){0.f, 0.f, 0.f, 0.f};
#pragma unroll
    for (int g = 0; g < 6; ++g) {
        const int xa = (g < 5) ? (32 * w + 32 * g) : 256, xb = (g < 5) ? (xa + 16) : 256;
        bf16x8 pf[2];
#pragma unroll
        for (int u = 0; u < 2; ++u) {
#pragma unroll
            for (int j = 0; j < 4; ++j) {
                pf[u][j] = (short)f2bf(s[2 * g][u][j]);
                pf[u][4 + j] = (g < 5) ? (short)f2bf(s[(g < 5) ? (2 * g + 1) : 0][u][j]) : (short)0;
            }
        }
#pragma unroll
        for (int dt = 0; dt < 4; ++dt) {
            const uint2 a0 = *(const uint2*)(VT + (16 * dt + fr) * LDV + xa + 4 * fq);
            const uint2 a1 = *(const uint2*)(VT + (16 * dt + fr) * LDV + xb + 4 * fq);
            union { uint4 q; bf16x8 v; } av; av.q = make_uint4(a0.x, a0.y, a1.x, a1.y);
#pragma unroll
            for (int u = 0; u < 2; ++u) o[dt][u] = __builtin_amdgcn_mfma_f32_16x16x32_bf16(av.v, pf[u], o[dt][u], 0, 0, 0);
        }
    }
#pragma unroll
    for (int u = 0; u < 2; ++u) {
        const size_t t = (size_t)b * SEQ + 128 * (n - 1) + 32 * w + 16 * u + fr;
#pragma unroll
        for (int dt = 0; dt < 4; ++dt) {
            uint2 ov;
            ov.x = pack2(o[dt][u][0] * inv[u], o[dt][u][1] * inv[u]);
            ov.y = pack2(o[dt][u][2] * inv[u], o[dt][u][3] * inv[u]);
            *(uint2*)(WS(bf16_t, OFF_ATT) + t * 512 + hq * 64 + 16 * dt + 4 * fq) = ov;
        }
    }
    __syncthreads();
}

#if HGRN_SIMPLE
__device__ __forceinline__ void d_hgrn_simple(const P& p, int bh, char* shm) {
    float (*fs)[128] = (float (*)[128])shm;
    float (*ks)[128] = (float (*)[128])(shm + 4096);
    float (*qs)[128] = (float (*)[128])(shm + 8192);
    float (*os)[128] = (float (*)[128])(shm + 12288);
    float (*red)[2] = (float (*)[2])(shm + 16384);
    const int b = bh >> 2, h = bh & 3, e = ltid() & 127;
    const bool act = ltid() < 128;
    float S[128];
#pragma unroll
    for (int d = 0; d < 128; ++d) S[d] = 0.f;
    const float g = p.g_rec[h * 128 + e];
    for (int p0 = PADF; p0 < LP; p0 += 8) {
        float v[8];
        if (act) {
#pragma unroll
            for (int i = 0; i < 8; ++i) {
                const size_t r = (size_t)b * LP + p0 + i;
                const float lf = WS(float, OFF_LOGF)[r * 512 + h * 128 + e] - (((p0 + i) & 63) ? WS(float, OFF_LOGF)[(r - 1) * 512 + h * 128 + e] : 0.f);
                const float f = __expf(lf);
                fs[i][e] = f; ks[i][e] = 1.f - f;
                qs[i][e] = bf2f(WS(bf16_t, OFF_RQ)[r * 512 + h * 128 + e]);
                v[i] = bf2f(WS(bf16_t, OFF_RI)[r * 512 + h * 128 + e]);
            }
        }
        __syncthreads();
        if (act) {
#pragma unroll
            for (int i = 0; i < 8; ++i) {
                float o = 0.f;
#pragma unroll
                for (int d = 0; d < 128; ++d) { S[d] = fs[i][d] * S[d] + ks[i][d] * v[i]; o += qs[i][d] * S[d]; }
                os[i][e] = o;
                const float ss = wave_sum(o * o);
                if ((e & 63) == 0) red[i][e >> 6] = ss;
            }
        }
        __syncthreads();
        if (act && p0 >= 128) {
#pragma unroll
            for (int i = 0; i < 8; ++i) {
                const size_t r = (size_t)b * LP + p0 + i;
                const size_t t = (size_t)b * SEQ + (p0 + i - 128);
                const float rstd = rsqrtf((red[i][0] + red[i][1]) * (1.f / 128.f) + EPS);
                const float val = os[i][e] * rstd * g * bf2f(WS(bf16_t, OFF_RG)[r * 512 + h * 128 + e]);
                WS(bf16_t, OFF_REC)[t * 512 + h * 128 + e] = f2bf(val);
            }
        }
        __syncthreads();
    }
}

#endif

constexpr int LD64 = 72;
constexpr int LD128 = 136;

__device__ __forceinline__ void d_hgrn_A(const P& p, int unit, char* shm) {
    bf16_t* VT = (bf16_t*)shm;
    bf16_t* KT = (bf16_t*)(shm + 128 * LD64 * 2);
    const int tid = ltid(), wid = tid >> 6, lane = tid & 63, fr = lane & 15, fq = lane >> 4;
    const int bh = unit >> 6, n = (unit & 63) + 1, b = bh >> 2, h = bh & 3;
    const int c = tid & 127, half = tid >> 7;
    const size_t r0 = (size_t)b * LP + 64 * n;
    const float* bb = WS(float, OFF_LOGF) + r0 * 512 + h * 128 + c;
    const bf16_t* vv = WS(bf16_t, OFF_RI) + r0 * 512 + h * 128 + c;
    {
        const float blast = bb[63 * 512];
        float prev = half ? bb[31 * 512] : 0.f;
        const float* bp = bb + (size_t)(32 * half) * 512;
        const bf16_t* vp_ = vv + (size_t)(32 * half) * 512;
#pragma unroll 1
        for (int g = 0; g < 4; ++g) {
            float bs[8]; uint32_t vs[8];
#pragma unroll
            for (int i = 0; i < 8; ++i) { bs[i] = bp[i * 512]; vs[i] = vp_[i * 512]; }
            uint32_t kp[4], vp[4];
#pragma unroll
            for (int i = 0; i < 8; i += 2) {
                const float k0 = (1.f - __expf(bs[i] - prev)) * __expf(blast - bs[i]);
                const float k1 = (1.f - __expf(bs[i + 1] - bs[i])) * __expf(blast - bs[i + 1]);
                prev = bs[i + 1];
                kp[i >> 1] = pack2(k0, k1);
                vp[i >> 1] = vs[i] | (vs[i + 1] << 16);
            }
            *(uint4*)(KT + c * LD64 + 32 * half + 8 * g) = make_uint4(kp[0], kp[1], kp[2], kp[3]);
            *(uint4*)(VT + c * LD64 + 32 * half + 8 * g) = make_uint4(vp[0], vp[1], vp[2], vp[3]);
            bp += 8 * 512; vp_ += 8 * 512;
        }
    }
    __syncthreads();
    f32x4 acc[2][8];
#pragma unroll
    for (int mi = 0; mi < 2; ++mi)
#pragma unroll
        for (int n8 = 0; n8 < 8; ++n8) acc[mi][n8] = (f32x4){0.f, 0.f, 0.f, 0.f};
#pragma unroll
    for (int ks = 0; ks < 2; ++ks) {
        bf16x8 a[2];
#pragma unroll
        for (int mi = 0; mi < 2; ++mi) a[mi] = *(const bf16x8*)(VT + (32 * wid + 16 * mi + fr) * LD64 + 32 * ks + 8 * fq);
#pragma unroll
        for (int n8 = 0; n8 < 8; ++n8) {
            const bf16x8 bf = *(const bf16x8*)(KT + (16 * n8 + fr) * LD64 + 32 * ks + 8 * fq);
#pragma unroll
            for (int mi = 0; mi < 2; ++mi) acc[mi][n8] = __builtin_amdgcn_mfma_f32_16x16x32_bf16(a[mi], bf, acc[mi][n8], 0, 0, 0);
        }
    }
    bf16_t* dst = WS(bf16_t, OFF_DS) + (size_t)unit * 16384;
#pragma unroll
    for (int mi = 0; mi < 2; ++mi)
#pragma unroll
        for (int n8 = 0; n8 < 8; ++n8)
#pragma unroll
            for (int j = 0; j < 4; ++j) dst[(32 * wid + 16 * mi + 4 * fq + j) * 128 + 16 * n8 + fr] = f2bf(acc[mi][n8][j]);
    __syncthreads();
}

__device__ __forceinline__ void d_hgrn_scan(const P& p, int unit) {
    const int gid = unit * 256 + ltid();
    const int bh = gid >> 13, rem = gid & 8191, e = rem >> 6, d2 = (rem & 63) * 2;
    uint32_t* base = (uint32_t*)(WS(bf16_t, OFF_DS) + (size_t)bh * 64 * 16384 + e * 128 + d2);
    const float* bb = WS(float, OFF_LOGF) + ((size_t)(bh >> 2) * LP + 64 + 63) * 512 + (bh & 3) * 128 + d2;
    float s0 = 0.f, s1 = 0.f;
#pragma unroll 8
    for (int j = 0; j < 64; ++j) {
        const uint32_t x = base[(size_t)j * 8192];
        const float2 bl = *(const float2*)(bb + (size_t)j * 64 * 512);
        s0 = __expf(bl.x) * s0 + __uint_as_float(x << 16);
        s1 = __expf(bl.y) * s1 + __uint_as_float(x & 0xFFFF0000u);
        base[(size_t)j * 8192] = pack2(s0, s1);
    }
}

__device__ __forceinline__ void d_hgrn_C(const P& p, int unit, char* shm) {
    bf16_t* KS = (bf16_t*)shm;
    bf16_t* KD = KS + 64 * LD128;
    bf16_t* VT = KD + 64 * LD128;
    bf16_t* AM = VT + 128 * LD64;
    const int tid = ltid(), lane = tid & 63, fr = lane & 15, fq = lane >> 4;
    const int wi = __builtin_amdgcn_readfirstlane(tid >> 6);
    const int bh = unit >> 6, n = (unit & 63) + 2, b = bh >> 2, h = bh & 3;
    const size_t r0 = (size_t)b * LP + 64 * n;
    const size_t t0 = (size_t)b * SEQ + 64 * n - 128;
    {
        const int c = tid & 127, half = tid >> 7;
        const float* bb = WS(float, OFF_LOGF) + r0 * 512 + h * 128 + c;
        const bf16_t* vv = WS(bf16_t, OFF_RI) + r0 * 512 + h * 128 + c;
        float prev = half ? bb[31 * 512] : 0.f;
        const float* bp = bb + (size_t)(32 * half) * 512;
        const bf16_t* vp_ = vv + (size_t)(32 * half) * 512;
#pragma unroll 1
        for (int g = 0; g < 4; ++g) {
            const int s0 = 32 * half + 8 * g, sb = s0 & ~15;
            const float bend = bb[(size_t)(sb + 15) * 512];
            const float bref = (sb == 0) ? 0.f : bb[(size_t)(sb - 1) * 512];
            float bs[8]; uint32_t vs[8];
#pragma unroll
            for (int i = 0; i < 8; ++i) { bs[i] = bp[i * 512]; vs[i] = vp_[i * 512]; }
#pragma unroll
            for (int i = 0; i < 8; ++i) {
                const float k = 1.f - __expf(bs[i] - prev);
                prev = bs[i];
                KS[(s0 + i) * LD128 + c] = f2bf(k * __expf(bend - bs[i]));
                KD[(s0 + i) * LD128 + c] = f2bf(k * __expf(bref - bs[i]));
            }
            *(uint4*)(VT + c * LD64 + s0) = make_uint4(vs[0] | (vs[1] << 16), vs[2] | (vs[3] << 16), vs[4] | (vs[5] << 16), vs[6] | (vs[7] << 16));
            bp += 8 * 512; vp_ += 8 * 512;
        }
#pragma unroll
        for (int i = 0; i < 9; ++i) ((uint32_t*)AM)[tid + 256 * i] = 0u;
    }
    __syncthreads();
    const int tl = 16 * wi + fr;
    bf16x8 qf[4]; float bt[4][8];
    {
        const bf16_t* qrow = WS(bf16_t, OFF_RQ) + (r0 + tl) * 512 + h * 128 + 8 * fq;
        const float* brow = WS(float, OFF_LOGF) + (r0 + tl) * 512 + h * 128 + 8 * fq;
#pragma unroll
        for (int ks = 0; ks < 4; ++ks) {
            qf[ks] = *(const bf16x8*)(qrow + 32 * ks);
            const float4 x0 = *(const float4*)(brow + 32 * ks), x1 = *(const float4*)(brow + 32 * ks + 4);
            bt[ks][0] = x0.x; bt[ks][1] = x0.y; bt[ks][2] = x0.z; bt[ks][3] = x0.w; bt[ks][4] = x1.x; bt[ks][5] = x1.y; bt[ks][6] = x1.z; bt[ks][7] = x1.w;
        }
    }
    auto qfrag = [&](int ks, const float* refrow) -> bf16x8 {
        float rf[8];
        if (refrow) {
            const float4 x0 = *(const float4*)(refrow + 32 * ks), x1 = *(const float4*)(refrow + 32 * ks + 4);
            rf[0] = x0.x; rf[1] = x0.y; rf[2] = x0.z; rf[3] = x0.w; rf[4] = x1.x; rf[5] = x1.y; rf[6] = x1.z; rf[7] = x1.w;
        } else {
#pragma unroll
            for (int jj = 0; jj < 8; ++jj) rf[jj] = 0.f;
        }
        bf16x8 o;
#pragma unroll
        for (int jj = 0; jj < 8; ++jj) o[jj] = (short)f2bf(bf2f((bf16_t)qf[ks][jj]) * __expf(bt[ks][jj] - rf[jj]));
        return o;
    };
    const float* bchunk = WS(float, OFF_LOGF) + r0 * 512 + h * 128 + 8 * fq;
    f32x4 acc[8];
#pragma unroll
    for (int n8 = 0; n8 < 8; ++n8) acc[n8] = (f32x4){0.f, 0.f, 0.f, 0.f};
    {
        const bf16_t* sp = WS(bf16_t, OFF_DS) + (size_t)unit * 16384 + fr * 128 + 8 * fq;
#pragma unroll
        for (int ks = 0; ks < 4; ++ks) {
            const bf16x8 a = qfrag(ks, nullptr);
#pragma unroll
            for (int n8 = 0; n8 < 8; ++n8) {
                const bf16x8 bf = *(const bf16x8*)(sp + (size_t)n8 * 16 * 128 + 32 * ks);
                acc[n8] = __builtin_amdgcn_mfma_f32_16x16x32_bf16(a, bf, acc[n8], 0, 0, 0);
            }
        }
    }
    for (int j = 0; j < wi; ++j) {
        f32x4 c4 = (f32x4){0.f, 0.f, 0.f, 0.f};
        const float* refrow = bchunk + (size_t)(16 * j + 15) * 512;
#pragma unroll
        for (int ks = 0; ks < 4; ++ks) {
            const bf16x8 a = qfrag(ks, refrow);
            const bf16x8 bf = *(const bf16x8*)(KS + (16 * j + fr) * LD128 + 32 * ks + 8 * fq);
            c4 = __builtin_amdgcn_mfma_f32_16x16x32_bf16(a, bf, c4, 0, 0, 0);
        }
#pragma unroll
        for (int jj = 0; jj < 4; ++jj) AM[(16 * wi + 4 * fq + jj) * LD64 + 16 * j + fr] = f2bf(c4[jj]);
    }
    {
        f32x4 c4 = (f32x4){0.f, 0.f, 0.f, 0.f};
        const float* refrow = (wi > 0) ? (bchunk + (size_t)(16 * wi - 1) * 512) : nullptr;
#pragma unroll
        for (int ks = 0; ks < 4; ++ks) {
            const bf16x8 a = qfrag(ks, refrow);
            const bf16x8 bf = *(const bf16x8*)(KD + (16 * wi + fr) * LD128 + 32 * ks + 8 * fq);
            c4 = __builtin_amdgcn_mfma_f32_16x16x32_bf16(a, bf, c4, 0, 0, 0);
        }
#pragma unroll
        for (int jj = 0; jj < 4; ++jj) AM[(16 * wi + 4 * fq + jj) * LD64 + 16 * wi + fr] = f2bf((fr <= 4 * fq + jj) ? c4[jj] : 0.f);
    }
    __syncthreads();
#pragma unroll
    for (int ks = 0; ks < 2; ++ks) {
        const bf16x8 a = *(const bf16x8*)(AM + (16 * wi + fr) * LD64 + 32 * ks + 8 * fq);
#pragma unroll
        for (int n8 = 0; n8 < 8; ++n8) {
            const bf16x8 bf = *(const bf16x8*)(VT + (16 * n8 + fr) * LD64 + 32 * ks + 8 * fq);
            acc[n8] = __builtin_amdgcn_mfma_f32_16x16x32_bf16(a, bf, acc[n8], 0, 0, 0);
        }
    }
#pragma unroll
    for (int jj = 0; jj < 4; ++jj) {
        float ss = 0.f;
#pragma unroll
        for (int n8 = 0; n8 < 8; ++n8) ss += acc[n8][jj] * acc[n8][jj];
        ss += __shfl_xor(ss, 1); ss += __shfl_xor(ss, 2); ss += __shfl_xor(ss, 4); ss += __shfl_xor(ss, 8);
        const float rstd = rsqrtf(ss * (1.f / 128.f) + EPS);
        const int trow = 16 * wi + 4 * fq + jj;
#pragma unroll
        for (int n8 = 0; n8 < 8; ++n8) {
            const int e = 16 * n8 + fr;
            const float val = acc[n8][jj] * rstd * p.g_rec[h * 128 + e] * bf2f(WS(bf16_t, OFF_RG)[(r0 + trow) * 512 + h * 128 + e]);
            WS(bf16_t, OFF_REC)[(t0 + trow) * 512 + h * 128 + e] = f2bf(val);
        }
        asm volatile("" ::: "memory");
    }
    __syncthreads();
}

#if TOPK_SIMPLE
__device__ __forceinline__ void d_peer_topk_simple(const P& p, int unit) {
    const int t = (unit >> 3) * 256 + ltid(), h = unit & 7;
    const bf16_t* qp = WS(bf16_t, OFF_QRY) + (size_t)t * DM + h * 128;
    float tv[2][16]; int ti[2][16];
#pragma unroll
    for (int pp = 0; pp < 2; ++pp) {
        float q[64];
#pragma unroll
        for (int d = 0; d < 64; ++d) q[d] = bf2f(qp[pp * 64 + d]);
#pragma unroll
        for (int i = 0; i < 16; ++i) { tv[pp][i] = -3.0e38f; ti[pp][i] = 0; }
        const bf16_t* kp = WS(bf16_t, OFF_KEYS) + (size_t)(h * 2 + pp) * 128 * 64;
        for (int n = 0; n < 128; ++n) {
            float sc = 0.f;
#pragma unroll
            for (int d = 0; d < 64; ++d) sc += q[d] * bf2f(kp[n * 64 + d]);
            float xv = sc; int xi = n;
#pragma unroll
            for (int i = 0; i < 16; ++i) {
                if (xv > tv[pp][i]) { const float tf = tv[pp][i]; const int tn = ti[pp][i]; tv[pp][i] = xv; ti[pp][i] = xi; xv = tf; xi = tn; }
            }
        }
    }
    float bv[16]; int bi[16];
#pragma unroll
    for (int i = 0; i < 16; ++i) { bv[i] = -3.0e38f; bi[i] = 0; }
#pragma unroll
    for (int i = 0; i < 16; ++i)
#pragma unroll
        for (int j = 0; j < 16; ++j) {
            if ((i + 1) * (j + 1) <= 16) {
                float xv = tv[0][i] + tv[1][j]; int xi = ti[0][i] * 128 + ti[1][j];
#pragma unroll
                for (int k = 0; k < 16; ++k) {
                    if (xv > bv[k]) { const float tf = bv[k]; const int tn = bi[k]; bv[k] = xv; bi[k] = xi; xv = tf; xi = tn; }
                }
            }
        }
    float se = 0.f, ev[16];
#pragma unroll
    for (int k = 0; k < 16; ++k) { ev[k] = __expf(bv[k] - bv[0]); se += ev[k]; }
    const float inv = 1.f / se;
#pragma unroll
    for (int k = 0; k < 16; ++k) {
        WS(int, OFF_PIDX)[(size_t)t * 128 + h * 16 + k] = bi[k];
        WS(float, OFF_PGATE)[(size_t)t * 128 + h * 16 + k] = ev[k] * inv;
    }
}

#endif
template <int N> __device__ __forceinline__ void bitonic_sort_desc(float (&v)[N]) {
#pragma unroll
    for (int k = 2; k <= N; k <<= 1)
#pragma unroll
        for (int j = k >> 1; j > 0; j >>= 1)
#pragma unroll
            for (int i = 0; i < N; ++i) {
                const int l = i ^ j;
                if (l > i) {
                    const bool desc = ((i & k) == 0);
                    const float a = v[i], b = v[l];
                    const float hi = fmaxf(a, b), lo = fminf(a, b);
                    v[i] = desc ? hi : lo; v[l] = desc ? lo : hi;
                }
            }
}
template <int N> __device__ __forceinline__ void bitonic_merge_desc(float (&v)[N]) {
#pragma unroll
    for (int j = N >> 1; j > 0; j >>= 1)
#pragma unroll
        for (int i = 0; i < N; ++i) {
            const int l = i ^ j;
            if (l > i) { const float a = v[i], b = v[l]; v[i] = fmaxf(a, b); v[l] = fminf(a, b); }
        }
}
__device__ __forceinline__ void ph_peer_qry_topk(const P& p, char* shm) {
    const int tid = ltid(), wid = tid >> 6, lane = tid & 63, wr = wid >> 1, wc = wid & 1, fr = lane & 15, fq = lane >> 4;
    float* tops = (float*)shm;
    for (int q = blockIdx.x >> 3; q < T / 128; q += gridDim.x >> 3) {
        const int h = q & 7, t0 = (8 * (q >> 3) + (blockIdx.x & 7)) * 128;
        f32x4 acc[4][4]; zero_acc(acc);
        gemm_kloop(WS(bf16_t, OFF_WQ), 1024, WS(bf16_t, OFF_H2B), 1024, 1024, h * 128, t0, acc, shm);
        int tb = t0 + wc * 64 + fr;
        asm volatile("" : "+v"(tb));
        float rstd4[4];
        {
            float ssv[4][8];
#pragma unroll
            for (int n = 0; n < 4; ++n)
#pragma unroll
                for (int i = 0; i < 8; ++i) ssv[n][i] = WS(float, OFF_SSQ)[(size_t)i * T + tb + n * 16];
#pragma unroll
            for (int n = 0; n < 4; ++n) {
                float s8 = 0.f;
#pragma unroll
                for (int i = 0; i < 8; ++i) s8 += ssv[n][i];
                rstd4[n] = rsqrtf(s8 * (1.f / DM) + EPS);
            }
        }
        {
            const bf16_t* ksrc = WS(bf16_t, OFF_KEYS) + (size_t)h * 2 * 128 * 64;
#pragma unroll
            for (int i = 0; i < 8; ++i) {
                const int q = tid + 256 * i, r = q >> 3, c8 = q & 7;
                *(uint4*)(shm + 16384 + (r * 72 + c8 * 8) * 2) = *(const uint4*)(ksrc + (size_t)r * 64 + c8 * 8);
            }
        }
        __syncthreads();
        const bf16_t* kbase = (const bf16_t*)(shm + 16384) + (size_t)(wr * 128 + fr) * 72 + 4 * fq;
#pragma unroll
        for (int n = 0; n < 4; ++n) {
            const int t = tb + n * 16;
            const float rstd = rstd4[n];
            if (wr == 0 && fq == 0 && h == 0) WS(float, OFF_RSTD)[t] = rstd;
            bf16x8 bq[2];
#pragma unroll
            for (int ks = 0; ks < 2; ++ks)
#pragma unroll
                for (int j = 0; j < 4; ++j) { bq[ks][j] = (short)f2bf(acc[2 * ks][n][j] * rstd); bq[ks][4 + j] = (short)f2bf(acc[2 * ks + 1][n][j] * rstd); }
            float v[32];
            {
                uint2 ka[8][2][2];
#pragma unroll
                for (int mk = 0; mk < 8; ++mk)
#pragma unroll
                    for (int ks = 0; ks < 2; ++ks) {
                        ka[mk][ks][0] = *(const uint2*)(kbase + mk * 16 * 72 + 32 * ks);
                        ka[mk][ks][1] = *(const uint2*)(kbase + mk * 16 * 72 + 32 * ks + 16);
                    }
#pragma unroll
                for (int mk = 0; mk < 8; ++mk) {
                    f32x4 c = (f32x4){0.f, 0.f, 0.f, 0.f};
#pragma unroll
                    for (int ks = 0; ks < 2; ++ks) {
                        union { uint4 q; bf16x8 v; } av; av.q = make_uint4(ka[mk][ks][0].x, ka[mk][ks][0].y, ka[mk][ks][1].x, ka[mk][ks][1].y);
                        c = __builtin_amdgcn_mfma_f32_16x16x32_bf16(av.v, bq[ks], c, 0, 0, 0);
                    }
#pragma unroll
                    for (int j = 0; j < 4; ++j) v[4 * mk + j] = __uint_as_float((__float_as_uint(c[j]) & ~0x7Fu) | (unsigned)(16 * mk + 4 * fq + j));
                }
            }
            float m[16];
            {
                float h0[16], h1[16];
#pragma unroll
                for (int i = 0; i < 16; ++i) { h0[i] = v[i]; h1[i] = v[16 + i]; }
                bitonic_sort_desc<16>(h0); bitonic_sort_desc<16>(h1);
#pragma unroll
                for (int i = 0; i < 16; ++i) m[i] = fmaxf(h0[i], h1[15 - i]);
                bitonic_merge_desc<16>(m);
            }
#pragma unroll
            for (int off = 16; off <= 32; off <<= 1) {
                float o[16];
#pragma unroll
                for (int i = 0; i < 16; ++i) o[i] = __shfl_xor(m[i], off);
#pragma unroll
                for (int i = 0; i < 16; ++i) m[i] = fmaxf(m[i], o[15 - i]);
                bitonic_merge_desc<16>(m);
            }
            if (fq == 0) {
                float4* dst = (float4*)(tops + ((size_t)wr * 128 + wc * 64 + n * 16 + fr) * 16);
                dst[0] = make_float4(m[0], m[1], m[2], m[3]); dst[1] = make_float4(m[4], m[5], m[6], m[7]);
                dst[2] = make_float4(m[8], m[9], m[10], m[11]); dst[3] = make_float4(m[12], m[13], m[14], m[15]);
            }
        }
        __syncthreads();
        if (tid < 128) {
            const float* ta = tops + (size_t)tid * 16;
            const float* tbp = tops + (size_t)(128 + tid) * 16;
            float a[16], b[16];
#pragma unroll
            for (int i = 0; i < 16; ++i) { a[i] = __uint_as_float(__float_as_uint(ta[i]) & ~0x7Fu); b[i] = __uint_as_float(__float_as_uint(tbp[i]) & ~0x7Fu); }
#define CAND(I, J) __uint_as_float((__float_as_uint(a[I] + b[J]) & ~0xFFu) | (unsigned)((I) * 16 + (J)))
            float cand[16];
#pragma unroll
            for (int j = 0; j < 16; ++j) cand[j] = CAND(0, j);
            {
#pragma unroll
                for (int j = 0; j < 8; ++j) cand[8 + j] = fmaxf(cand[8 + j], CAND(1, 7 - j));
                bitonic_merge_desc<16>(cand);
            }
            {
                float g[16] = {CAND(2, 0), CAND(2, 1), CAND(2, 2), CAND(2, 3), CAND(2, 4), CAND(3, 0), CAND(3, 1), CAND(3, 2), CAND(3, 3), CAND(4, 0), CAND(4, 1), CAND(4, 2), CAND(5, 0), CAND(5, 1), -3.0e38f, -3.0e38f};
                bitonic_sort_desc<16>(g);
#pragma unroll
                for (int j = 0; j < 16; ++j) cand[j] = fmaxf(cand[j], g[15 - j]);
                bitonic_merge_desc<16>(cand);
            }
            {
                float g[16] = {CAND(6, 0), CAND(6, 1), CAND(7, 0), CAND(7, 1), CAND(8, 0), CAND(9, 0), CAND(10, 0), CAND(11, 0), CAND(12, 0), CAND(13, 0), CAND(14, 0), CAND(15, 0), -3.0e38f, -3.0e38f, -3.0e38f, -3.0e38f};
                bitonic_sort_desc<16>(g);
#pragma unroll
                for (int j = 0; j < 16; ++j) cand[j] = fmaxf(cand[j], g[15 - j]);
                bitonic_merge_desc<16>(cand);
            }
#undef CAND
            float ev[16], se = 0.f; int ex[16];
            const float best = __uint_as_float(__float_as_uint(cand[0]) & ~0xFFu);
#pragma unroll
            for (int q = 0; q < 16; ++q) {
                const unsigned bits = __float_as_uint(cand[q]);
                const int ci = (bits >> 4) & 15, cj = bits & 15;
                const int ia = (int)(__float_as_uint(ta[ci]) & 0x7Fu), ib = (int)(__float_as_uint(tbp[cj]) & 0x7Fu);
                ex[q] = ia * 128 + ib;
                ev[q] = __expf(__uint_as_float(bits & ~0xFFu) - best); se += ev[q];
            }
            const float inv = 1.f / se;
            int4* pi = (int4*)(WS(int, OFF_PIDX) + (size_t)(t0 + tid) * 128 + h * 16);
            float4* pg = (float4*)(WS(float, OFF_PGATE) + (size_t)(t0 + tid) * 128 + h * 16);
#pragma unroll
            for (int q = 0; q < 4; ++q) {
                pi[q] = make_int4(ex[4 * q], ex[4 * q + 1], ex[4 * q + 2], ex[4 * q + 3]);
                pg[q] = make_float4(ev[4 * q] * inv, ev[4 * q + 1] * inv, ev[4 * q + 2] * inv, ev[4 * q + 3] * inv);
            }
        }
        __syncthreads();
    }
}

#if PEER_SIMPLE
__device__ __forceinline__ void d_peer_expert(const P& p, int t, char* shm) {
    float* act = (float*)shm;
    float* red = (float*)(shm + 512);
    const int tid = ltid(), wid = tid >> 6, lane = tid & 63;
    const float rstd = row_rstd(p, t);
    const float* h2 = WS(float, OFF_H2) + (size_t)t * DM;
    float xn[16];
#pragma unroll
    for (int i = 0; i < 4; ++i) {
        const float4 v = ((const float4*)h2)[lane * 4 + i];
        const float4 g = ((const float4*)p.g_ffn)[lane * 4 + i];
        xn[4 * i + 0] = v.x * rstd * g.x; xn[4 * i + 1] = v.y * rstd * g.y; xn[4 * i + 2] = v.z * rstd * g.z; xn[4 * i + 3] = v.w * rstd * g.w;
    }
    const int* idx = WS(int, OFF_PIDX) + (size_t)t * 128;
    const float* gate = WS(float, OFF_PGATE) + (size_t)t * 128;
    const bf16_t* edn = WS(bf16_t, OFF_EDN);
    const bf16_t* eup = WS(bf16_t, OFF_EUP);
    for (int e = wid; e < 128; e += 4) {
        const bf16_t* row = edn + (size_t)idx[e] * DM + lane * 16;
        const uint4 a = ((const uint4*)row)[0], c = ((const uint4*)row)[1];
        const uint32_t w[8] = {a.x, a.y, a.z, a.w, c.x, c.y, c.z, c.w};
        float s = 0.f;
#pragma unroll
        for (int i = 0; i < 8; ++i) s += xn[2 * i] * __uint_as_float(w[i] << 16) + xn[2 * i + 1] * __uint_as_float(w[i] & 0xFFFF0000u);
        s = wave_sum(s);
        if (lane == 0) act[e] = 0.5f * s * (1.f + erff(s * 0.70710678118654752f)) * gate[e];
    }
    __syncthreads();
    float y0 = 0.f, y1 = 0.f, y2 = 0.f, y3 = 0.f;
    for (int e = 0; e < 128; ++e) {
        const float a = act[e];
        const uint2 w = *(const uint2*)(eup + (size_t)idx[e] * DM + tid * 4);
        y0 += a * __uint_as_float(w.x << 16); y1 += a * __uint_as_float(w.x & 0xFFFF0000u);
        y2 += a * __uint_as_float(w.y << 16); y3 += a * __uint_as_float(w.y & 0xFFFF0000u);
    }
    const float4 hv = ((const float4*)h2)[tid];
    const float o0 = hv.x + y0, o1 = hv.y + y1, o2 = hv.z + y2, o3 = hv.w + y3;
    float ss = wave_sum(o0 * o0 + o1 * o1 + o2 * o2 + o3 * o3);
    if (lane == 0) red[wid] = ss;
    __syncthreads();
    ss = red[0] + red[1] + red[2] + red[3];
    const float rs = rsqrtf(ss * (1.f / DM) + EPS);
    const float4 g = ((const float4*)p.g_fin)[tid];
    float4 ov; ov.x = o0 * rs * g.x; ov.y = o1 * rs * g.y; ov.z = o2 * rs * g.z; ov.w = o3 * rs * g.w;
    ((float4*)(p.out + (size_t)t * DM))[tid] = ov;
    __syncthreads();
}

#endif
__device__ __forceinline__ float* part_ptr(const P& p, int c) {
    return WS(float, OFF_PART) + (size_t)c * T * 128;
}
__device__ __forceinline__ unsigned xcc_id() { return (unsigned)__builtin_amdgcn_s_getreg((3 << 11) | 20) & 7u; }

typedef float f32x2_t __attribute__((ext_vector_type(2)));
__device__ __forceinline__ float dpp_xor1(float v) { return __builtin_amdgcn_update_dpp(0.f, v, 0xB1, 0xF, 0xF, false); }
__device__ __forceinline__ float dpp_xor2(float v) { return __builtin_amdgcn_update_dpp(0.f, v, 0x4E, 0xF, 0xF, false); }
__device__ __forceinline__ float swz_xor4(float v) { return __int_as_float(__builtin_amdgcn_ds_swizzle(__float_as_int(v), 0x101F)); }
__device__ __forceinline__ float gelu_as(float v) {
    const float av = fabsf(v), t = __builtin_amdgcn_rcpf(av * 0.2316418882f + 1.0f);
    float q = t * 0.5307027145f + (-0.7265760135f); q = q * t + 0.7107068705f; q = q * t + (-0.142248368f); q = q * t + 0.127414796f; q = q * t;
    const float m = v * (q * __builtin_amdgcn_exp2f((v * v) * (-0.72134752044f)));
    return v < 0.f ? m : v - m;
}
__device__ __forceinline__ float group8_transpose_sum(const float (&s)[8], int ch) {
    const bool b0 = ch & 1, b1 = (ch >> 1) & 1, b2 = (ch >> 2) & 1;
    float r4[4], r2[2];
#pragma unroll
    for (int j = 0; j < 4; ++j) { const float keep = b0 ? s[2 * j + 1] : s[2 * j], send = b0 ? s[2 * j] : s[2 * j + 1]; r4[j] = keep + dpp_xor1(send); }
#pragma unroll
    for (int j = 0; j < 2; ++j) { const float keep = b1 ? r4[2 * j + 1] : r4[2 * j], send = b1 ? r4[2 * j] : r4[2 * j + 1]; r2[j] = keep + dpp_xor2(send); }
    const float keep = b2 ? r2[1] : r2[0], send = b2 ? r2[0] : r2[1];
    return keep + swz_xor4(send);
}
constexpr int PEER_TILE = 128;
constexpr int PEER_WTOK = PEER_TILE / 4;
__device__ __forceinline__ void d_peer_e1_run(const P& p, int t0, int c, int lane) {
    const int g8 = lane >> 3, ch = lane & 7;
    const unsigned char* tab = WS(unsigned char, OFF_EDN);
    const unsigned loff = 128u * (unsigned)c + 16u * (unsigned)ch;
    float4 gf[4];
#pragma unroll
    for (int q = 0; q < 4; ++q) gf[q] = *(const float4*)(p.g_ffn + 128 * c + 16 * ch + 4 * q);
    const int4* ip = (const int4*)(WS(int, OFF_PIDX) + (size_t)t0 * 128 + 16 * g8);
    int4 nidx[4];
#pragma unroll
    for (int k = 0; k < 4; ++k) nidx[k] = ip[k];
#pragma unroll 1
    for (int tk = 0; tk < PEER_WTOK; ++tk) {
        const int t = t0 + tk;
        const unsigned idx[16] = {(unsigned)nidx[0].x, (unsigned)nidx[0].y, (unsigned)nidx[0].z, (unsigned)nidx[0].w, (unsigned)nidx[1].x, (unsigned)nidx[1].y, (unsigned)nidx[1].z, (unsigned)nidx[1].w,
                                  (unsigned)nidx[2].x, (unsigned)nidx[2].y, (unsigned)nidx[2].z, (unsigned)nidx[2].w, (unsigned)nidx[3].x, (unsigned)nidx[3].y, (unsigned)nidx[3].z, (unsigned)nidx[3].w};
        uint4 w[16];
#pragma unroll
        for (int k = 0; k < 16; ++k) w[k] = *(const uint4*)(tab + (idx[k] * 1024u + loff));
        const bf16_t* hp = WS(bf16_t, OFF_H2B) + (size_t)t * DM + 128 * c + 16 * ch;
        const uint4 h0 = *(const uint4*)hp, h1 = *(const uint4*)(hp + 8);
        const float rstd = WS(float, OFF_RSTD)[t];
        if (tk + 1 < PEER_WTOK) {
#pragma unroll
            for (int k = 0; k < 4; ++k) nidx[k] = ip[(tk + 1) * 32 + k];
        }
        MEMFENCE();
        f32x2_t x[8];
        {
            const uint32_t hw[8] = {h0.x, h0.y, h0.z, h0.w, h1.x, h1.y, h1.z, h1.w};
#pragma unroll
            for (int q = 0; q < 4; ++q) {
                x[2 * q] = (f32x2_t){__uint_as_float(hw[2 * q] << 16) * rstd * gf[q].x, __uint_as_float(hw[2 * q] & 0xFFFF0000u) * rstd * gf[q].y};
                x[2 * q + 1] = (f32x2_t){__uint_as_float(hw[2 * q + 1] << 16) * rstd * gf[q].z, __uint_as_float(hw[2 * q + 1] & 0xFFFF0000u) * rstd * gf[q].w};
            }
        }
        float res[2];
#pragma unroll
        for (int hh = 0; hh < 2; ++hh) {
            float s[8];
#pragma unroll
            for (int k = 0; k < 8; ++k) {
                const uint4 wk = w[8 * hh + k];
                f32x2_t a2 = __builtin_amdgcn_cvt_pk_f32_fp8((int)wk.x, false) * x[0];
                a2 = __builtin_elementwise_fma(__builtin_amdgcn_cvt_pk_f32_fp8((int)wk.x, true), x[1], a2);
                a2 = __builtin_elementwise_fma(__builtin_amdgcn_cvt_pk_f32_fp8((int)wk.y, false), x[2], a2);
                a2 = __builtin_elementwise_fma(__builtin_amdgcn_cvt_pk_f32_fp8((int)wk.y, true), x[3], a2);
                a2 = __builtin_elementwise_fma(__builtin_amdgcn_cvt_pk_f32_fp8((int)wk.z, false), x[4], a2);
                a2 = __builtin_elementwise_fma(__builtin_amdgcn_cvt_pk_f32_fp8((int)wk.z, true), x[5], a2);
                a2 = __builtin_elementwise_fma(__builtin_amdgcn_cvt_pk_f32_fp8((int)wk.w, false), x[6], a2);
                a2 = __builtin_elementwise_fma(__builtin_amdgcn_cvt_pk_f32_fp8((int)wk.w, true), x[7], a2);
                s[k] = a2[0] + a2[1];
            }
            res[hh] = group8_transpose_sum(s, ch);
        }
        float* pp = part_ptr(p, c) + (size_t)t * 128 + 16 * g8 + ch;
        pp[0] = res[0]; pp[8] = res[1];
    }
}

__device__ __forceinline__ void d_peer_act(const P& p, int vblk, int nvblk) {
    const int lane = ltid() & 63, wv = ltid() >> 6;
    for (int t = vblk * 4 + wv; t < T; t += nvblk * 4) {
        float pu[2][8], gt[2];
#pragma unroll
        for (int k = 0; k < 2; ++k) {
#pragma unroll
            for (int cc = 0; cc < 8; ++cc) pu[k][cc] = part_ptr(p, cc)[(size_t)t * 128 + lane + 64 * k];
            gt[k] = WS(float, OFF_PGATE)[(size_t)t * 128 + lane + 64 * k];
        }
#pragma unroll
        for (int k = 0; k < 2; ++k) {
            const float u = (((pu[k][0] + pu[k][1]) + (pu[k][2] + pu[k][3])) + ((pu[k][4] + pu[k][5]) + (pu[k][6] + pu[k][7]))) * (1.f / 64.f);
            WS(float, OFF_ACT)[(size_t)t * 128 + lane + 64 * k] = gelu_as(u) * gt[k] * 0.125f;
        }
    }
}

__device__ __forceinline__ void d_peer_e2_run(const P& p, int t0, int c, int lane, float* sact) {
    const int g8 = lane >> 3, ch = lane & 7;
    const unsigned char* tab = WS(unsigned char, OFF_EUP);
    const unsigned loff = 128u * (unsigned)c + 16u * (unsigned)ch;
    const bool b3 = (lane >> 3) & 1, b4 = (lane >> 4) & 1, b5 = (lane >> 5) & 1;
    const int col = 128 * c + 16 * ch + 8 * (int)b3 + 4 * (int)b4 + 2 * (int)b5;
    const int4* ip = (const int4*)(WS(int, OFF_PIDX) + (size_t)t0 * 128 + 16 * g8);
    const float4* ap = (const float4*)(WS(float, OFF_ACT) + (size_t)t0 * 128 + 16 * g8);
    int4 nidx[4]; float4 nact[4];
#pragma unroll
    for (int k = 0; k < 4; ++k) { nidx[k] = ip[k]; nact[k] = ap[k]; }
#pragma unroll 1
    for (int tk = 0; tk < PEER_WTOK; ++tk) {
        const int t = t0 + tk;
        const unsigned idx[16] = {(unsigned)nidx[0].x, (unsigned)nidx[0].y, (unsigned)nidx[0].z, (unsigned)nidx[0].w, (unsigned)nidx[1].x, (unsigned)nidx[1].y, (unsigned)nidx[1].z, (unsigned)nidx[1].w,
                                  (unsigned)nidx[2].x, (unsigned)nidx[2].y, (unsigned)nidx[2].z, (unsigned)nidx[2].w, (unsigned)nidx[3].x, (unsigned)nidx[3].y, (unsigned)nidx[3].z, (unsigned)nidx[3].w};
        const float a[16] = {nact[0].x, nact[0].y, nact[0].z, nact[0].w, nact[1].x, nact[1].y, nact[1].z, nact[1].w, nact[2].x, nact[2].y, nact[2].z, nact[2].w, nact[3].x, nact[3].y, nact[3].z, nact[3].w};
        uint4 w[16];
#pragma unroll
        for (int k = 0; k < 16; ++k) w[k] = *(const uint4*)(tab + (idx[k] * 1024u + loff));
        const uint32_t hb = *(const uint32_t*)(WS(bf16_t, OFF_H2B) + (size_t)t * DM + col);
        if (tk + 1 < PEER_WTOK) {
#pragma unroll
            for (int k = 0; k < 4; ++k) { nidx[k] = ip[(tk + 1) * 32 + k]; nact[k] = ap[(tk + 1) * 32 + k]; }
        }
        MEMFENCE();
        f32x2_t y[8];
#pragma unroll
        for (int k = 0; k < 8; ++k) y[k] = (f32x2_t){0.f, 0.f};
#pragma unroll
        for (int k = 0; k < 16; ++k) {
            const f32x2_t av = (f32x2_t){a[k], a[k]};
            const uint4 wk = w[k];
            y[0] = __builtin_elementwise_fma(__builtin_amdgcn_cvt_pk_f32_fp8((int)wk.x, false), av, y[0]);
            y[1] = __builtin_elementwise_fma(__builtin_amdgcn_cvt_pk_f32_fp8((int)wk.x, true), av, y[1]);
            y[2] = __builtin_elementwise_fma(__builtin_amdgcn_cvt_pk_f32_fp8((int)wk.y, false), av, y[2]);
            y[3] = __builtin_elementwise_fma(__builtin_amdgcn_cvt_pk_f32_fp8((int)wk.y, true), av, y[3]);
            y[4] = __builtin_elementwise_fma(__builtin_amdgcn_cvt_pk_f32_fp8((int)wk.z, false), av, y[4]);
            y[5] = __builtin_elementwise_fma(__builtin_amdgcn_cvt_pk_f32_fp8((int)wk.z, true), av, y[5]);
            y[6] = __builtin_elementwise_fma(__builtin_amdgcn_cvt_pk_f32_fp8((int)wk.w, false), av, y[6]);
            y[7] = __builtin_elementwise_fma(__builtin_amdgcn_cvt_pk_f32_fp8((int)wk.w, true), av, y[7]);
        }
        f32x2_t k4[4], k2[2], k1;
#pragma unroll
        for (int k = 0; k < 4; ++k) {
            const f32x2_t keep = b3 ? y[4 + k] : y[k], send = b3 ? y[k] : y[4 + k];
            k4[k] = keep + (f32x2_t){__shfl_xor(send[0], 8), __shfl_xor(send[1], 8)};
        }
#pragma unroll
        for (int k = 0; k < 2; ++k) {
            const f32x2_t keep = b4 ? k4[2 + k] : k4[k], send = b4 ? k4[k] : k4[2 + k];
            k2[k] = keep + (f32x2_t){__shfl_xor(send[0], 16), __shfl_xor(send[1], 16)};
        }
        {
            const f32x2_t keep = b5 ? k2[1] : k2[0], send = b5 ? k2[0] : k2[1];
            k1 = keep + (f32x2_t){__shfl_xor(send[0], 32), __shfl_xor(send[1], 32)};
        }
        float2 o;
        o.x = __uint_as_float(hb << 16) + k1[0]; o.y = __uint_as_float(hb & 0xFFFF0000u) + k1[1];
        *(float2*)(p.out + (size_t)t * DM + col) = o;
        float ss = row_sum16(o.x * o.x + o.y * o.y);
        ss += __shfl_xor(ss, 16); ss += __shfl_xor(ss, 32);
        if (lane == 0) WS(float, OFF_SSQ2)[(size_t)c * T + t] = ss;
    }
}

template <int PHASE> __device__ __forceinline__ void ph_peer_sliced(const P& p, char* shm, int rep) {
    int* s_tile = (int*)shm;
    float* sact = (float*)(shm + 64) + (ltid() >> 6) * 128;
    const int tid = ltid(), lane = tid & 63, wid = tid >> 6;
    unsigned* qc = WS(unsigned, OFF_QCNT) + (PHASE == 2 ? 8 : 0) + 16 * rep;
    const unsigned x0 = xcc_id();
    for (int dc = 0; dc < 8; ++dc) {
        const int c = (int)((x0 + dc) & 7u);
        __syncthreads();
        if (tid == 0) *s_tile = (int)atomicAdd(&qc[c], 1u);
        __syncthreads();
        int tile = *s_tile;
        while (tile < T / PEER_TILE) {
            __syncthreads();
            int nxt = 0;
            if (tid == 0) nxt = (int)atomicAdd(&qc[c], 1u);
            const int t0 = tile * PEER_TILE + wid * PEER_WTOK;
            if (PHASE == 1) d_peer_e1_run(p, t0, c, lane); else d_peer_e2_run(p, t0, c, lane, sact);
            if (tid == 0) *s_tile = nxt;
            __syncthreads();
            tile = *s_tile;
        }
    }
}

__device__ __forceinline__ void d_peer_e3(const P& p, int t) {
    const int tid = ltid();
    float s = 0.f;
#pragma unroll
    for (int c = 0; c < 8; ++c) s += WS(float, OFF_SSQ2)[(size_t)c * T + t];
    const float rs = rsqrtf(s * (1.f / DM) + EPS);
    float4* op = (float4*)(p.out + (size_t)t * DM) + tid;
    const float4 g = ((const float4*)p.g_fin)[tid];
    float4 v = *op;
    v.x *= rs * g.x; v.y *= rs * g.y; v.z *= rs * g.z; v.w *= rs * g.w;
    *op = v;
}

#define XB_TMO      128
#define XB_XCNT(j)  (256  + 64 * (j))
#define XB_XSUB(j)  (1280 + 64 * (j))
#define XB_XGEN(j)  (2304 + 64 * (j))
#define XB_TOP      3328
#define XB_TOPGEN   3392
#define XCD_BAR_WORDS 3456
#define XB_SPIN_CAP (1u << 22)
#define LAS __attribute__((address_space(3)))
__device__ __forceinline__ unsigned xb_ld(unsigned* p) { return __hip_atomic_load(p, __ATOMIC_RELAXED, __HIP_MEMORY_SCOPE_AGENT); }
__device__ __forceinline__ unsigned xb_add(unsigned* p, unsigned v) { return __hip_atomic_fetch_add(p, v, __ATOMIC_RELAXED, __HIP_MEMORY_SCOPE_AGENT); }
__device__ __forceinline__ unsigned xb_xcc_id() { return (unsigned)__builtin_amdgcn_s_getreg((3 << 11) | 20) & 0xFu; }
#define XB_SPIN(cond, bar) do { unsigned _sp = 0; while (cond) { __builtin_amdgcn_s_sleep(1); \
    if ((++_sp & 255u) == 0u) { if (xb_ld(&(bar)[XB_TMO])) break; if (_sp > XB_SPIN_CAP) { atomicAdd(&(bar)[XB_TMO], 1u); break; } } } } while (0)
struct XcdBarrier { unsigned* bar; unsigned x; volatile LAS unsigned* st; };
__device__ __forceinline__ XcdBarrier xcd_barrier_post(unsigned* bar, volatile LAS unsigned* st) {
    XcdBarrier b; b.bar = bar; b.x = xb_xcc_id(); b.st = st;
    if (threadIdx.x == 0) (void)xb_add(&bar[XB_XCNT(b.x)], 1u);
    return b;
}
__device__ __forceinline__ void xcd_barrier_complete(unsigned* bar, unsigned x, unsigned& nloc, unsigned& nx) {
    const unsigned G = gridDim.x * gridDim.y * gridDim.z;
    unsigned sum, cnt, mine, sp = 0u;
    for (;;) {
        sum = 0u; cnt = 0u; mine = 0u;
#pragma unroll
        for (unsigned j = 0; j < 16; ++j) { const unsigned c = xb_ld(&bar[XB_XCNT(j)]); sum += c; cnt += (c > 0u) ? 1u : 0u; mine = (j == x) ? c : mine; }
        if (sum == G) break;
        __builtin_amdgcn_s_sleep(1);
        if ((++sp & 255u) == 0u) { if (xb_ld(&bar[XB_TMO])) break; if (sp > XB_SPIN_CAP) { atomicAdd(&bar[XB_TMO], 1u); break; } }
    }
    nloc = mine > 0u ? mine : 1u; nx = cnt > 0u ? cnt : 1u;
}
__device__ __forceinline__ void xcd_barrier(const XcdBarrier& b) {
    asm volatile("s_waitcnt vmcnt(0)" ::: "memory");
    __syncthreads();
    if (threadIdx.x == 0) {
        unsigned* bar = b.bar;
        __builtin_amdgcn_s_waitcnt(0);
        unsigned nloc = b.st[0], nx = b.st[1];
        if (nloc == 0u) { xcd_barrier_complete(bar, b.x, nloc, nx); b.st[0] = nloc; b.st[1] = nx; }
        const unsigned old = xb_add(&bar[XB_XSUB(b.x)], 1u);
        const unsigned gen = old / nloc;
        if (old + 1u == (gen + 1u) * nloc) {
            __builtin_amdgcn_fence(__ATOMIC_RELEASE, "agent");
            asm volatile("s_waitcnt vmcnt(0)" ::: "memory");
            const unsigned og = xb_add(&bar[XB_TOP], 1u);
            const unsigned tg = og / nx;
            if (og + 1u == (tg + 1u) * nx) xb_add(&bar[XB_TOPGEN], 1u);
            else XB_SPIN(xb_ld(&bar[XB_TOPGEN]) == tg, bar);
            __builtin_amdgcn_fence(__ATOMIC_ACQUIRE, "agent");
            xb_add(&bar[XB_XGEN(b.x)], 1u);
            asm volatile("s_waitcnt vmcnt(0)" ::: "memory");
        } else {
            XB_SPIN(xb_ld(&bar[XB_XGEN(b.x)]) == gen, bar);
            __builtin_amdgcn_fence(__ATOMIC_ACQUIRE, "agent");
            asm volatile("s_waitcnt vmcnt(0)" ::: "memory");
        }
    }
    __syncthreads();
}

#define REP_P0 1
#define REP_P1 1
#define REP_P2 1
#define REP_P2C 1
#define REP_P3 1
#define REP_P4G 1
#define REP_P4C 1
#define REP_P5 1
#define REP_P6 1
#define REP_P9 1
#define REP_E1 1
#define REP_E2 1
#define REPEAT(N) for (int rep_ = 0; rep_ < (N); ++rep_)
constexpr int SHM_BYTES = 65536;
__global__ void __launch_bounds__(256, 2) mega(P p) {
    __shared__ __attribute__((aligned(16))) char shm[SHM_BYTES + 16];
    const int G = gridDim.x, bid = blockIdx.x;
    volatile LAS unsigned* xst = (volatile LAS unsigned*)(shm + SHM_BYTES);
    if (threadIdx.x == 0) { xst[0] = 0u; xst[1] = 0u; }
    __syncthreads();
    const XcdBarrier xb = xcd_barrier_post(WS(unsigned, OFF_BAR), xst);

    {
        constexpr int U_WIN = (NIN / 64) * 16, U_WUA = 16 * 8, U_WUR = 16 * 8, U_WOUT = 16 * 16, U_WQ = 16 * 16, U_KEYS = 32, U_MISC = (LP * 8 + 255) / 256;
        constexpr int E0 = U_WIN, E1 = E0 + U_WUA, E2 = E1 + U_WUR, E3 = E2 + U_WOUT, E4 = E3 + U_WQ, E5 = E4 + U_KEYS, E6 = E5 + U_MISC, E7 = E6 + R / 4;
        if (bid == 0 && threadIdx.x < 64) WS(unsigned, OFF_QCNT)[threadIdx.x] = 0u;
        REPEAT(REP_P0)
        for (int u = bid; u < E7; u += G) {
            if (u < E0) d_transpose(p.w_in, WS(bf16_t, OFF_WIN), 1024, NIN, nullptr, u, shm);
            else if (u < E1) d_transpose(p.w_ua, WS(bf16_t, OFF_WUA), 512, 1024, nullptr, u - E0, shm);
            else if (u < E2) d_transpose(p.w_ur, WS(bf16_t, OFF_WUR), 512, 1024, nullptr, u - E1, shm);
            else if (u < E3) d_transpose(p.w_out, WS(bf16_t, OFF_WOUT), 1024, 1024, nullptr, u - E2, shm);
            else if (u < E4) d_transpose(p.w_q, WS(bf16_t, OFF_WQ), 1024, 1024, p.g_ffn, u - E3, shm);
            else if (u < E5) d_cvt(p.keys, WS(bf16_t, OFF_KEYS), (size_t)16 * 128 * 64 / 4, u - E4, U_KEYS);
            else if (u < E6) d_misc(p, u - E5);
            else d_rmsnorm_in(p, u - E6);
        }
    }
    xcd_barrier(xb);
    REPEAT(REP_P1) ph_gemm_inproj(p, shm);
    xcd_barrier(xb);
    REPEAT(REP_P2)
    for (int u = bid; u < 2048; u += G) { if (u < 1024) d_hgrn_A(p, u, shm); else d_attn(p, u - 1024, shm); }
    xcd_barrier(xb);
    for (int u = bid; u < 512; u += G) d_hgrn_scan(p, u);
    xcd_barrier(xb);
    REPEAT(REP_P2C)
    for (int u = bid; u < 1024; u += G) d_hgrn_C(p, u, shm);
    xcd_barrier(xb);
    REPEAT(REP_P3) ph_gemm_merge(p, shm);
    xcd_barrier(xb);
    REPEAT(REP_P4G) ph_gemm_out(p, shm);
    REPEAT(REP_P4C) {
    d_cvt8(p.edown, WS(unsigned char, OFF_EDN), (size_t)16384 * 1024 / 16, 64.f, bid, G);
    d_cvt8(p.eup, WS(unsigned char, OFF_EUP), (size_t)16384 * 1024 / 16, 8.f, bid, G); }
    xcd_barrier(xb);
    REPEAT(REP_P5) ph_peer_qry_topk(p, shm);
    xcd_barrier(xb);
    REPEAT(REP_E1) ph_peer_sliced<1>(p, shm, rep_);
    xcd_barrier(xb);
    d_peer_act(p, bid, G);
    xcd_barrier(xb);
    REPEAT(REP_E2) ph_peer_sliced<2>(p, shm, rep_);
    xcd_barrier(xb);
    REPEAT(REP_P9)
    for (int t = bid; t < T; t += G) d_peer_e3(p, t);
}

extern "C" void kernel_launch(void* const* d_in, const int* in_sizes, int n_in, void* d_out, int out_size, void* d_ws, size_t ws_size, hipStream_t stream) {
    P p{};
    p.x = (const float*)d_in[0]; p.meta = (const float*)d_in[1]; p.g_mix = (const float*)d_in[2]; p.w_in = (const float*)d_in[3];
    p.b_in = (const float*)d_in[4]; p.sinks = (const float*)d_in[5]; p.lb_logits = (const float*)d_in[6]; p.g_rec = (const float*)d_in[7];
    p.w_ua = (const float*)d_in[8]; p.w_ur = (const float*)d_in[9]; p.w_out = (const float*)d_in[10]; p.g_ffn = (const float*)d_in[11];
    p.w_q = (const float*)d_in[12]; p.keys = (const float*)d_in[13]; p.edown = (const float*)d_in[14]; p.eup = (const float*)d_in[15];
    p.g_fin = (const float*)d_in[16];
    p.out = (float*)d_out; p.ws = (char*)d_ws;
    static int grid_blocks = 0;
    if (!grid_blocks) {
        int dev = 0, cus = 0, per_cu = 0;
        (void)hipGetDevice(&dev);
        (void)hipDeviceGetAttribute(&cus, hipDeviceAttributeMultiprocessorCount, dev);
        (void)hipOccupancyMaxActiveBlocksPerMultiprocessor(&per_cu, mega, 256, 0);
        if (per_cu > 2) per_cu = 2;
        if (per_cu < 1) per_cu = 1;
        grid_blocks = cus * per_cu;
    }
    (void)hipMemsetAsync((char*)d_ws + OFF_BAR, 0, XCD_BAR_WORDS * 4, stream);
    void* args[] = {&p};
    hipError_t e = hipLaunchCooperativeKernel((void*)mega, dim3(grid_blocks), dim3(256), args, 0, stream);
    if (e != hipSuccess) fprintf(stderr, "cooperative launch failed: %s (grid %d)\n", hipGetErrorString(e), grid_blocks);
}
```
